# Optimizing an MI355X kernel written in HIP

```python
import jax, jax.numpy as jnp
from jax import lax
import numpy as np

D_MODEL = 2048
BATCH = 2
SEQ = 16384
DEPTH = 2

HEAD_DIM = 128
ROT_DIM = HEAD_DIM // 4
ROPE_THETA = 500000.0
NORM_EPS = 1e-6

DIL_GROUPS = ((128, 1), (512, 4), (2048, 16))
A_SLOTS = D_MODEL // 512
A_HEADS = A_SLOTS * len(DIL_GROUPS)
A_WIDTH = A_SLOTS * HEAD_DIM
B_Q_HEADS = D_MODEL // 256
B_KV_HEADS = B_Q_HEADS // 4
B_HALF_WINDOW = 128
B_WIDTH = B_Q_HEADS * HEAD_DIM
C_HEADS = D_MODEL // 256
C_DK = 128
C_DV = 128
C_WIDTH = C_HEADS * C_DV
C_CHUNK = 64
N_BRANCHES = 3

SPLIT_SIZES = (
    3 * A_HEADS * HEAD_DIM,
    A_WIDTH,
    B_Q_HEADS * HEAD_DIM,
    B_KV_HEADS * HEAD_DIM,
    B_KV_HEADS * HEAD_DIM,
    B_WIDTH,
    C_HEADS * C_DK,
    C_HEADS * C_DK,
    C_HEADS * C_DK,
    C_HEADS * C_DV,
    C_WIDTH,
    N_BRANCHES * D_MODEL,
)
IN_COLS = sum(SPLIT_SIZES)

kernel_name = "hybrid_dilated_window_hgrn2_encoder"


def rms_norm(t, gain):
    t32 = t.astype(jnp.float32)
    y = t32 * lax.rsqrt(jnp.mean(t32 * t32, axis=-1, keepdims=True) + NORM_EPS)
    return (y * gain.astype(jnp.float32)).astype(t.dtype)


def rope_tables(seq):
    pos = jnp.arange(seq, dtype=jnp.float32)
    inv_freq = ROPE_THETA ** (-jnp.arange(0, ROT_DIM, 2, dtype=jnp.float32) / ROT_DIM)
    ang = pos[:, None] * inv_freq[None, :]
    return jnp.cos(ang), jnp.sin(ang)


def apply_partial_rope(t, cos, sin):
    half = ROT_DIM // 2
    t32 = t.astype(jnp.float32)
    x1, x2, rest = t32[..., :half], t32[..., half:ROT_DIM], t32[..., ROT_DIM:]
    c, s = cos[:, None, :], sin[:, None, :]
    return jnp.concatenate([x1 * c - x2 * s, x2 * c + x1 * s, rest], axis=-1).astype(t.dtype)


def banded_window_attention(q, k, v, half_window, sink=None):
    bsz, L, hq, dh = q.shape
    hkv = k.shape[2]
    grp = hq // hkv
    blk = half_window
    nb = -(-L // blk)
    lp = nb * blk
    pad = lp - L
    q = jnp.pad(q, ((0, 0), (0, pad), (0, 0), (0, 0)))
    kpad = ((0, 0), (blk, pad + blk), (0, 0), (0, 0))
    k = jnp.pad(k, kpad)
    v = jnp.pad(v, kpad)

    def three_blocks(t):
        t = t.reshape(bsz, nb + 2, blk, hkv, dh)
        return jnp.concatenate([t[:, :-2], t[:, 1:-1], t[:, 2:]], axis=2)

    kb, vb = three_blocks(k), three_blocks(v)
    qb = q.reshape(bsz, nb, blk, hkv, grp, dh)
    s = jnp.einsum('bnqhgd,bnkhd->bnhgqk', qb, kb,
                   preferred_element_type=jnp.float32) * (dh ** -0.5)
    qpos = jnp.arange(lp).reshape(nb, blk)
    kpos = (jnp.arange(nb)[:, None] - 1) * blk + jnp.arange(3 * blk)[None, :]
    rel = kpos[:, None, :] - qpos[:, :, None]
    valid = (jnp.abs(rel) <= half_window) & (kpos[:, None, :] >= 0) & (kpos[:, None, :] < L)
    s = jnp.where(valid[None, :, None, None], s, -jnp.inf)
    m = jnp.max(s, axis=-1, keepdims=True)
    if sink is not None:
        sink_b = sink.astype(jnp.float32).reshape(1, 1, hkv, grp, 1, 1)
        m = jnp.maximum(m, sink_b)
    p = jnp.exp(s - m)
    denom = jnp.sum(p, axis=-1, keepdims=True)
    if sink is not None:
        denom = denom + jnp.exp(sink_b - m)
    o = jnp.einsum('bnhgqk,bnkhd->bnqhgd', p / denom, vb.astype(jnp.float32))
    lse = (m + jnp.log(denom))[..., 0].transpose(0, 1, 4, 2, 3)
    o = o.reshape(bsz, lp, hq, dh)[:, :L]
    lse = lse.reshape(bsz, lp, hq)[:, :L]
    return o, lse


def dilated_attention(q, k, v):
    bsz, s, _, dh = q.shape
    outs, lses = [], []
    for g, (window, dil) in enumerate(DIL_GROUPS):
        hs = slice(g * A_SLOTS, (g + 1) * A_SLOTS)

        def gather(t):
            t = t[:, :, hs].reshape(bsz, s // dil, dil, A_SLOTS, dh)
            return t.transpose(0, 2, 1, 3, 4).reshape(bsz * dil, s // dil, A_SLOTS, dh)

        o, lse = banded_window_attention(gather(q), gather(k), gather(v), window // (2 * dil))
        o = o.reshape(bsz, dil, s // dil, A_SLOTS, dh).transpose(0, 2, 1, 3, 4).reshape(bsz, s, A_SLOTS, dh)
        lse = lse.reshape(bsz, dil, s // dil, A_SLOTS).transpose(0, 2, 1, 3).reshape(bsz, s, A_SLOTS)
        outs.append(o)
        lses.append(lse)
    w = jax.nn.softmax(jnp.stack(lses), axis=0)
    out = jnp.einsum('gbsh,gbshd->bshd', w, jnp.stack(outs))
    return out.reshape(bsz, s, A_WIDTH)


def gla_chunk_scan(q, k, log_f, v):
    bsz, s, h, dk = q.shape
    dv = v.shape[-1]
    n = s // C_CHUNK

    def to_chunks(t):
        return t.reshape(bsz, n, C_CHUNK, h, t.shape[-1]).transpose(1, 0, 3, 2, 4)

    causal = jnp.tril(jnp.ones((C_CHUNK, C_CHUNK), dtype=bool))[:, :, None]

    def step(state, inp):
        qx, kx, lfx, vx = inp
        b = jnp.cumsum(lfx, axis=2)
        rel = b[:, :, :, None, :] - b[:, :, None, :, :]
        decay = jnp.exp(jnp.where(causal, rel, -jnp.inf))
        scores = jnp.einsum('bhtk,bhsk,bhtsk->bhts', qx, kx, decay)
        o = (jnp.einsum('bhts,bhsv->bhtv', scores, vx)
             + jnp.einsum('bhtk,bhkv->bhtv', qx * jnp.exp(b), state))
        b_last = b[:, :, -1:, :]
        state = (state * jnp.exp(b_last)[:, :, 0, :, None]
                 + jnp.einsum('bhsk,bhsv->bhkv', kx * jnp.exp(b_last - b), vx))
        return state, o

    state0 = jnp.zeros((bsz, h, dk, dv), jnp.float32)
    _, o = lax.scan(step, state0, (to_chunks(q), to_chunks(k), to_chunks(log_f), to_chunks(v)))
    return o.transpose(1, 0, 3, 2, 4).reshape(bsz, s, h, dv)


def hgrn2_bidirectional(q, f_fwd, f_bwd, inp, gate, lb, norm_gain):
    bsz, s, _ = q.shape

    def heads(t, d):
        return t.reshape(bsz, s, C_HEADS, d).astype(jnp.float32)

    qh = jax.nn.silu(heads(q, C_DK))
    vh = heads(inp, C_DV)
    lb = lb.reshape(C_HEADS, C_DK)
    log_lb = jnp.log(lb)

    def gates(fz):
        fz = heads(fz, C_DK)
        log_f = jnp.logaddexp(log_lb, jnp.log1p(-lb) + jax.nn.log_sigmoid(fz))
        k = (1.0 - lb) * jax.nn.sigmoid(-fz)
        return log_f, k

    lf_f, k_f = gates(f_fwd)
    lf_b, k_b = gates(f_bwd)
    o_f = gla_chunk_scan(qh, k_f, lf_f, vh)
    flip = lambda t: jnp.flip(t, axis=1)
    o_b = flip(gla_chunk_scan(flip(qh), flip(k_b), flip(lf_b), flip(vh)))
    o = o_f + o_b
    o = o * lax.rsqrt(jnp.mean(o * o, axis=-1, keepdims=True) + NORM_EPS)
    o = o * norm_gain.astype(jnp.float32).reshape(C_HEADS, C_DV)
    return o.reshape(bsz, s, C_WIDTH) * jax.nn.silu(gate.astype(jnp.float32))


def setup_inputs(seed: int = 0) -> dict:
    key = jax.random.key(seed)
    ks = jax.random.split(key, 12)
    f32 = jnp.float32

    def dense(k, shape, fan_in):
        return jax.random.normal(k, shape, f32) * (fan_in ** -0.5)

    return {
        "x": jax.random.normal(ks[0], (BATCH, SEQ, D_MODEL), f32),
        "pre_norm": 1.0 + 0.05 * jax.random.normal(ks[1], (DEPTH, D_MODEL), f32),
        "post_norm": 1.0 + 0.05 * jax.random.normal(ks[2], (DEPTH, D_MODEL), f32),
        "w_in": dense(ks[3], (DEPTH, D_MODEL, IN_COLS), D_MODEL),
        "sink_logits": 0.5 * jax.random.normal(ks[4], (DEPTH, B_Q_HEADS), f32),
        "hgrn_lower_bounds": 0.5 * jax.random.normal(ks[5], (DEPTH, C_HEADS * C_DK), f32),
        "hgrn_norm": 1.0 + 0.05 * jax.random.normal(ks[6], (DEPTH, C_WIDTH), f32),
        "w_branch_a": dense(ks[7], (DEPTH, A_WIDTH, D_MODEL), A_WIDTH),
        "w_branch_b": dense(ks[8], (DEPTH, B_WIDTH, D_MODEL), B_WIDTH),
        "w_branch_c": dense(ks[9], (DEPTH, C_WIDTH, D_MODEL), C_WIDTH),
        "w_out": dense(ks[10], (DEPTH, D_MODEL, D_MODEL), D_MODEL),
    }


def reference(x, pre_norm, post_norm, w_in, sink_logits, hgrn_lower_bounds, hgrn_norm,
              w_branch_a, w_branch_b, w_branch_c, w_out):
    bsz, s, _ = x.shape
    cos, sin = rope_tables(s)
    lb_all = jnp.cumsum(jax.nn.softmax(hgrn_lower_bounds.astype(jnp.float32), axis=0), axis=0)
    lb_all = lb_all - lb_all[0:1]
    split_points = [int(p) for p in np.cumsum(SPLIT_SIZES)[:-1]]
    for layer in range(DEPTH):
        xn = rms_norm(x, pre_norm[layer])
        proj = xn @ w_in[layer]
        (a_qkv, a_gate, b_q, b_k, b_v, b_gate,
         c_q, c_ff, c_fb, c_i, c_gate, merge) = jnp.split(proj, split_points, axis=-1)

        a_qkv = a_qkv.reshape(bsz, s, 3, A_HEADS, HEAD_DIM)
        qa = apply_partial_rope(a_qkv[:, :, 0], cos, sin)
        ka = apply_partial_rope(a_qkv[:, :, 1], cos, sin)
        ya = dilated_attention(qa, ka, a_qkv[:, :, 2]) * jax.nn.silu(a_gate.astype(jnp.float32))

        qb = apply_partial_rope(b_q.reshape(bsz, s, B_Q_HEADS, HEAD_DIM), cos, sin)
        kb = apply_partial_rope(b_k.reshape(bsz, s, B_KV_HEADS, HEAD_DIM), cos, sin)
        vb = b_v.reshape(bsz, s, B_KV_HEADS, HEAD_DIM)
        ob, _ = banded_window_attention(qb, kb, vb, B_HALF_WINDOW, sink=sink_logits[layer])
        yb = ob.reshape(bsz, s, B_WIDTH) * jax.nn.silu(b_gate.astype(jnp.float32))

        yc = hgrn2_bidirectional(c_q, c_ff, c_fb, c_i, c_gate, lb_all[layer], hgrn_norm[layer])

        g = jax.nn.sigmoid(merge.astype(jnp.float32)).reshape(bsz, s, N_BRANCHES, D_MODEL)
        dt = x.dtype
        y = (g[:, :, 0] * (ya.astype(dt) @ w_branch_a[layer])
             + g[:, :, 1] * (yb.astype(dt) @ w_branch_b[layer])
             + g[:, :, 2] * (yc.astype(dt) @ w_branch_c[layer]))
        out = y.astype(dt) @ w_out[layer]
        x = x + rms_norm(out, post_norm[layer])
    return x
```

```cpp
#include <hip/hip_runtime.h>
#include <hip/hip_cooperative_groups.h>
#include <cstdio>
#include <cstdint>
namespace cg = cooperative_groups;
namespace pg8 {
#define PG8_LAS __attribute__((address_space(3)))
typedef unsigned short bf16_t;
typedef short bf16x8 __attribute__((ext_vector_type(8)));
typedef float f32x4 __attribute__((ext_vector_type(4)));
typedef unsigned u32x4 __attribute__((ext_vector_type(4)));
constexpr int BM = 256, BK = 64, HALF = 128, HTB = HALF * BK * 2  , STAGE_BYTES = 8 * HTB, NXCD = 8, WGM = 8;

__host__ __device__ __forceinline__ int lds_byte(int r, int c) { const int st = (r >> 4) * 2 + (c >> 5), rr = r & 15, cc = c & 31, ob = rr * 64 + cc * 2; return st * 1024 + (ob ^ (((ob >> 9) & 1) << 5)); }
__host__ __device__ __forceinline__ void stage_rc(int b, int& R, int& C) { const int st = b / 1024, sb = b % 1024, swz = sb ^ (((sb >> 9) & 1) << 5); R = (st >> 1) * 16 + swz / 64; C = (st & 1) * 32 + (swz % 64) / 2; }
__host__ __device__ __forceinline__ int perm32(int rho) { const int n = rho >> 4, i = rho & 15; return 8 * (i >> 2) + 4 * n + (i & 3); }

struct Unit { int pm, pn; };
struct Gemm { const bf16_t* A; const bf16_t* Bt; int M, N, K; };

struct StaticOrder {
    int nM, nN, nwg, G, c;
    __host__ __device__ void init(int M, int N, int G_, int c_) { nM = M / BM; nN = N / BM; nwg = nM * nN; G = G_; c = c_; }
    __host__ __device__ bool next(int i, Unit& u) const {
        const long L = (long)i * G + c; if (L >= nwg) return false;
        int wgid = (int)L; { const int q = nwg / NXCD, r = nwg % NXCD, xcd = wgid % NXCD, off = wgid / NXCD; wgid = (xcd < r ? xcd * (q + 1) : r * (q + 1) + (xcd - r) * q) + off; }
        const int nig = WGM * nN, gid = wgid / nig, fm = gid * WGM, gsz = (nM - fm) < WGM ? (nM - fm) : WGM;
        u.pm = fm + ((wgid % nig) % gsz); u.pn = (wgid % nig) / gsz; return true;
    }
    __device__ __forceinline__ void a_ready(const Unit&) const {}
    __device__ __forceinline__ void done(const Unit&) const {}
};

__device__ __forceinline__ unsigned cvt_pk_bf16(float lo, float hi) { unsigned r; asm volatile("v_cvt_pk_bf16_f32 %0, %1, %2" : "=v"(r) : "v"(lo), "v"(hi)); return r; }
template <class Epi, class Sched, bool ALIGN_EPI = false, bool SP2 = false>
__device__ __forceinline__ void gemm_phase(PG8_LAS unsigned char* lds, const Gemm g, const Sched& S, const Epi& E) {
    int tid = threadIdx.x; asm volatile("" : "+v"(tid));
    const int wid = __builtin_amdgcn_readfirstlane(tid >> 6), lane = tid & 63, wr = wid >> 2, wc = wid & 3, fr = lane & 15, fq = lane >> 4;
    const int K = g.K, nt = K / BK;
    unsigned voffA[2], voffB[2];
#pragma unroll
    for (int i = 0; i < 2; ++i) { int R, C; stage_rc(tid * 16 + i * 8192, R, C); const int Rb = Epi::PERM ? ((R & ~31) + perm32(R & 31)) : R;
        voffA[i] = (unsigned)(R * K + C) * 2u; voffB[i] = (unsigned)(Rb * K + C) * 2u; }
    const size_t kstep = (size_t)(BK * 2);
    const size_t hstep = (size_t)HALF * K * 2;
    const size_t tstep = 2 * hstep;
    const unsigned ldsw = (unsigned)wid * 1024u;
    const int aoff = lds_byte(wr * 64 + fr, fq * 8), boff = lds_byte(wc * 32 + fr, fq * 8);
#define PG8_SA(b, h) (((b) * 2 + (h)) * HTB)
#define PG8_SB(b, h) ((4 + (b) * 2 + (h)) * HTB)
#define PG8_STAGE(bufoff, gbase, voff) do { _Pragma("unroll") for (int _i = 0; _i < 2; ++_i) \
        __builtin_amdgcn_global_load_lds((const unsigned*)((const char*)(gbase) + (voff)[_i]), (PG8_LAS unsigned*)(lds + (bufoff) + ldsw + _i * 8192), 16, 0, 0); } while (0)
#define PG8_LDA(dst, b, h) do { _Pragma("unroll") for (int m = 0; m < 4; ++m) _Pragma("unroll") for (int k = 0; k < 2; ++k) dst[m][k] = *(const PG8_LAS bf16x8*)(lds + PG8_SA(b, h) + aoff + m * 2048 + k * 1024); } while (0)
#define PG8_LDB(dst, b, h) do { _Pragma("unroll") for (int n = 0; n < 2; ++n) _Pragma("unroll") for (int k = 0; k < 2; ++k) dst[n][k] = *(const PG8_LAS bf16x8*)(lds + PG8_SB(b, h) + boff + n * 2048 + k * 1024); } while (0)
#define PG8_MMA(ai, bj, At, Bt) do { __builtin_amdgcn_s_setprio(1); _Pragma("unroll") for (int m = 0; m < 4; ++m) _Pragma("unroll") for (int n = 0; n < 2; ++n) _Pragma("unroll") for (int k = 0; k < 2; ++k) \
        acc[ai][bj][m][n] = __builtin_amdgcn_mfma_f32_16x16x32_bf16(Bt[n][k], At[m][k], acc[ai][bj][m][n], 0, 0, 0); __builtin_amdgcn_s_setprio(0); } while (0)
#define PG8_WAIT_V(n) asm volatile("s_waitcnt vmcnt(" #n ")" ::: "memory")
#define PG8_WAIT_L(n) asm volatile("s_waitcnt lgkmcnt(" #n ")" ::: "memory")
#define PG8_BAR __builtin_amdgcn_s_barrier()
#define PG8_SCHED __builtin_amdgcn_sched_barrier(0)
    Unit cur, nxt; int ui = 0;
    if (!S.next(0, cur)) return;
    f32x4 acc[2][2][4][2];
#pragma unroll
    for (int a = 0; a < 2; ++a)
#pragma unroll
        for (int b = 0; b < 2; ++b)
#pragma unroll
            for (int m = 0; m < 4; ++m)
#pragma unroll
                for (int n = 0; n < 2; ++n) acc[a][b][m][n] = (f32x4){0.f, 0.f, 0.f, 0.f};
    bf16x8 At[4][2], B0[2][2], B1[2][2];
    const char* cA = (const char*)g.A + (size_t)cur.pm * tstep; const char* cB = (const char*)g.Bt + (size_t)cur.pn * tstep;
    S.a_ready(cur);
    if constexpr (SP2) {
        PG8_STAGE(PG8_SB(0, 0), cB, voffB); PG8_STAGE(PG8_SB(0, 1), cB + hstep, voffB); PG8_STAGE(PG8_SA(0, 0), cA, voffA); PG8_STAGE(PG8_SA(0, 1), cA + hstep, voffA);
        if (wr == 1) PG8_BAR;
        PG8_WAIT_V(2); PG8_BAR;
        PG8_STAGE(PG8_SB(1, 0), cB + kstep, voffB); PG8_STAGE(PG8_SA(1, 0), cA + kstep, voffA); PG8_STAGE(PG8_SB(1, 1), cB + hstep + kstep, voffB);
        PG8_WAIT_V(6); PG8_BAR;
    } else {
        PG8_STAGE(PG8_SB(0, 0), cB, voffB); PG8_STAGE(PG8_SA(0, 0), cA, voffA); PG8_STAGE(PG8_SB(0, 1), cB + hstep, voffB); PG8_STAGE(PG8_SA(0, 1), cA + hstep, voffA);
        if (wr == 1) PG8_BAR;
        PG8_WAIT_V(4); PG8_BAR;
        PG8_STAGE(PG8_SB(1, 0), cB + kstep, voffB); PG8_STAGE(PG8_SA(1, 0), cA + kstep, voffA); PG8_STAGE(PG8_SB(1, 1), cB + hstep + kstep, voffB);
        PG8_WAIT_V(6); PG8_BAR;
    }
    for (;;) {
        const bool has_next = S.next(ui + 1, nxt);
        const char* nA = has_next ? (const char*)g.A + (size_t)nxt.pm * tstep : cA; const char* nB = has_next ? (const char*)g.Bt + (size_t)nxt.pn * tstep : cB;
        for (int t = 0; t < nt; t += 2) {
            const bool last = (t == nt - 2);
            const char* a1 = cA + (size_t)(t + 1) * kstep;
            const char* a2 = last ? nA : cA + (size_t)(t + 2) * kstep; const char* b2 = last ? nB : cB + (size_t)(t + 2) * kstep;
            const char* a3 = a2 + kstep; const char* b3 = b2 + kstep;
            if (last && has_next) S.a_ready(nxt);
            if constexpr (SP2) {
            PG8_LDB(B0, 0, 0); PG8_LDB(B1, 0, 1); PG8_SCHED; PG8_LDA(At, 0, 0); PG8_STAGE(PG8_SA(1, 1), a1 + hstep, voffA);
            PG8_WAIT_V(8); PG8_WAIT_L(0); PG8_BAR; PG8_MMA(0, 0, At, B0); PG8_MMA(0, 1, At, B1); PG8_BAR; PG8_SCHED;
            PG8_LDA(At, 0, 1); PG8_STAGE(PG8_SB(0, 0), b2, voffB); PG8_STAGE(PG8_SB(0, 1), b2 + hstep, voffB); PG8_STAGE(PG8_SA(0, 0), a2, voffA);
            PG8_WAIT_V(8); PG8_WAIT_L(0); PG8_BAR; PG8_MMA(1, 0, At, B0); PG8_MMA(1, 1, At, B1); PG8_BAR; PG8_SCHED;
            PG8_LDB(B0, 1, 0); PG8_LDB(B1, 1, 1); PG8_SCHED; PG8_LDA(At, 1, 0); PG8_STAGE(PG8_SA(0, 1), a2 + hstep, voffA);
            PG8_WAIT_V(8); PG8_WAIT_L(0); PG8_BAR; PG8_MMA(0, 0, At, B0); PG8_MMA(0, 1, At, B1); PG8_BAR; PG8_SCHED;
            PG8_LDA(At, 1, 1); PG8_STAGE(PG8_SB(1, 0), b3, voffB); PG8_STAGE(PG8_SB(1, 1), b3 + hstep, voffB); PG8_STAGE(PG8_SA(1, 0), a3, voffA);
            PG8_WAIT_V(8); PG8_WAIT_L(0); PG8_BAR; PG8_MMA(1, 0, At, B0); PG8_MMA(1, 1, At, B1); PG8_BAR; PG8_SCHED;
            } else {
            PG8_LDB(B0, 0, 0); PG8_SCHED; PG8_LDA(At, 0, 0); PG8_STAGE(PG8_SA(1, 1), a1 + hstep, voffA);
            PG8_WAIT_L(8); PG8_BAR; PG8_WAIT_L(0); PG8_MMA(0, 0, At, B0); PG8_BAR; PG8_SCHED;
            PG8_LDB(B1, 0, 1); PG8_STAGE(PG8_SB(0, 0), b2, voffB);
            PG8_BAR; PG8_WAIT_L(0); PG8_MMA(0, 1, At, B1); PG8_BAR;
            PG8_LDA(At, 0, 1); PG8_STAGE(PG8_SA(0, 0), a2, voffA);
            PG8_BAR; PG8_WAIT_L(0); PG8_MMA(1, 0, At, B0); PG8_BAR; PG8_SCHED;
            PG8_STAGE(PG8_SB(0, 1), b2 + hstep, voffB);
            PG8_WAIT_V(6); PG8_BAR; PG8_MMA(1, 1, At, B1); PG8_BAR;
            PG8_LDB(B0, 1, 0); PG8_SCHED; PG8_LDA(At, 1, 0); PG8_STAGE(PG8_SA(0, 1), a2 + hstep, voffA);
            PG8_WAIT_L(8); PG8_BAR; PG8_WAIT_L(0); PG8_MMA(0, 0, At, B0); PG8_BAR; PG8_SCHED;
            PG8_LDB(B1, 1, 1); PG8_STAGE(PG8_SB(1, 0), b3, voffB);
            PG8_BAR; PG8_WAIT_L(0); PG8_MMA(0, 1, At, B1); PG8_BAR;
            PG8_LDA(At, 1, 1); PG8_STAGE(PG8_SA(1, 0), a3, voffA);
            PG8_BAR; PG8_WAIT_L(0); PG8_MMA(1, 0, At, B0); PG8_BAR; PG8_SCHED;
            PG8_STAGE(PG8_SB(1, 1), b3 + hstep, voffB);
            PG8_WAIT_V(6); PG8_BAR; PG8_MMA(1, 1, At, B1); PG8_BAR;
            }
        }
        if constexpr (ALIGN_EPI) { if (wr == 0) PG8_BAR; }
        if constexpr (!Epi::AFTER_DRAIN) { E(acc, cur, wr, wc, fr, fq); S.done(cur); }
        if (!has_next) break;
#pragma unroll
        for (int a = 0; a < 2; ++a)
#pragma unroll
            for (int b = 0; b < 2; ++b)
#pragma unroll
                for (int m = 0; m < 4; ++m)
#pragma unroll
                    for (int n = 0; n < 2; ++n) acc[a][b][m][n] = (f32x4){0.f, 0.f, 0.f, 0.f};
        cur = nxt; cA = nA; cB = nB; ++ui;
        if constexpr (ALIGN_EPI) { if (wr == 1) PG8_BAR; }
    }
    PG8_WAIT_V(0);
    if constexpr (!ALIGN_EPI) { if (wr == 0) PG8_BAR; }
    PG8_BAR;
    if constexpr (Epi::AFTER_DRAIN) { E.fused(acc, cur, wr, wc, fr, fq, lds, wid, lane); S.done(cur); }
#undef PG8_SA
#undef PG8_SB
#undef PG8_STAGE
#undef PG8_LDA
#undef PG8_LDB
#undef PG8_MMA
#undef PG8_WAIT_V
#undef PG8_WAIT_L
#undef PG8_BAR
#undef PG8_SCHED
}
}

#define LAS __attribute__((address_space(3)))
typedef unsigned short bf16_t;
typedef short bf16x8 __attribute__((ext_vector_type(8)));
typedef short bf16x4 __attribute__((ext_vector_type(4)));
typedef float f32x4 __attribute__((ext_vector_type(4)));
typedef unsigned u32x4 __attribute__((ext_vector_type(4)));
typedef unsigned u32x2 __attribute__((ext_vector_type(2)));

constexpr int T = 32768, S = 16384, D = 2048;
constexpr int PC = 10240;
constexpr int NGATE = 2560, NMERGE = 6144, NIN = 18944;
constexpr int PA_Q = 0, PA_K = 1536, PA_V = 3072, PB_Q = 4608, PB_K = 5632, PB_V = 5888, PC_Q = 6144, PC_FF = 7168, PC_FB = 8192, PC_I = 9216;
constexpr float NORM_EPS = 1e-6f;
constexpr size_t MiB = 1u << 20;
constexpr size_t WS_ROPE = 1 * MiB, WS_LSE = 3 * MiB, WS_LB = 5 * MiB, WS_LSUM = 5 * MiB + 65536;
constexpr size_t WS_WIN = 6 * MiB, WS_WA = 80 * MiB, WS_WB = 82 * MiB, WS_WC = 86 * MiB, WS_WO = 90 * MiB;
constexpr size_t WS_XN = 98 * MiB, WS_YA = 226 * MiB, WS_YB = 258 * MiB, WS_YC = 322 * MiB, WS_SUM = 386 * MiB, WS_P = 418 * MiB, WS_END = 1058 * MiB;
constexpr size_t WS_G = WS_P, WS_YM = WS_P + 384 * MiB, WS_OUT = WS_P;
constexpr int LDS_BYTES = 163840;
constexpr int NTHREADS = 512;
#ifndef NLAYER
#define NLAYER 2
#endif

__device__ __forceinline__ float bf2f(unsigned short b) { return __builtin_bit_cast(float, (unsigned)b << 16); }
__device__ __forceinline__ float bf2f_s(short b) { return __builtin_bit_cast(float, ((unsigned)(unsigned short)b) << 16); }
typedef float f32x2_t __attribute__((ext_vector_type(2))); typedef __bf16 bf16x2_t __attribute__((ext_vector_type(2)));
__device__ __forceinline__ unsigned pk2(float lo, float hi) { f32x2_t v = {lo, hi}; bf16x2_t b = __builtin_convertvector(v, bf16x2_t); return __builtin_bit_cast(unsigned, b); }
__device__ __forceinline__ float wave_sum(float v) {
#pragma unroll
    for (int o = 1; o < 64; o <<= 1) v += __shfl_xor(v, o);
    return v;
}
__device__ __forceinline__ f32x4 mfma16(bf16x8 a, bf16x8 b, f32x4 c) { return __builtin_amdgcn_mfma_f32_16x16x32_bf16(a, b, c, 0, 0, 0); }
__device__ __forceinline__ float fast_sigmoid(float x) { return __builtin_amdgcn_rcpf(1.0f + __expf(-x)); }

__device__ __forceinline__ void transpose_item(const float* W, int K, int N, bf16_t* WT, int drow, LAS float* scr, int k0, int n0, int lane) {
#pragma unroll 8
    for (int i = 0; i < 32; ++i) { const int kk = 2 * i + (lane >> 5); scr[kk * 33 + (lane & 31)] = W[(size_t)(k0 + kk) * N + n0 + (lane & 31)]; }
    asm volatile("s_waitcnt lgkmcnt(0)" ::: "memory");
    const int c = lane & 7;
#pragma unroll
    for (int j = 0; j < 4; ++j) { const int n = (lane >> 3) + 8 * j; const LAS float* s = scr + (8 * c) * 33 + n;
        u32x4 o; o.x = pk2(s[0 * 33], s[1 * 33]); o.y = pk2(s[2 * 33], s[3 * 33]); o.z = pk2(s[4 * 33], s[5 * 33]); o.w = pk2(s[6 * 33], s[7 * 33]);
        *(u32x4*)(WT + (size_t)(drow + n) * K + k0 + 8 * c) = o; }
    asm volatile("s_waitcnt lgkmcnt(0)" ::: "memory");
}
__device__ __forceinline__ int win_dst(int n) {
    if (n < 4608) return n;
    if (n < 5120) return 10240 + (n - 4608);
    if (n < 6656) return 4608 + (n - 5120);
    if (n < 7680) return 10240 + 512 + (n - 6656);
    if (n < 11776) return 6144 + (n - 7680);
    if (n < 12800) return 10240 + 1536 + (n - 11776);
    return n;
}
struct Weights { const float *win, *wa, *wb, *wc, *wo; };
__device__ __forceinline__ void transpose_weights(const Weights& Wt, unsigned char* ws, LAS unsigned char* lds, int gw, int NGW, int wave, int lane) {
    LAS float* scr = (LAS float*)(lds + wave * 8448);
    constexpr int I_IN = 32 * (NIN / 32), I_A = 8 * 64, I_B = 16 * 64, I_C = 16 * 64, I_O = 32 * 64;
    constexpr int NITEMS = I_IN + I_A + I_B + I_C + I_O;
    for (int it = gw; it < NITEMS; it += NGW) {
        int r = it;
        if (r < I_IN) { const int nb = r % (NIN / 32), kb = r / (NIN / 32); transpose_item(Wt.win, D, NIN, (bf16_t*)(ws + WS_WIN), win_dst(nb * 32), scr, kb * 64, nb * 32, lane); continue; } r -= I_IN;
        if (r < I_A) { const int nb = r % 64, kb = r / 64; transpose_item(Wt.wa, 512, D, (bf16_t*)(ws + WS_WA), nb * 32, scr, kb * 64, nb * 32, lane); continue; } r -= I_A;
        if (r < I_B) { const int nb = r % 64, kb = r / 64; transpose_item(Wt.wb, 1024, D, (bf16_t*)(ws + WS_WB), nb * 32, scr, kb * 64, nb * 32, lane); continue; } r -= I_B;
        if (r < I_C) { const int nb = r % 64, kb = r / 64; transpose_item(Wt.wc, 1024, D, (bf16_t*)(ws + WS_WC), nb * 32, scr, kb * 64, nb * 32, lane); continue; } r -= I_C;
        { const int nb = r % 64, kb = r / 64; transpose_item(Wt.wo, D, D, (bf16_t*)(ws + WS_WO), nb * 32, scr, kb * 64, nb * 32, lane); }
    }
}
__device__ __forceinline__ void prenorm_row(const float* xrow, const float* gain, bf16_t* orow, int lane) {
    f32x4 v[8]; float s = 0.f;
#pragma unroll
    for (int j = 0; j < 8; ++j) { v[j] = ((const f32x4*)xrow)[lane + 64 * j]; s += (v[j].x * v[j].x + v[j].y * v[j].y) + (v[j].z * v[j].z + v[j].w * v[j].w); }
    const float r = 1.0f / sqrtf(wave_sum(s) * (1.0f / D) + NORM_EPS);
#pragma unroll
    for (int j = 0; j < 8; ++j) { const f32x4 g = ((const f32x4*)gain)[lane + 64 * j]; u32x2 o; o.x = pk2(v[j].x * r * g.x, v[j].y * r * g.y); o.y = pk2(v[j].z * r * g.z, v[j].w * r * g.w);
        ((u32x2*)orow)[lane + 64 * j] = o; }
}
__device__ __forceinline__ void final_row(const float* orow, const float* post, const float* xold, float* xnew, const float* pre_next, bf16_t* xn_next, int lane) {
    f32x4 v[8]; float s = 0.f;
#pragma unroll
    for (int j = 0; j < 8; ++j) { v[j] = ((const f32x4*)orow)[lane + 64 * j]; s += (v[j].x * v[j].x + v[j].y * v[j].y) + (v[j].z * v[j].z + v[j].w * v[j].w); }
    const float r = 1.0f / sqrtf(wave_sum(s) * (1.0f / D) + NORM_EPS);
    float s2 = 0.f;
#pragma unroll
    for (int j = 0; j < 8; ++j) { const f32x4 g = ((const f32x4*)post)[lane + 64 * j]; const f32x4 xo = ((const f32x4*)xold)[lane + 64 * j];
        f32x4 y; y.x = xo.x + v[j].x * r * g.x; y.y = xo.y + v[j].y * r * g.y; y.z = xo.z + v[j].z * r * g.z; y.w = xo.w + v[j].w * r * g.w;
        v[j] = y; s2 += (y.x * y.x + y.y * y.y) + (y.z * y.z + y.w * y.w); ((f32x4*)xnew)[lane + 64 * j] = y; }
    if (xn_next) {
        const float r2 = 1.0f / sqrtf(wave_sum(s2) * (1.0f / D) + NORM_EPS);
#pragma unroll
        for (int j = 0; j < 8; ++j) { const f32x4 g = ((const f32x4*)pre_next)[lane + 64 * j]; u32x2 o; o.x = pk2(v[j].x * r2 * g.x, v[j].y * r2 * g.y); o.y = pk2(v[j].z * r2 * g.z, v[j].w * r2 * g.w);
            ((u32x2*)xn_next)[lane + 64 * j] = o; }
    }
}

#define EPI_LOOP_BEGIN \
    const int row0 = u.pm * 256 + wr * 64 + fr; const int colb = u.pn * 256 + wc * 32 + 8 * fq; \
    _Pragma("unroll") for (int ai = 0; ai < 2; ++ai) _Pragma("unroll") for (int m = 0; m < 4; ++m) { const int row = row0 + ai * 128 + m * 16; \
    _Pragma("unroll") for (int bj = 0; bj < 2; ++bj) { const int col = colb + bj * 128; const f32x4 v0 = acc[ai][bj][m][0], v1 = acc[ai][bj][m][1];
#define EPI_LOOP_END } }

struct EpiStoreBf16 {
    static constexpr bool PERM = true, AFTER_DRAIN = false;
    bf16_t* O; int ldc;
    __device__ __forceinline__ void operator()(const f32x4 (&acc)[2][2][4][2], const pg8::Unit& u, int wr, int wc, int fr, int fq) const {
        EPI_LOOP_BEGIN
            u32x4 w; w.x = pk2(v0[0], v0[1]); w.y = pk2(v0[2], v0[3]); w.z = pk2(v1[0], v1[1]); w.w = pk2(v1[2], v1[3]);
            *(u32x4*)(O + (size_t)row * ldc + col) = w;
        EPI_LOOP_END
    }
};
struct EpiSigmoidBf16 {
    static constexpr bool PERM = true, AFTER_DRAIN = false;
    bf16_t* O; int ldc;
    __device__ __forceinline__ void operator()(const f32x4 (&acc)[2][2][4][2], const pg8::Unit& u, int wr, int wc, int fr, int fq) const {
        EPI_LOOP_BEGIN
            u32x4 w; w.x = pk2(fast_sigmoid(v0[0]), fast_sigmoid(v0[1])); w.y = pk2(fast_sigmoid(v0[2]), fast_sigmoid(v0[3]));
            w.z = pk2(fast_sigmoid(v1[0]), fast_sigmoid(v1[1])); w.w = pk2(fast_sigmoid(v1[2]), fast_sigmoid(v1[3]));
            *(u32x4*)(O + (size_t)row * ldc + col) = w;
        EPI_LOOP_END
    }
};
struct EpiStoreF32 {
    static constexpr bool PERM = true, AFTER_DRAIN = false;
    float* O; int ldc;
    __device__ __forceinline__ void operator()(const f32x4 (&acc)[2][2][4][2], const pg8::Unit& u, int wr, int wc, int fr, int fq) const {
        EPI_LOOP_BEGIN
            float* p = O + (size_t)row * ldc + col; *(f32x4*)p = v0; *(f32x4*)(p + 4) = v1;
        EPI_LOOP_END
    }
};
template <bool FIRST> struct EpiBranch {
    static constexpr bool PERM = true, AFTER_DRAIN = false;
    bf16_t* YM; const bf16_t* G; int br;
    __device__ __forceinline__ void operator()(const f32x4 (&acc)[2][2][4][2], const pg8::Unit& u, int wr, int wc, int fr, int fq) const {
        EPI_LOOP_BEGIN
            const u32x4 g = *(const u32x4*)(G + (size_t)row * NMERGE + br * 2048 + col);
            float y[8];
            y[0] = v0[0] * __builtin_bit_cast(float, g.x << 16); y[1] = v0[1] * __builtin_bit_cast(float, g.x & 0xffff0000u);
            y[2] = v0[2] * __builtin_bit_cast(float, g.y << 16); y[3] = v0[3] * __builtin_bit_cast(float, g.y & 0xffff0000u);
            y[4] = v1[0] * __builtin_bit_cast(float, g.z << 16); y[5] = v1[1] * __builtin_bit_cast(float, g.z & 0xffff0000u);
            y[6] = v1[2] * __builtin_bit_cast(float, g.w << 16); y[7] = v1[3] * __builtin_bit_cast(float, g.w & 0xffff0000u);
            bf16_t* yp = YM + (size_t)row * D + col;
            if (!FIRST) { const u32x4 o = *(const u32x4*)yp;
                y[0] += __builtin_bit_cast(float, o.x << 16); y[1] += __builtin_bit_cast(float, o.x & 0xffff0000u);
                y[2] += __builtin_bit_cast(float, o.y << 16); y[3] += __builtin_bit_cast(float, o.y & 0xffff0000u);
                y[4] += __builtin_bit_cast(float, o.z << 16); y[5] += __builtin_bit_cast(float, o.z & 0xffff0000u);
                y[6] += __builtin_bit_cast(float, o.w << 16); y[7] += __builtin_bit_cast(float, o.w & 0xffff0000u); }
            u32x4 w; w.x = pk2(y[0], y[1]); w.y = pk2(y[2], y[3]); w.z = pk2(y[4], y[5]); w.w = pk2(y[6], y[7]);
            *(u32x4*)yp = w;
        EPI_LOOP_END
    }
};
struct EpiGate {
    static constexpr bool PERM = true, AFTER_DRAIN = false;
    bf16_t *Ya, *Yb, *Yc; const bf16_t* P; const float* lse;
    __device__ __forceinline__ void operator()(const f32x4 (&acc)[2][2][4][2], const pg8::Unit& u, int wr, int wc, int fr, int fq) const {
        EPI_LOOP_BEGIN
            float sl[8];
            sl[0] = v0[0] * fast_sigmoid(v0[0]); sl[1] = v0[1] * fast_sigmoid(v0[1]); sl[2] = v0[2] * fast_sigmoid(v0[2]); sl[3] = v0[3] * fast_sigmoid(v0[3]);
            sl[4] = v1[0] * fast_sigmoid(v1[0]); sl[5] = v1[1] * fast_sigmoid(v1[1]); sl[6] = v1[2] * fast_sigmoid(v1[2]); sl[7] = v1[3] * fast_sigmoid(v1[3]);
            float raw[8]; bf16_t* dst;
            if (u.pn < 2) {
                const int slot = col >> 7;
                const float l0 = lse[((size_t)0 * T + row) * 4 + slot], l1 = lse[((size_t)1 * T + row) * 4 + slot], l2 = lse[((size_t)2 * T + row) * 4 + slot];
                const float mx = fmaxf(l0, fmaxf(l1, l2)); float e0 = __expf(l0 - mx), e1 = __expf(l1 - mx), e2 = __expf(l2 - mx);
                const float inv = 1.0f / (e0 + e1 + e2); e0 *= inv; e1 *= inv; e2 *= inv;
                const u32x4 a = *(const u32x4*)(P + (size_t)row * PC + col), b = *(const u32x4*)(P + (size_t)row * PC + 512 + col), c = *(const u32x4*)(P + (size_t)row * PC + 1024 + col);
#define MIX(i, fld, hi) raw[i] = e0 * __builtin_bit_cast(float, hi ? (a.fld & 0xffff0000u) : (a.fld << 16)) + e1 * __builtin_bit_cast(float, hi ? (b.fld & 0xffff0000u) : (b.fld << 16)) + e2 * __builtin_bit_cast(float, hi ? (c.fld & 0xffff0000u) : (c.fld << 16))
                MIX(0, x, 0); MIX(1, x, 1); MIX(2, y, 0); MIX(3, y, 1); MIX(4, z, 0); MIX(5, z, 1); MIX(6, w, 0); MIX(7, w, 1);
#undef MIX
                dst = Ya + (size_t)row * 512 + col;
            } else {
                dst = (u.pn < 6) ? (Yb + (size_t)row * 1024 + (col - 512)) : (Yc + (size_t)row * 1024 + (col - 1536));
                const u32x4 a = *(const u32x4*)dst;
                raw[0] = __builtin_bit_cast(float, a.x << 16); raw[1] = __builtin_bit_cast(float, a.x & 0xffff0000u);
                raw[2] = __builtin_bit_cast(float, a.y << 16); raw[3] = __builtin_bit_cast(float, a.y & 0xffff0000u);
                raw[4] = __builtin_bit_cast(float, a.z << 16); raw[5] = __builtin_bit_cast(float, a.z & 0xffff0000u);
                raw[6] = __builtin_bit_cast(float, a.w << 16); raw[7] = __builtin_bit_cast(float, a.w & 0xffff0000u);
            }
            u32x4 w; w.x = pk2(raw[0] * sl[0], raw[1] * sl[1]); w.y = pk2(raw[2] * sl[2], raw[3] * sl[3]); w.z = pk2(raw[4] * sl[4], raw[5] * sl[5]); w.w = pk2(raw[6] * sl[6], raw[7] * sl[7]);
            *(u32x4*)dst = w;
        EPI_LOOP_END
    }
};

constexpr int KP = 136;
__device__ __forceinline__ bf16x8 rope8(bf16x8 v, bf16x8 pt, int pos, int c, const float2* rope) {
    const float2* rp = rope + (size_t)pos * 16 + (c & 1) * 8; const float sgn = (c < 2) ? -1.f : 1.f;
    u32x4 r; float o[8];
#pragma unroll
    for (int i = 0; i < 8; ++i) { const float2 cs = rp[i]; o[i] = bf2f_s(v[i]) * cs.x + sgn * bf2f_s(pt[i]) * cs.y; }
    r.x = pk2(o[0], o[1]); r.y = pk2(o[2], o[3]); r.z = pk2(o[4], o[5]); r.w = pk2(o[6], o[7]);
    return __builtin_bit_cast(bf16x8, r);
}
template <int NKK, int NKV, int VP>
__device__ __forceinline__ void stage_kv(const bf16_t* Kg, const bf16_t* Vg, long tok0, int dil, int phase, int kbase, int L, const float2* rope, LAS bf16_t* Ks, LAS bf16_t* Vt, int tid) {
    for (int task = tid; task < NKK * 16; task += NTHREADS) {
        const int row = task >> 4, c = task & 15; const int ki = kbase + row;
        bf16x8 v = (bf16x8){0, 0, 0, 0, 0, 0, 0, 0};
        if (ki >= 0 && ki < L) { const bf16_t* rp = Kg + (size_t)(tok0 + (long)ki * dil) * PC;
            v = *(const bf16x8*)(rp + c * 8);
            if (c < 4) { const bf16x8 pt = *(const bf16x8*)(rp + (c ^ 2) * 8); v = rope8(v, pt, ki * dil + phase, c, rope); } }
        *(LAS bf16x8*)(Ks + row * KP + c * 8) = v;
    }
    const int wave = tid >> 6, lane = tid & 63;
    for (int it = wave; it < (NKV / 16) * 4; it += 8) {
        const int row = (it >> 2) * 16 + (lane & 15), c = (it & 3) * 4 + (lane >> 4); const int ki = kbase + row;
        bf16x8 v = (bf16x8){0, 0, 0, 0, 0, 0, 0, 0};
        if (ki >= 0 && ki < L) v = *(const bf16x8*)(Vg + (size_t)(tok0 + (long)ki * dil) * PC + c * 8);
#pragma unroll
        for (int i = 0; i < 8; ++i) Vt[(c * 8 + i) * VP + row] = (bf16_t)v[i];
    }
}
template <int NT, int VP>
__device__ __forceinline__ void attn_wave(const LAS bf16_t* Ks, const LAS bf16_t* Vt, int kt0, const bf16x8 (&qf)[4], int qi, int kbase, int L, int hw,
                                          bool has_sink, float sink, f32x4 (&o)[8], float& lse_out, int lane) {
    const int lr = lane & 15, lq = lane >> 4;
    f32x4 s[NT];
#pragma unroll
    for (int kt = 0; kt < NT; ++kt) { f32x4 a = (f32x4){0.f, 0.f, 0.f, 0.f}; const LAS bf16_t* kp = Ks + (kt0 + 16 * kt + lr) * KP + lq * 8;
#pragma unroll
        for (int ks = 0; ks < 4; ++ks) a = mfma16(*(const LAS bf16x8*)(kp + ks * 32), qf[ks], a);
        s[kt] = a; }
    const float scale = 0.08838834764831845f;
    float m = -INFINITY;
#pragma unroll
    for (int kt = 0; kt < NT; ++kt)
#pragma unroll
        for (int j = 0; j < 4; ++j) { const int ki = kbase + kt0 + 16 * kt + lq * 4 + j; const int rel = ki - qi;
            const bool ok = (ki >= 0) && (ki < L) && (rel <= hw) && (rel >= -hw);
            const float v = ok ? s[kt][j] * scale : -INFINITY; s[kt][j] = v; m = fmaxf(m, v); }
    m = fmaxf(m, __shfl_xor(m, 16)); m = fmaxf(m, __shfl_xor(m, 32));
    if (has_sink) m = fmaxf(m, sink);
    float den = 0.f;
#pragma unroll
    for (int kt = 0; kt < NT; ++kt)
#pragma unroll
        for (int j = 0; j < 4; ++j) { const float p = __expf(s[kt][j] - m); s[kt][j] = p; den += p; }
    den += __shfl_xor(den, 16); den += __shfl_xor(den, 32);
    if (has_sink) den += __expf(sink - m);
#pragma unroll
    for (int dt = 0; dt < 8; ++dt) o[dt] = (f32x4){0.f, 0.f, 0.f, 0.f};
#pragma unroll
    for (int t = 0; t < NT / 2; ++t) {
        u32x4 pw; pw.x = pk2(s[2 * t][0], s[2 * t][1]); pw.y = pk2(s[2 * t][2], s[2 * t][3]); pw.z = pk2(s[2 * t + 1][0], s[2 * t + 1][1]); pw.w = pk2(s[2 * t + 1][2], s[2 * t + 1][3]);
        const bf16x8 p = __builtin_bit_cast(bf16x8, pw);
#pragma unroll
        for (int dt = 0; dt < 8; ++dt) { const LAS bf16_t* vp = Vt + (dt * 16 + lr) * VP + kt0 + 32 * t + lq * 4;
            const u32x2 a0 = *(const LAS u32x2*)vp, a1 = *(const LAS u32x2*)(vp + 16);
            u32x4 aw; aw.x = a0.x; aw.y = a0.y; aw.z = a1.x; aw.w = a1.y;
            o[dt] = mfma16(__builtin_bit_cast(bf16x8, aw), p, o[dt]); }
    }
    const float inv = 1.0f / den;
#pragma unroll
    for (int dt = 0; dt < 8; ++dt) o[dt] = o[dt] * inv;
    lse_out = m + __logf(den);
}
__device__ __forceinline__ void load_q(const bf16_t* qrow, int pos, const float2* rope, bf16x8 (&qf)[4], int lq) {
#pragma unroll
    for (int ks = 0; ks < 4; ++ks) qf[ks] = *(const bf16x8*)(qrow + ks * 32 + lq * 8);
    const bf16x8 pt = *(const bf16x8*)(qrow + (lq ^ 2) * 8);
    qf[0] = rope8(qf[0], pt, pos, lq, rope);
}
constexpr int A_NK = 272, A_VP = 280, B_NKK = 288, B_NKV = 304, B_VP = 312;
__device__ __forceinline__ void attnA_unit(int u, bf16_t* P, const float2* rope, float* lse, LAS unsigned char* lds, int tid) {
    const int b = u / 1536, r = u % 1536, g = r >> 9, r2 = r & 511, slot = r2 >> 7, blk = r2 & 127;
    const int sh = 2 * g, dil = 1 << sh, nbp = 128 >> sh, phase = blk / nbp, jb = blk % nbp, L = S >> sh, head = g * 4 + slot;
    const long tok0 = (long)b * S + phase; const int kbase = jb * 128 - 64;
    LAS bf16_t* Ks = (LAS bf16_t*)lds; LAS bf16_t* Vt = (LAS bf16_t*)(lds + A_NK * KP * 2);
    stage_kv<A_NK, A_NK, A_VP>(P + PA_K + head * 128, P + PA_V + head * 128, tok0, dil, phase, kbase, L, rope, Ks, Vt, tid);
    __syncthreads();
    const int w = tid >> 6, lane = tid & 63, lr = lane & 15, lq = lane >> 4;
    const int qi = jb * 128 + 16 * w + lr; const long token = tok0 + (long)qi * dil;
    bf16_t* qrow = P + (size_t)token * PC + PA_Q + head * 128;
    bf16x8 qf[4]; load_q(qrow, qi * dil + phase, rope, qf, lq);
    f32x4 o[8]; float lv;
    attn_wave<10, A_VP>(Ks, Vt, 16 * w, qf, qi, kbase, L, 64, false, 0.f, o, lv, lane);
#pragma unroll
    for (int dt = 0; dt < 8; ++dt) { u32x2 wv; wv.x = pk2(o[dt][0], o[dt][1]); wv.y = pk2(o[dt][2], o[dt][3]); *(u32x2*)(qrow + dt * 16 + lq * 4) = wv; }
    if (lq == 0) lse[((size_t)g * T + token) * 4 + slot] = lv;
    __syncthreads();
}
__device__ __forceinline__ void attnB_unit(int u, bf16_t* P, bf16_t* Yb, const float2* rope, const float* sinks, LAS unsigned char* lds, int tid) {
    const int b = u >> 10, r = u & 1023, kvh = r >> 9, blk = r & 511;
    const long tok0 = (long)b * S; const int kbase = blk * 32 - 128;
    LAS bf16_t* Ks = (LAS bf16_t*)lds; LAS bf16_t* Vt = (LAS bf16_t*)(lds + B_NKK * KP * 2);
    stage_kv<B_NKK, B_NKV, B_VP>(P + PB_K + kvh * 128, P + PB_V + kvh * 128, tok0, 1, 0, kbase, S, rope, Ks, Vt, tid);
    __syncthreads();
    const int w = tid >> 6, lane = tid & 63, lr = lane & 15, lq = lane >> 4;
    const int head = kvh * 4 + (w >> 1), rg = w & 1;
    const int qi = blk * 32 + 16 * rg + lr; const long token = tok0 + qi;
    const bf16_t* qrow = P + (size_t)token * PC + PB_Q + head * 128;
    bf16x8 qf[4]; load_q(qrow, qi, rope, qf, lq);
    f32x4 o[8]; float lv;
    attn_wave<18, B_VP>(Ks, Vt, 16 * rg, qf, qi, kbase, S, 128, true, sinks[head], o, lv, lane);
    bf16_t* orow = Yb + (size_t)token * 1024 + head * 128;
#pragma unroll
    for (int dt = 0; dt < 8; ++dt) { u32x2 wv; wv.x = pk2(o[dt][0], o[dt][1]); wv.y = pk2(o[dt][2], o[dt][3]); *(u32x2*)(orow + dt * 16 + lq * 4) = wv; }
    __syncthreads();
}

constexpr int H_QT = 0, H_KT = 17408, H_QH = 34816, H_KHT = 52224, H_VT = 70656, H_ST = 89088, H_SC = 123904, H_QS = 133120, H_DEC = 135168;
__device__ __forceinline__ void hgrn_unit(int b, int h, int seg, int dir, int mode, bf16_t* P, const float* lb, float* SUM, float* LSUM, LAS unsigned char* lds, int tid) {
    const int w = tid >> 6, lane = tid & 63, lr = lane & 15, lq = lane >> 4;
    const int k = tid & 127, tq = tid >> 7;
    LAS bf16_t* Qt = (LAS bf16_t*)(lds + H_QT); LAS bf16_t* Kt = (LAS bf16_t*)(lds + H_KT); LAS bf16_t* Qh = (LAS bf16_t*)(lds + H_QH);
    LAS bf16_t* KhT = (LAS bf16_t*)(lds + H_KHT); LAS bf16_t* VT = (LAS bf16_t*)(lds + H_VT); LAS bf16_t* ST = (LAS bf16_t*)(lds + H_ST);
    LAS bf16_t* Sc = (LAS bf16_t*)(lds + H_SC); LAS float* QS = (LAS float*)(lds + H_QS); LAS float* DEC = (LAS float*)(lds + H_DEC);
    const float lbv = lb[h * 128 + k], oml = 1.0f - lbv;
    f32x4 Sacc[8];
#pragma unroll
    for (int vt = 0; vt < 8; ++vt) Sacc[vt] = (f32x4){0.f, 0.f, 0.f, 0.f};
    float lsum = 0.f;
    const int chain = ((b * 8 + h) * 2 + dir) * 16;
    if (mode == 1) {
        const int nprev = dir ? 15 - seg : seg;
        for (int jj = 0; jj < nprev; ++jj) { const int su = chain + (dir ? 15 - jj : jj);
            const float* sp = SUM + (size_t)su * 16384; const float* lp = LSUM + su * 128 + 16 * w + lq * 4;
            const f32x4 lv = *(const f32x4*)lp; f32x4 dv; dv.x = __expf(lv.x); dv.y = __expf(lv.y); dv.z = __expf(lv.z); dv.w = __expf(lv.w);
#pragma unroll
            for (int vt = 0; vt < 8; ++vt) { const f32x4 x = *(const f32x4*)(sp + ((w * 8 + vt) * 64 + lane) * 4); Sacc[vt] = Sacc[vt] * dv + x; } }
    }
    const bf16_t* fbase = P + (dir ? PC_FB : PC_FF) + h * 128 + k;
    for (int cc = 0; cc < 16; ++cc) {
        const int c = seg * 16 + (dir ? 15 - cc : cc); const long btok = (long)b * S + c * 64;
        float lf[16], kk[16];
#pragma unroll
        for (int ii = 0; ii < 16; ++ii) { const int i = tq * 16 + ii; const long tok = btok + (dir ? 63 - i : i);
            const float fz = bf2f(fbase[(size_t)tok * PC]); const float e = __expf(-fz), sg = __builtin_amdgcn_rcpf(1.0f + e);
            lf[ii] = __logf(lbv + oml * sg); kk[ii] = oml * e * sg; }
#pragma unroll
        for (int ii = 1; ii < 16; ++ii) lf[ii] += lf[ii - 1];
        QS[tq * 128 + k] = lf[15];
        __syncthreads();
        const float q0 = QS[k], q1 = QS[128 + k], q2 = QS[256 + k], q3 = QS[384 + k];
        const float off = (tq > 0 ? q0 : 0.f) + (tq > 1 ? q1 : 0.f) + (tq > 2 ? q2 : 0.f);
        const float rref = q0 + q1, bl = (q0 + q1) + (q2 + q3);
        if (tq == 0) { DEC[k] = __expf(bl); lsum += bl; }
        u32x4 kh0, kh1, vv0, vv1;
        {
            float khat[16]; unsigned short vraw[16];
#pragma unroll
            for (int ii = 0; ii < 16; ++ii) { const int i = tq * 16 + ii; const long tok = btok + (dir ? 63 - i : i); const float bt = off + lf[ii];
                khat[ii] = kk[ii] * __expf(bl - bt);
                vraw[ii] = P[(size_t)tok * PC + PC_I + h * 128 + k];
                if (mode == 1) { const float qv = bf2f(P[(size_t)tok * PC + PC_Q + h * 128 + k]); const float qh = qv * fast_sigmoid(qv);
                    const float eq = __expf(fminf(bt - rref, 80.f)), ek = __expf(fminf(rref - bt, 80.f));
                    Qt[i * KP + k] = (bf16_t)(pk2(qh * eq, 0.f) & 0xffffu); Kt[i * KP + k] = (bf16_t)(pk2(kk[ii] * ek, 0.f) & 0xffffu); Qh[i * KP + k] = (bf16_t)(pk2(qh * __expf(bt), 0.f) & 0xffffu); } }
            kh0.x = pk2(khat[0], khat[1]); kh0.y = pk2(khat[2], khat[3]); kh0.z = pk2(khat[4], khat[5]); kh0.w = pk2(khat[6], khat[7]);
            kh1.x = pk2(khat[8], khat[9]); kh1.y = pk2(khat[10], khat[11]); kh1.z = pk2(khat[12], khat[13]); kh1.w = pk2(khat[14], khat[15]);
            vv0.x = vraw[0] | ((unsigned)vraw[1] << 16); vv0.y = vraw[2] | ((unsigned)vraw[3] << 16); vv0.z = vraw[4] | ((unsigned)vraw[5] << 16); vv0.w = vraw[6] | ((unsigned)vraw[7] << 16);
            vv1.x = vraw[8] | ((unsigned)vraw[9] << 16); vv1.y = vraw[10] | ((unsigned)vraw[11] << 16); vv1.z = vraw[12] | ((unsigned)vraw[13] << 16); vv1.w = vraw[14] | ((unsigned)vraw[15] << 16);
        }
        *(LAS u32x4*)(KhT + k * 72 + tq * 16) = kh0; *(LAS u32x4*)(KhT + k * 72 + tq * 16 + 8) = kh1;
        *(LAS u32x4*)(VT + k * 72 + tq * 16) = vv0; *(LAS u32x4*)(VT + k * 72 + tq * 16 + 8) = vv1;
        if (mode == 1) {
#pragma unroll
            for (int vt = 0; vt < 8; ++vt) { u32x2 sv; sv.x = pk2(Sacc[vt][0], Sacc[vt][1]); sv.y = pk2(Sacc[vt][2], Sacc[vt][3]); *(LAS u32x2*)(ST + (16 * vt + lr) * KP + 16 * w + lq * 4) = sv; }
        }
        __syncthreads();
        if (mode == 1) {
#pragma unroll
            for (int e = 0; e < 2; ++e) { const int ti = 2 * w + e, st = ti >> 2, tt = ti & 3;
                f32x4 a = (f32x4){0.f, 0.f, 0.f, 0.f};
                if (st <= tt) {
#pragma unroll
                    for (int ks = 0; ks < 4; ++ks) a = mfma16(*(const LAS bf16x8*)(Kt + (16 * st + lr) * KP + ks * 32 + lq * 8), *(const LAS bf16x8*)(Qt + (16 * tt + lr) * KP + ks * 32 + lq * 8), a);
                }
                const int t = 16 * tt + lr, s0 = 16 * st + lq * 4;
                float x0 = (t >= s0 && st <= tt) ? a[0] : 0.f, x1 = (t >= s0 + 1 && st <= tt) ? a[1] : 0.f, x2 = (t >= s0 + 2 && st <= tt) ? a[2] : 0.f, x3 = (t >= s0 + 3 && st <= tt) ? a[3] : 0.f;
                u32x2 sv; sv.x = pk2(x0, x1); sv.y = pk2(x2, x3); *(LAS u32x2*)(Sc + t * 72 + s0) = sv; }
            __syncthreads();
            const int tt = w & 3, vh = w >> 2;
            bf16x8 scf[2], qhf[4];
#pragma unroll
            for (int ks = 0; ks < 2; ++ks) scf[ks] = *(const LAS bf16x8*)(Sc + (16 * tt + lr) * 72 + ks * 32 + lq * 8);
#pragma unroll
            for (int ks = 0; ks < 4; ++ks) qhf[ks] = *(const LAS bf16x8*)(Qh + (16 * tt + lr) * KP + ks * 32 + lq * 8);
            const int il = 16 * tt + lr; const long tok = btok + (dir ? 63 - il : il);
#pragma unroll
            for (int vi = 0; vi < 4; ++vi) { const int vt = vh * 4 + vi; f32x4 a = (f32x4){0.f, 0.f, 0.f, 0.f};
#pragma unroll
                for (int ks = 0; ks < 2; ++ks) a = mfma16(*(const LAS bf16x8*)(VT + (16 * vt + lr) * 72 + ks * 32 + lq * 8), scf[ks], a);
#pragma unroll
                for (int ks = 0; ks < 4; ++ks) a = mfma16(*(const LAS bf16x8*)(ST + (16 * vt + lr) * KP + ks * 32 + lq * 8), qhf[ks], a);
                bf16_t* of = P + (size_t)tok * PC + PC_FF + h * 128 + 16 * vt + lq * 4;
                if (dir == 0) { u32x2 sv; sv.x = pk2(a[0], a[1]); sv.y = pk2(a[2], a[3]); *(u32x2*)of = sv; }
                else { const u32x2 pv = *(const u32x2*)of;
                    a[0] += __builtin_bit_cast(float, pv.x << 16); a[1] += __builtin_bit_cast(float, pv.x & 0xffff0000u); a[2] += __builtin_bit_cast(float, pv.y << 16); a[3] += __builtin_bit_cast(float, pv.y & 0xffff0000u);
                    u32x2 sv; sv.x = pk2(a[0], a[1]); sv.y = pk2(a[2], a[3]); *(u32x2*)(P + (size_t)tok * PC + PC_FB + h * 128 + 16 * vt + lq * 4) = sv; } }
        }
        { const f32x4 dv = *(const LAS f32x4*)(DEC + 16 * w + lq * 4);
          bf16x8 af[2];
#pragma unroll
          for (int ks = 0; ks < 2; ++ks) af[ks] = *(const LAS bf16x8*)(KhT + (16 * w + lr) * 72 + ks * 32 + lq * 8);
#pragma unroll
          for (int vt = 0; vt < 8; ++vt) { f32x4 a = Sacc[vt] * dv;
#pragma unroll
              for (int ks = 0; ks < 2; ++ks) a = mfma16(af[ks], *(const LAS bf16x8*)(VT + (16 * vt + lr) * 72 + ks * 32 + lq * 8), a);
              Sacc[vt] = a; } }
        __syncthreads();
    }
    if (mode == 0) { const int su = chain + seg; float* sp = SUM + (size_t)su * 16384;
#pragma unroll
        for (int vt = 0; vt < 8; ++vt) *(f32x4*)(sp + ((w * 8 + vt) * 64 + lane) * 4) = Sacc[vt];
        if (tq == 0) LSUM[su * 128 + k] = lsum; }
}
__device__ __forceinline__ void hgrn_full_unit(int u, bf16_t* P, const float* lb, const float* hnorm, float* SUM, float* LSUM, bf16_t* Yc, LAS unsigned char* lds, int tid) {
    const int b = u >> 7, h = (u >> 4) & 7, seg = u & 15;
    hgrn_unit(b, h, seg, 0, 1, P, lb, SUM, LSUM, lds, tid);
    __threadfence(); __syncthreads();
#if defined(PROBE_HG) && PROBE_HG == 1
    return;
#endif
    hgrn_unit(b, h, seg, 1, 1, P, lb, SUM, LSUM, lds, tid);
    __threadfence(); __syncthreads();
#if defined(PROBE_HG) && PROBE_HG == 2
    return;
#endif
    const int w = tid >> 6, lane = tid & 63;
    const float g0 = hnorm[h * 128 + 2 * lane], g1 = hnorm[h * 128 + 2 * lane + 1];
    for (int r = w; r < 1024; r += 8) { const long tok = (long)b * S + seg * 1024 + r;
        const unsigned pv = *(const unsigned*)(P + (size_t)tok * PC + PC_FB + h * 128 + 2 * lane);
        const float x0 = __builtin_bit_cast(float, pv << 16), x1 = __builtin_bit_cast(float, pv & 0xffff0000u);
        const float ss = wave_sum(x0 * x0 + x1 * x1); const float rs = 1.0f / sqrtf(ss * (1.0f / 128.f) + NORM_EPS);
        *(unsigned*)(Yc + (size_t)tok * 1024 + h * 128 + 2 * lane) = pk2(x0 * rs * g0, x1 * rs * g1); }
    __syncthreads();
}

struct Args { const float* in[11]; float* out; unsigned char* ws; int ph_lo, ph_hi; };
#define DERIVE_PTRS \
    int tid = threadIdx.x; asm volatile("" : "+v"(tid)); const int lane = tid & 63, wave = __builtin_amdgcn_readfirstlane(tid >> 6); \
    int G = gridDim.x, bx = blockIdx.x; asm volatile("" : "+s"(G), "+s"(bx)); \
    const int gw = bx * 8 + wave, NGW = G * 8; \
    unsigned char* ws = args.ws; asm volatile("" : "+s"(ws)); \
    const float* x0 = args.in[0]; const float* pre_norm = args.in[1]; const float* post_norm = args.in[2]; const float* sink_logits = args.in[4]; \
    const float* hlb = args.in[5]; const float* hnorm = args.in[6]; float* outp = args.out; \
    asm volatile("" : "+s"(x0), "+s"(pre_norm), "+s"(post_norm), "+s"(sink_logits), "+s"(hlb), "+s"(hnorm), "+s"(outp)); \
    float2* rope = (float2*)(ws + WS_ROPE); float* lse = (float*)(ws + WS_LSE); float* LB = (float*)(ws + WS_LB); float* LSUM = (float*)(ws + WS_LSUM); \
    bf16_t* WinT = (bf16_t*)(ws + WS_WIN); bf16_t* WaT = (bf16_t*)(ws + WS_WA); bf16_t* WbT = (bf16_t*)(ws + WS_WB); bf16_t* WcT = (bf16_t*)(ws + WS_WC); bf16_t* WoT = (bf16_t*)(ws + WS_WO); \
    bf16_t* XN = (bf16_t*)(ws + WS_XN); bf16_t* Ya = (bf16_t*)(ws + WS_YA); bf16_t* Yb = (bf16_t*)(ws + WS_YB); bf16_t* Yc = (bf16_t*)(ws + WS_YC); \
    float* SUM = (float*)(ws + WS_SUM); bf16_t* P = (bf16_t*)(ws + WS_P); bf16_t* Gm = (bf16_t*)(ws + WS_G); bf16_t* YM = (bf16_t*)(ws + WS_YM); float* OUT = (float*)(ws + WS_OUT); \
    (void)tid; (void)lane; (void)gw; (void)NGW; (void)x0; (void)pre_norm; (void)post_norm; (void)sink_logits; (void)hlb; (void)hnorm; (void)outp; (void)rope; (void)lse; (void)LB; (void)LSUM; \
    (void)WinT; (void)WaT; (void)WbT; (void)WcT; (void)WoT; (void)XN; (void)Ya; (void)Yb; (void)Yc; (void)SUM; (void)P; (void)Gm; (void)YM; (void)OUT;
#define IN(k) (args.ph_lo <= (k) && (k) < args.ph_hi)
#define GRID_SYNC(k) do { if (IN(k) && IN((k) + 1)) cg::this_grid().sync(); } while (0)
template <int layer> __device__ __forceinline__ void run_layer(const Args& args, LAS unsigned char* lds) {
#ifndef SKIP_P1
        if (IN(1 + 8 * layer + 0)) { DERIVE_PTRS pg8::Gemm g{XN, WinT, T, PC, D}; pg8::StaticOrder So; So.init(T, PC, G, bx); EpiStoreBf16 E{P, PC};
          pg8::gemm_phase<EpiStoreBf16, pg8::StaticOrder, true, true>(lds, g, So, E); }
#endif
        GRID_SYNC(1 + 8 * layer + 0);
#ifndef SKIP_P2
        if (IN(1 + 8 * layer + 1)) { DERIVE_PTRS const float* lbL = LB + layer * 1024;
          for (int u = bx; u < 512; u += G) { const int dir = u & 1, seg = (u >> 1) & 15, h = (u >> 5) & 7, b = u >> 8; hgrn_unit(b, h, seg, dir, 0, P, lbL, SUM, LSUM, lds, tid); }
          __syncthreads();
          for (int u = bx; u < 3072; u += G) attnA_unit(u, P, rope, lse, lds, tid);
          for (int u = bx; u < 2048; u += G) attnB_unit(u, P, Yb, rope, sink_logits + layer * 8, lds, tid); }
#endif
        GRID_SYNC(1 + 8 * layer + 1);
#ifndef SKIP_P3
        if (IN(1 + 8 * layer + 2)) { DERIVE_PTRS for (int u = bx; u < 256; u += G) hgrn_full_unit(u, P, LB + layer * 1024, hnorm + layer * 1024, SUM, LSUM, Yc, lds, tid); }
#endif
        GRID_SYNC(1 + 8 * layer + 2);
#ifndef SKIP_P4
        if (IN(1 + 8 * layer + 3)) { DERIVE_PTRS pg8::Gemm g{XN, WinT + (size_t)PC * D, T, NGATE, D}; pg8::StaticOrder So; So.init(T, NGATE, G, bx); EpiGate E{Ya, Yb, Yc, P, lse};
          pg8::gemm_phase<EpiGate, pg8::StaticOrder, true, true>(lds, g, So, E); }
#endif
        GRID_SYNC(1 + 8 * layer + 3);
#ifndef SKIP_P5
        if (IN(1 + 8 * layer + 4)) { DERIVE_PTRS pg8::Gemm g{XN, WinT + (size_t)(PC + NGATE) * D, T, NMERGE, D}; pg8::StaticOrder So; So.init(T, NMERGE, G, bx); EpiSigmoidBf16 E{Gm, NMERGE};
          pg8::gemm_phase<EpiSigmoidBf16, pg8::StaticOrder, true, true>(lds, g, So, E); }
#endif
        GRID_SYNC(1 + 8 * layer + 4);
#ifndef SKIP_P6
        if (IN(1 + 8 * layer + 5)) { DERIVE_PTRS pg8::StaticOrder So; So.init(T, D, G, bx);
          { pg8::Gemm g{Ya, WaT, T, D, 512}; EpiBranch<true> E{YM, Gm, 0}; pg8::gemm_phase<EpiBranch<true>, pg8::StaticOrder, true, true>(lds, g, So, E); }
          { pg8::Gemm g{Yb, WbT, T, D, 1024}; EpiBranch<false> E{YM, Gm, 1}; pg8::gemm_phase<EpiBranch<false>, pg8::StaticOrder, true, true>(lds, g, So, E); }
          { pg8::Gemm g{Yc, WcT, T, D, 1024}; EpiBranch<false> E{YM, Gm, 2}; pg8::gemm_phase<EpiBranch<false>, pg8::StaticOrder, true, true>(lds, g, So, E); } }
#endif
        GRID_SYNC(1 + 8 * layer + 5);
#ifndef SKIP_P7
        if (IN(1 + 8 * layer + 6)) { DERIVE_PTRS pg8::Gemm g{YM, WoT, T, D, D}; pg8::StaticOrder So; So.init(T, D, G, bx); EpiStoreF32 E{OUT, D};
          pg8::gemm_phase<EpiStoreF32, pg8::StaticOrder, true, true>(lds, g, So, E); }
#endif
        GRID_SYNC(1 + 8 * layer + 6);
        if (IN(1 + 8 * layer + 7)) { DERIVE_PTRS const float* xold = layer == 0 ? x0 : outp;
          for (int m = gw; m < T; m += NGW) final_row(OUT + (size_t)m * D, post_norm + layer * D, xold + (size_t)m * D, outp + (size_t)m * D,
                                                     layer == 0 ? pre_norm + D : nullptr, layer == 0 ? XN + (size_t)m * D : nullptr, lane);
          if (layer == 0) { Weights Wt{args.in[3] + (size_t)D * NIN, args.in[7] + (size_t)512 * D, args.in[8] + (size_t)1024 * D, args.in[9] + (size_t)1024 * D, args.in[10] + (size_t)D * D};
              __syncthreads(); transpose_weights(Wt, ws, lds, gw, NGW, wave, lane); GRID_SYNC(1 + 8 * layer + 7); } }
}
__global__ void __launch_bounds__(NTHREADS, 2) fwd_megakernel(Args args) {
    extern __shared__ __attribute__((aligned(16))) unsigned char lds_raw[];
    LAS unsigned char* lds = (LAS unsigned char*)lds_raw;
    if (IN(0)) { DERIVE_PTRS
    for (int i = bx * NTHREADS + tid; i < S * 16; i += G * NTHREADS) { const int pos = i >> 4, j = i & 15;
        const float inv = exp2f(-(float)j * (18.931568569324174f / 16.0f)); const float ang = (float)pos * inv;
        const double rev = (double)ang * 0.15915494309189535; const float fr = (float)(rev - floor(rev));
        rope[i] = make_float2(__builtin_amdgcn_cosf(fr), __builtin_amdgcn_sinf(fr)); }
    for (int i = bx * NTHREADS + tid; i < 1024; i += G * NTHREADS) { const float h0 = hlb[i], h1 = hlb[1024 + i]; const float mx = fmaxf(h0, h1);
        const float e0 = expf(h0 - mx), e1 = expf(h1 - mx); LB[i] = 0.f; LB[1024 + i] = e1 / (e0 + e1); }
    { Weights Wt{args.in[3], args.in[7], args.in[8], args.in[9], args.in[10]}; transpose_weights(Wt, ws, lds, gw, NGW, wave, lane); }
    for (int m = gw; m < T; m += NGW) prenorm_row(x0 + (size_t)m * D, pre_norm, XN + (size_t)m * D, lane);
    }
    GRID_SYNC(0);

    run_layer<0>(args, lds);
#if NLAYER > 1
    run_layer<1>(args, lds);
#endif
}

__global__ void dump_bf16(const bf16_t* src, size_t pitch, float* out) {
    const size_t i = (size_t)blockIdx.x * blockDim.x + threadIdx.x; const size_t r = i / 2048, c = i % 2048;
    out[i] = bf2f(src[r * pitch + c]);
}
__global__ void dump_f32(const float* src, float* out) { const size_t i = (size_t)blockIdx.x * blockDim.x + threadIdx.x; out[i] = src[i]; }
__global__ void dump_mix(const unsigned char* ws, float* out) {
    const size_t i = (size_t)blockIdx.x * blockDim.x + threadIdx.x; const size_t r = i / 2048, c = i % 2048;
    const bf16_t* P = (const bf16_t*)(ws + WS_P); const bf16_t* Yb = (const bf16_t*)(ws + WS_YB); const bf16_t* Yc = (const bf16_t*)(ws + WS_YC); const float* SUM = (const float*)(ws + WS_SUM); const float* lse = (const float*)(ws + WS_LSE);
    float v = 0.f;
#if PROBE_SEL & 1
    v += bf2f(P[r * PC + c]);
#endif
#if PROBE_SEL & 2
    v += bf2f(Yb[r * 1024 + (c & 1023)]);
#endif
#if PROBE_SEL & 4
    v += SUM[i % ((size_t)512 * 16384)];
#endif
#if PROBE_SEL & 8
    v += lse[i % ((size_t)3 * T * 4)];
#endif
#if PROBE_SEL & 16
    v += bf2f(Yc[r * 1024 + (c & 1023)]);
#endif
#if PROBE_SEL & 32
    v += bf2f(P[r * PC + PC_FF + (c & 1023)]);
#endif
#if PROBE_SEL & 64
    v += bf2f(P[r * PC + PC_FB + (c & 1023)]);
#endif
    if (!(v == v) || fabsf(v) > 1e30f) v = 12345.f;
    out[i] = v;
}
extern "C" void kernel_launch(void* const* d_in, const int* in_sizes, int n_in, void* d_out, int out_size, void* d_ws, size_t ws_size, hipStream_t stream) {
    static int grid = 0;
    if (grid == 0) {
        if (n_in != 11 || ws_size < WS_END) { fprintf(stderr, "kernel_launch: unexpected inputs (n_in %d, ws %zu)\n", n_in, ws_size); grid = -1; return; }
        int dev = 0, cus = 0, per_cu = 0;
        hipGetDevice(&dev); hipDeviceGetAttribute(&cus, hipDeviceAttributeMultiprocessorCount, dev);
        hipFuncSetAttribute((const void*)fwd_megakernel, hipFuncAttributeMaxDynamicSharedMemorySize, LDS_BYTES);
        hipOccupancyMaxActiveBlocksPerMultiprocessor(&per_cu, (const void*)fwd_megakernel, NTHREADS, LDS_BYTES);
        if (per_cu < 1) per_cu = 1;
        grid = cus * per_cu;
    }
    if (grid < 0) return;
    Args a{};
    for (int i = 0; i < 11; ++i) a.in[i] = (const float*)d_in[i];
    a.out = (float*)d_out; a.ws = (unsigned char*)d_ws;
#ifdef PROBE_PHASES
    for (int ph = 0; ph < PROBE_PHASES; ++ph) { a.ph_lo = ph; a.ph_hi = ph + 1; hipLaunchKernelGGL(fwd_megakernel, dim3(grid), dim3(NTHREADS), LDS_BYTES, stream, a); }
    PROBE_DUMP
#elif defined(MULTI_LAUNCH)
    for (int ph = 0; ph < 17; ++ph) { a.ph_lo = ph; a.ph_hi = ph + 1; hipLaunchKernelGGL(fwd_megakernel, dim3(grid), dim3(NTHREADS), LDS_BYTES, stream, a); }
#else
    a.ph_lo = 0; a.ph_hi = 17;
    void* kargs[] = {&a};
    hipError_t e = hipLaunchCooperativeKernel((const void*)fwd_megakernel, dim3(grid), dim3(NTHREADS), kargs, LDS_BYTES, stream);
    if (e != hipSuccess) fprintf(stderr, "cooperative launch failed: %s (grid %d)\n", hipGetErrorString(e), grid);
#endif
}
```

```cpp
#include <hip/hip_runtime.h>
#include <hip/hip_cooperative_groups.h>
#include <cstdio>
#include <cstdint>
namespace cg = cooperative_groups;
namespace pg8 {
#define PG8_LAS __attribute__((address_space(3)))
typedef unsigned short bf16_t;
typedef short bf16x8 __attribute__((ext_vector_type(8)));
typedef float f32x4 __attribute__((ext_vector_type(4)));
typedef unsigned u32x4 __attribute__((ext_vector_type(4)));
constexpr int BM = 256, BK = 64, HALF = 128, HTB = HALF * BK * 2  , STAGE_BYTES = 8 * HTB, NXCD = 8, WGM = 8;

__host__ __device__ __forceinline__ int lds_byte(int r, int c) { const int st = (r >> 4) * 2 + (c >> 5), rr = r & 15, cc = c & 31, ob = rr * 64 + cc * 2; return st * 1024 + (ob ^ (((ob >> 9) & 1) << 5)); }
__host__ __device__ __forceinline__ void stage_rc(int b, int& R, int& C) { const int st = b / 1024, sb = b % 1024, swz = sb ^ (((sb >> 9) & 1) << 5); R = (st >> 1) * 16 + swz / 64; C = (st & 1) * 32 + (swz % 64) / 2; }
__host__ __device__ __forceinline__ int perm32(int rho) { const int n = rho >> 4, i = rho & 15; return 8 * (i >> 2) + 4 * n + (i & 3); }

struct Unit { int pm, pn; };
struct Gemm { const bf16_t* A; const bf16_t* Bt; int M, N, K; };

struct StaticOrder {
    int nM, nN, nwg, G, c;
    __host__ __device__ void init(int M, int N, int G_, int c_) { nM = M / BM; nN = N / BM; nwg = nM * nN; G = G_; c = c_; }
    __host__ __device__ bool next(int i, Unit& u) const {
        const long L = (long)i * G + c; if (L >= nwg) return false;
        int wgid = (int)L; { const int q = nwg / NXCD, r = nwg % NXCD, xcd = wgid % NXCD, off = wgid / NXCD; wgid = (xcd < r ? xcd * (q + 1) : r * (q + 1) + (xcd - r) * q) + off; }
        const int nig = WGM * nN, gid = wgid / nig, fm = gid * WGM, gsz = (nM - fm) < WGM ? (nM - fm) : WGM;
        u.pm = fm + ((wgid % nig) % gsz); u.pn = (wgid % nig) / gsz; return true;
    }
    __device__ __forceinline__ void a_ready(const Unit&) const {}
    __device__ __forceinline__ void done(const Unit&) const {}
};

__device__ __forceinline__ unsigned cvt_pk_bf16(float lo, float hi) { unsigned r; asm volatile("v_cvt_pk_bf16_f32 %0, %1, %2" : "=v"(r) : "v"(lo), "v"(hi)); return r; }
template <class Epi, class Sched, bool ALIGN_EPI = false, bool SP2 = false>
__device__ __forceinline__ void gemm_phase(PG8_LAS unsigned char* lds, const Gemm g, const Sched& S, const Epi& E) {
    int tid = threadIdx.x; asm volatile("" : "+v"(tid));
    const int wid = __builtin_amdgcn_readfirstlane(tid >> 6), lane = tid & 63, wr = wid >> 2, wc = wid & 3, fr = lane & 15, fq = lane >> 4;
    const int K = g.K, nt = K / BK;
    unsigned voffA[2], voffB[2];
#pragma unroll
    for (int i = 0; i < 2; ++i) { int R, C; stage_rc(tid * 16 + i * 8192, R, C); const int Rb = Epi::PERM ? ((R & ~31) + perm32(R & 31)) : R;
        voffA[i] = (unsigned)(R * K + C) * 2u; voffB[i] = (unsigned)(Rb * K + C) * 2u; }
    const size_t kstep = (size_t)(BK * 2);
    const size_t hstep = (size_t)HALF * K * 2;
    const size_t tstep = 2 * hstep;
    const unsigned ldsw = (unsigned)wid * 1024u;
    const int aoff = lds_byte(wr * 64 + fr, fq * 8), boff = lds_byte(wc * 32 + fr, fq * 8);
#define PG8_SA(b, h) (((b) * 2 + (h)) * HTB)
#define PG8_SB(b, h) ((4 + (b) * 2 + (h)) * HTB)
#define PG8_STAGE(bufoff, gbase, voff) do { _Pragma("unroll") for (int _i = 0; _i < 2; ++_i) \
        __builtin_amdgcn_global_load_lds((const unsigned*)((const char*)(gbase) + (voff)[_i]), (PG8_LAS unsigned*)(lds + (bufoff) + ldsw + _i * 8192), 16, 0, 0); } while (0)
#define PG8_LDA(dst, b, h) do { _Pragma("unroll") for (int m = 0; m < 4; ++m) _Pragma("unroll") for (int k = 0; k < 2; ++k) dst[m][k] = *(const PG8_LAS bf16x8*)(lds + PG8_SA(b, h) + aoff + m * 2048 + k * 1024); } while (0)
#define PG8_LDB(dst, b, h) do { _Pragma("unroll") for (int n = 0; n < 2; ++n) _Pragma("unroll") for (int k = 0; k < 2; ++k) dst[n][k] = *(const PG8_LAS bf16x8*)(lds + PG8_SB(b, h) + boff + n * 2048 + k * 1024); } while (0)
#define PG8_MMA(ai, bj, At, Bt) do { __builtin_amdgcn_s_setprio(1); _Pragma("unroll") for (int m = 0; m < 4; ++m) _Pragma("unroll") for (int n = 0; n < 2; ++n) _Pragma("unroll") for (int k = 0; k < 2; ++k) \
        acc[ai][bj][m][n] = __builtin_amdgcn_mfma_f32_16x16x32_bf16(Bt[n][k], At[m][k], acc[ai][bj][m][n], 0, 0, 0); __builtin_amdgcn_s_setprio(0); } while (0)
#define PG8_WAIT_V(n) asm volatile("s_waitcnt vmcnt(" #n ")" ::: "memory")
#define PG8_WAIT_L(n) asm volatile("s_waitcnt lgkmcnt(" #n ")" ::: "memory")
#define PG8_BAR __builtin_amdgcn_s_barrier()
#define PG8_SCHED __builtin_amdgcn_sched_barrier(0)
    Unit cur, nxt; int ui = 0;
    if (!S.next(0, cur)) return;
    f32x4 acc[2][2][4][2];
#pragma unroll
    for (int a = 0; a < 2; ++a)
#pragma unroll
        for (int b = 0; b < 2; ++b)
#pragma unroll
            for (int m = 0; m < 4; ++m)
#pragma unroll
                for (int n = 0; n < 2; ++n) acc[a][b][m][n] = (f32x4){0.f, 0.f, 0.f, 0.f};
    bf16x8 At[4][2], B0[2][2], B1[2][2];
    const char* cA = (const char*)g.A + (size_t)cur.pm * tstep; const char* cB = (const char*)g.Bt + (size_t)cur.pn * tstep;
    S.a_ready(cur);
    if constexpr (SP2) {
        PG8_STAGE(PG8_SB(0, 0), cB, voffB); PG8_STAGE(PG8_SB(0, 1), cB + hstep, voffB); PG8_STAGE(PG8_SA(0, 0), cA, voffA); PG8_STAGE(PG8_SA(0, 1), cA + hstep, voffA);
        if (wr == 1) PG8_BAR;
        PG8_WAIT_V(2); PG8_BAR;
        PG8_STAGE(PG8_SB(1, 0), cB + kstep, voffB); PG8_STAGE(PG8_SA(1, 0), cA + kstep, voffA); PG8_STAGE(PG8_SB(1, 1), cB + hstep + kstep, voffB);
        PG8_WAIT_V(6); PG8_BAR;
    } else {
        PG8_STAGE(PG8_SB(0, 0), cB, voffB); PG8_STAGE(PG8_SA(0, 0), cA, voffA); PG8_STAGE(PG8_SB(0, 1), cB + hstep, voffB); PG8_STAGE(PG8_SA(0, 1), cA + hstep, voffA);
        if (wr == 1) PG8_BAR;
        PG8_WAIT_V(4); PG8_BAR;
        PG8_STAGE(PG8_SB(1, 0), cB + kstep, voffB); PG8_STAGE(PG8_SA(1, 0), cA + kstep, voffA); PG8_STAGE(PG8_SB(1, 1), cB + hstep + kstep, voffB);
        PG8_WAIT_V(6); PG8_BAR;
    }
    for (;;) {
        const bool has_next = S.next(ui + 1, nxt);
        const char* nA = has_next ? (const char*)g.A + (size_t)nxt.pm * tstep : cA; const char* nB = has_next ? (const char*)g.Bt + (size_t)nxt.pn * tstep : cB;
        for (int t = 0; t < nt; t += 2) {
            const bool last = (t == nt - 2);
            const char* a1 = cA + (size_t)(t + 1) * kstep;
            const char* a2 = last ? nA : cA + (size_t)(t + 2) * kstep; const char* b2 = last ? nB : cB + (size_t)(t + 2) * kstep;
            const char* a3 = a2 + kstep; const char* b3 = b2 + kstep;
            if (last && has_next) S.a_ready(nxt);
            if constexpr (SP2) {
            PG8_LDB(B0, 0, 0); PG8_LDB(B1, 0, 1); PG8_SCHED; PG8_LDA(At, 0, 0); PG8_STAGE(PG8_SA(1, 1), a1 + hstep, voffA);
            PG8_WAIT_V(8); PG8_WAIT_L(0); PG8_BAR; PG8_MMA(0, 0, At, B0); PG8_MMA(0, 1, At, B1); PG8_BAR; PG8_SCHED;
            PG8_LDA(At, 0, 1); PG8_STAGE(PG8_SB(0, 0), b2, voffB); PG8_STAGE(PG8_SB(0, 1), b2 + hstep, voffB); PG8_STAGE(PG8_SA(0, 0), a2, voffA);
            PG8_WAIT_V(8); PG8_WAIT_L(0); PG8_BAR; PG8_MMA(1, 0, At, B0); PG8_MMA(1, 1, At, B1); PG8_BAR; PG8_SCHED;
            PG8_LDB(B0, 1, 0); PG8_LDB(B1, 1, 1); PG8_SCHED; PG8_LDA(At, 1, 0); PG8_STAGE(PG8_SA(0, 1), a2 + hstep, voffA);
            PG8_WAIT_V(8); PG8_WAIT_L(0); PG8_BAR; PG8_MMA(0, 0, At, B0); PG8_MMA(0, 1, At, B1); PG8_BAR; PG8_SCHED;
            PG8_LDA(At, 1, 1); PG8_STAGE(PG8_SB(1, 0), b3, voffB); PG8_STAGE(PG8_SB(1, 1), b3 + hstep, voffB); PG8_STAGE(PG8_SA(1, 0), a3, voffA);
            PG8_WAIT_V(8); PG8_WAIT_L(0); PG8_BAR; PG8_MMA(1, 0, At, B0); PG8_MMA(1, 1, At, B1); PG8_BAR; PG8_SCHED;
            } else {
            PG8_LDB(B0, 0, 0); PG8_SCHED; PG8_LDA(At, 0, 0); PG8_STAGE(PG8_SA(1, 1), a1 + hstep, voffA);
            PG8_WAIT_L(8); PG8_BAR; PG8_WAIT_L(0); PG8_MMA(0, 0, At, B0); PG8_BAR; PG8_SCHED;
            PG8_LDB(B1, 0, 1); PG8_STAGE(PG8_SB(0, 0), b2, voffB);
            PG8_BAR; PG8_WAIT_L(0); PG8_MMA(0, 1, At, B1); PG8_BAR;
            PG8_LDA(At, 0, 1); PG8_STAGE(PG8_SA(0, 0), a2, voffA);
            PG8_BAR; PG8_WAIT_L(0); PG8_MMA(1, 0, At, B0); PG8_BAR; PG8_SCHED;
            PG8_STAGE(PG8_SB(0, 1), b2 + hstep, voffB);
            PG8_WAIT_V(6); PG8_BAR; PG8_MMA(1, 1, At, B1); PG8_BAR;
            PG8_LDB(B0, 1, 0); PG8_SCHED; PG8_LDA(At, 1, 0); PG8_STAGE(PG8_SA(0, 1), a2 + hstep, voffA);
            PG8_WAIT_L(8); PG8_BAR; PG8_WAIT_L(0); PG8_MMA(0, 0, At, B0); PG8_BAR; PG8_SCHED;
            PG8_LDB(B1, 1, 1); PG8_STAGE(PG8_SB(1, 0), b3, voffB);
            PG8_BAR; PG8_WAIT_L(0); PG8_MMA(0, 1, At, B1); PG8_BAR;
            PG8_LDA(At, 1, 1); PG8_STAGE(PG8_SA(1, 0), a3, voffA);
            PG8_BAR; PG8_WAIT_L(0); PG8_MMA(1, 0, At, B0); PG8_BAR; PG8_SCHED;
            PG8_STAGE(PG8_SB(1, 1), b3 + hstep, voffB);
            PG8_WAIT_V(6); PG8_BAR; PG8_MMA(1, 1, At, B1); PG8_BAR;
            }
        }
        if constexpr (ALIGN_EPI) { if (wr == 0) PG8_BAR; }
        if constexpr (!Epi::AFTER_DRAIN) { E(acc, cur, wr, wc, fr, fq); S.done(cur); }
        if (!has_next) break;
#pragma unroll
        for (int a = 0; a < 2; ++a)
#pragma unroll
            for (int b = 0; b < 2; ++b)
#pragma unroll
                for (int m = 0; m < 4; ++m)
#pragma unroll
                    for (int n = 0; n < 2; ++n) acc[a][b][m][n] = (f32x4){0.f, 0.f, 0.f, 0.f};
        cur = nxt; cA = nA; cB = nB; ++ui;
        if constexpr (ALIGN_EPI) { if (wr == 1) PG8_BAR; }
    }
    PG8_WAIT_V(0);
    if constexpr (!ALIGN_EPI) { if (wr == 0) PG8_BAR; }
    PG8_BAR;
    if constexpr (Epi::AFTER_DRAIN) { E.fused(acc, cur, wr, wc, fr, fq, lds, wid, lane); S.done(cur); }
#undef PG8_SA
#undef PG8_SB
#undef PG8_STAGE
#undef PG8_LDA
#undef PG8_LDB
#undef PG8_MMA
#undef PG8_WAIT_V
#undef PG8_WAIT_L
#undef PG8_BAR
#undef PG8_SCHED
}
}

#define LAS __attribute__((address_space(3)))
typedef unsigned short bf16_t;
typedef short bf16x8 __attribute__((ext_vector_type(8)));
typedef short bf16x4 __attribute__((ext_vector_type(4)));
typedef float f32x4 __attribute__((ext_vector_type(4)));
typedef unsigned u32x4 __attribute__((ext_vector_type(4)));
typedef unsigned u32x2 __attribute__((ext_vector_type(2)));

constexpr int T = 32768, S = 16384, D = 2048;
constexpr int PC = 10240;
constexpr int NGATE = 2560, NMERGE = 6144, NIN = 18944;
constexpr int PA_Q = 0, PA_K = 1536, PA_V = 3072, PB_Q = 4608, PB_K = 5632, PB_V = 5888, PC_Q = 6144, PC_FF = 7168, PC_FB = 8192, PC_I = 9216;
constexpr float NORM_EPS = 1e-6f;
constexpr size_t MiB = 1u << 20;
constexpr size_t WS_ROPE = 1 * MiB, WS_LSE = 3 * MiB, WS_LB = 5 * MiB, WS_LSUM = 5 * MiB + 65536;
constexpr size_t WS_WIN = 6 * MiB, WS_WA = 80 * MiB, WS_WB = 82 * MiB, WS_WC = 86 * MiB, WS_WO = 90 * MiB;
constexpr size_t WS_XN = 98 * MiB, WS_YA = 226 * MiB, WS_YB = 258 * MiB, WS_YC = 322 * MiB, WS_SUM = 386 * MiB, WS_P = 418 * MiB, WS_END = 1058 * MiB;
constexpr size_t WS_G = WS_P, WS_YM = WS_P + 384 * MiB, WS_OUT = WS_P;
constexpr int LDS_BYTES = 163840;
constexpr int NTHREADS = 512;
#ifndef NLAYER
#define NLAYER 2
#endif

__device__ __forceinline__ float bf2f(unsigned short b) { return __builtin_bit_cast(float, (unsigned)b << 16); }
__device__ __forceinline__ float bf2f_s(short b) { return __builtin_bit_cast(float, ((unsigned)(unsigned short)b) << 16); }
typedef float f32x2_t __attribute__((ext_vector_type(2))); typedef __bf16 bf16x2_t __attribute__((ext_vector_type(2)));
__device__ __forceinline__ unsigned pk2(float lo, float hi) { f32x2_t v = {lo, hi}; bf16x2_t b = __builtin_convertvector(v, bf16x2_t); return __builtin_bit_cast(unsigned, b); }
__device__ __forceinline__ float wave_sum(float v) {
#pragma unroll
    for (int o = 1; o < 64; o <<= 1) v += __shfl_xor(v, o);
    return v;
}
__device__ __forceinline__ f32x4 mfma16(bf16x8 a, bf16x8 b, f32x4 c) { return __builtin_amdgcn_mfma_f32_16x16x32_bf16(a, b, c, 0, 0, 0); }
__device__ __forceinline__ float fast_sigmoid(float x) { return __builtin_amdgcn_rcpf(1.0f + __expf(-x)); }

__device__ __forceinline__ void transpose_item(const float* W, int K, int N, bf16_t* WT, int drow, LAS float* scr, int k0, int n0, int lane) {
#pragma unroll 8
    for (int i = 0; i < 32; ++i) { const int kk = 2 * i + (lane >> 5); scr[kk * 33 + (lane & 31)] = W[(size_t)(k0 + kk) * N + n0 + (lane & 31)]; }
    asm volatile("s_waitcnt lgkmcnt(0)" ::: "memory");
    const int c = lane & 7;
#pragma unroll
    for (int j = 0; j < 4; ++j) { const int n = (lane >> 3) + 8 * j; const LAS float* s = scr + (8 * c) * 33 + n;
        u32x4 o; o.x = pk2(s[0 * 33], s[1 * 33]); o.y = pk2(s[2 * 33], s[3 * 33]); o.z = pk2(s[4 * 33], s[5 * 33]); o.w = pk2(s[6 * 33], s[7 * 33]);
        *(u32x4*)(WT + (size_t)(drow + n) * K + k0 + 8 * c) = o; }
    asm volatile("s_waitcnt lgkmcnt(0)" ::: "memory");
}
__device__ __forceinline__ int win_dst(int n) {
    if (n < 4608) return n;
    if (n < 5120) return 10240 + (n - 4608);
    if (n < 6656) return 4608 + (n - 5120);
    if (n < 7680) return 10240 + 512 + (n - 6656);
    if (n < 11776) return 6144 + (n - 7680);
    if (n < 12800) return 10240 + 1536 + (n - 11776);
    return n;
}
struct Weights { const float *win, *wa, *wb, *wc, *wo; };
__device__ __forceinline__ void transpose_weights(const Weights& Wt, unsigned char* ws, LAS unsigned char* lds, int gw, int NGW, int wave, int lane) {
    LAS float* scr = (LAS float*)(lds + wave * 8448);
    constexpr int I_IN = 32 * (NIN / 32), I_A = 8 * 64, I_B = 16 * 64, I_C = 16 * 64, I_O = 32 * 64;
    constexpr int NITEMS = I_IN + I_A + I_B + I_C + I_O;
    for (int it = gw; it < NITEMS; it += NGW) {
        int r = it;
        if (r < I_IN) { const int nb = r % (NIN / 32), kb = r / (NIN / 32); transpose_item(Wt.win, D, NIN, (bf16_t*)(ws + WS_WIN), win_dst(nb * 32), scr, kb * 64, nb * 32, lane); continue; } r -= I_IN;
        if (r < I_A) { const int nb = r % 64, kb = r / 64; transpose_item(Wt.wa, 512, D, (bf16_t*)(ws + WS_WA), nb * 32, scr, kb * 64, nb * 32, lane); continue; } r -= I_A;
        if (r < I_B) { const int nb = r % 64, kb = r / 64; transpose_item(Wt.wb, 1024, D, (bf16_t*)(ws + WS_WB), nb * 32, scr, kb * 64, nb * 32, lane); continue; } r -= I_B;
        if (r < I_C) { const int nb = r % 64, kb = r / 64; transpose_item(Wt.wc, 1024, D, (bf16_t*)(ws + WS_WC), nb * 32, scr, kb * 64, nb * 32, lane); continue; } r -= I_C;
        { const int nb = r % 64, kb = r / 64; transpose_item(Wt.wo, D, D, (bf16_t*)(ws + WS_WO), nb * 32, scr, kb * 64, nb * 32, lane); }
    }
}
__device__ __forceinline__ void prenorm_row(const float* xrow, const float* gain, bf16_t* orow, int lane) {
    f32x4 v[8]; float s = 0.f;
#pragma unroll
    for (int j = 0; j < 8; ++j) { v[j] = ((const f32x4*)xrow)[lane + 64 * j]; s += (v[j].x * v[j].x + v[j].y * v[j].y) + (v[j].z * v[j].z + v[j].w * v[j].w); }
    const float r = 1.0f / sqrtf(wave_sum(s) * (1.0f / D) + NORM_EPS);
#pragma unroll
    for (int j = 0; j < 8; ++j) { const f32x4 g = ((const f32x4*)gain)[lane + 64 * j]; u32x2 o; o.x = pk2(v[j].x * r * g.x, v[j].y * r * g.y); o.y = pk2(v[j].z * r * g.z, v[j].w * r * g.w);
        ((u32x2*)orow)[lane + 64 * j] = o; }
}
__device__ __forceinline__ void final_row(const float* orow, const float* post, const float* xold, float* xnew, const float* pre_next, bf16_t* xn_next, int lane) {
    f32x4 v[8]; float s = 0.f;
#pragma unroll
    for (int j = 0; j < 8; ++j) { v[j] = ((const f32x4*)orow)[lane + 64 * j]; s += (v[j].x * v[j].x + v[j].y * v[j].y) + (v[j].z * v[j].z + v[j].w * v[j].w); }
    const float r = 1.0f / sqrtf(wave_sum(s) * (1.0f / D) + NORM_EPS);
    float s2 = 0.f;
#pragma unroll
    for (int j = 0; j < 8; ++j) { const f32x4 g = ((const f32x4*)post)[lane + 64 * j]; const f32x4 xo = ((const f32x4*)xold)[lane + 64 * j];
        f32x4 y; y.x = xo.x + v[j].x * r * g.x; y.y = xo.y + v[j].y * r * g.y; y.z = xo.z + v[j].z * r * g.z; y.w = xo.w + v[j].w * r * g.w;
        v[j] = y; s2 += (y.x * y.x + y.y * y.y) + (y.z * y.z + y.w * y.w); ((f32x4*)xnew)[lane + 64 * j] = y; }
    if (xn_next) {
        const float r2 = 1.0f / sqrtf(wave_sum(s2) * (1.0f / D) + NORM_EPS);
#pragma unroll
        for (int j = 0; j < 8; ++j) { const f32x4 g = ((const f32x4*)pre_next)[lane + 64 * j]; u32x2 o; o.x = pk2(v[j].x * r2 * g.x, v[j].y * r2 * g.y); o.y = pk2(v[j].z * r2 * g.z, v[j].w * r2 * g.w);
            ((u32x2*)xn_next)[lane + 64 * j] = o; }
    }
}

#define EPI_LOOP_BEGIN \
    const int row0 = u.pm * 256 + wr * 64 + fr; const int colb = u.pn * 256 + wc * 32 + 8 * fq; \
    _Pragma("unroll") for (int ai = 0; ai < 2; ++ai) _Pragma("unroll") for (int m = 0; m < 4; ++m) { const int row = row0 + ai * 128 + m * 16; \
    _Pragma("unroll") for (int bj = 0; bj < 2; ++bj) { const int col = colb + bj * 128; const f32x4 v0 = acc[ai][bj][m][0], v1 = acc[ai][bj][m][1];
#define EPI_LOOP_END } }

struct EpiStoreBf16 {
    static constexpr bool PERM = true, AFTER_DRAIN = false;
    bf16_t* O; int ldc;
    __device__ __forceinline__ void operator()(const f32x4 (&acc)[2][2][4][2], const pg8::Unit& u, int wr, int wc, int fr, int fq) const {
        EPI_LOOP_BEGIN
            u32x4 w; w.x = pk2(v0[0], v0[1]); w.y = pk2(v0[2], v0[3]); w.z = pk2(v1[0], v1[1]); w.w = pk2(v1[2], v1[3]);
            *(u32x4*)(O + (size_t)row * ldc + col) = w;
        EPI_LOOP_END
    }
};
struct EpiStoreRope {
    static constexpr bool PERM = true, AFTER_DRAIN = false;
    bf16_t* O; int ldc; const float2* rope;
    __device__ __forceinline__ void operator()(const f32x4 (&acc)[2][2][4][2], const pg8::Unit& u, int wr, int wc, int fr, int fq) const {
        const bool rt = (wc == 0) && ((u.pn < 12) || (u.pn >= 18 && u.pn < 23));
        const float sgn = (fq < 2) ? -1.f : 1.f;
        EPI_LOOP_BEGIN
            float y[8] = {v0[0], v0[1], v0[2], v0[3], v1[0], v1[1], v1[2], v1[3]};
            if (rt) { const float2* rp = rope + (size_t)(row & (S - 1)) * 16 + (fq & 1) * 8;
#pragma unroll
                for (int i = 0; i < 8; ++i) { const float pt = __shfl_xor(y[i], 32); const float2 cs = rp[i]; y[i] = y[i] * cs.x + sgn * pt * cs.y; } }
            u32x4 w; w.x = pk2(y[0], y[1]); w.y = pk2(y[2], y[3]); w.z = pk2(y[4], y[5]); w.w = pk2(y[6], y[7]);
            *(u32x4*)(O + (size_t)row * ldc + col) = w;
        EPI_LOOP_END
    }
};
struct EpiSigmoidBf16 {
    static constexpr bool PERM = true, AFTER_DRAIN = false;
    bf16_t* O; int ldc;
    __device__ __forceinline__ void operator()(const f32x4 (&acc)[2][2][4][2], const pg8::Unit& u, int wr, int wc, int fr, int fq) const {
        EPI_LOOP_BEGIN
            u32x4 w; w.x = pk2(fast_sigmoid(v0[0]), fast_sigmoid(v0[1])); w.y = pk2(fast_sigmoid(v0[2]), fast_sigmoid(v0[3]));
            w.z = pk2(fast_sigmoid(v1[0]), fast_sigmoid(v1[1])); w.w = pk2(fast_sigmoid(v1[2]), fast_sigmoid(v1[3]));
            *(u32x4*)(O + (size_t)row * ldc + col) = w;
        EPI_LOOP_END
    }
};
struct EpiStoreF32 {
    static constexpr bool PERM = true, AFTER_DRAIN = false;
    float* O; int ldc;
    __device__ __forceinline__ void operator()(const f32x4 (&acc)[2][2][4][2], const pg8::Unit& u, int wr, int wc, int fr, int fq) const {
        EPI_LOOP_BEGIN
            float* p = O + (size_t)row * ldc + col; *(f32x4*)p = v0; *(f32x4*)(p + 4) = v1;
        EPI_LOOP_END
    }
};
template <bool FIRST> struct EpiBranch {
    static constexpr bool PERM = true, AFTER_DRAIN = false;
    bf16_t* YM; const bf16_t* G; int br;
    __device__ __forceinline__ void operator()(const f32x4 (&acc)[2][2][4][2], const pg8::Unit& u, int wr, int wc, int fr, int fq) const {
        EPI_LOOP_BEGIN
            const u32x4 g = *(const u32x4*)(G + (size_t)row * NMERGE + br * 2048 + col);
            float y[8];
            y[0] = v0[0] * __builtin_bit_cast(float, g.x << 16); y[1] = v0[1] * __builtin_bit_cast(float, g.x & 0xffff0000u);
            y[2] = v0[2] * __builtin_bit_cast(float, g.y << 16); y[3] = v0[3] * __builtin_bit_cast(float, g.y & 0xffff0000u);
            y[4] = v1[0] * __builtin_bit_cast(float, g.z << 16); y[5] = v1[1] * __builtin_bit_cast(float, g.z & 0xffff0000u);
            y[6] = v1[2] * __builtin_bit_cast(float, g.w << 16); y[7] = v1[3] * __builtin_bit_cast(float, g.w & 0xffff0000u);
            bf16_t* yp = YM + (size_t)row * D + col;
            if (!FIRST) { const u32x4 o = *(const u32x4*)yp;
                y[0] += __builtin_bit_cast(float, o.x << 16); y[1] += __builtin_bit_cast(float, o.x & 0xffff0000u);
                y[2] += __builtin_bit_cast(float, o.y << 16); y[3] += __builtin_bit_cast(float, o.y & 0xffff0000u);
                y[4] += __builtin_bit_cast(float, o.z << 16); y[5] += __builtin_bit_cast(float, o.z & 0xffff0000u);
                y[6] += __builtin_bit_cast(float, o.w << 16); y[7] += __builtin_bit_cast(float, o.w & 0xffff0000u); }
            u32x4 w; w.x = pk2(y[0], y[1]); w.y = pk2(y[2], y[3]); w.z = pk2(y[4], y[5]); w.w = pk2(y[6], y[7]);
            *(u32x4*)yp = w;
        EPI_LOOP_END
    }
};
struct EpiGate {
    static constexpr bool PERM = true, AFTER_DRAIN = false;
    bf16_t *Ya, *Yb, *Yc; const bf16_t* P; const float* lse;
    __device__ __forceinline__ void operator()(const f32x4 (&acc)[2][2][4][2], const pg8::Unit& u, int wr, int wc, int fr, int fq) const {
        EPI_LOOP_BEGIN
            float sl[8];
            sl[0] = v0[0] * fast_sigmoid(v0[0]); sl[1] = v0[1] * fast_sigmoid(v0[1]); sl[2] = v0[2] * fast_sigmoid(v0[2]); sl[3] = v0[3] * fast_sigmoid(v0[3]);
            sl[4] = v1[0] * fast_sigmoid(v1[0]); sl[5] = v1[1] * fast_sigmoid(v1[1]); sl[6] = v1[2] * fast_sigmoid(v1[2]); sl[7] = v1[3] * fast_sigmoid(v1[3]);
            float raw[8]; bf16_t* dst;
            if (u.pn < 2) {
                const int slot = col >> 7;
                const float l0 = lse[((size_t)0 * T + row) * 4 + slot], l1 = lse[((size_t)1 * T + row) * 4 + slot], l2 = lse[((size_t)2 * T + row) * 4 + slot];
                const float mx = fmaxf(l0, fmaxf(l1, l2)); float e0 = __expf(l0 - mx), e1 = __expf(l1 - mx), e2 = __expf(l2 - mx);
                const float inv = 1.0f / (e0 + e1 + e2); e0 *= inv; e1 *= inv; e2 *= inv;
                const u32x4 a = *(const u32x4*)(P + (size_t)row * PC + col), b = *(const u32x4*)(P + (size_t)row * PC + 512 + col), c = *(const u32x4*)(P + (size_t)row * PC + 1024 + col);
#define MIX(i, fld, hi) raw[i] = e0 * __builtin_bit_cast(float, hi ? (a.fld & 0xffff0000u) : (a.fld << 16)) + e1 * __builtin_bit_cast(float, hi ? (b.fld & 0xffff0000u) : (b.fld << 16)) + e2 * __builtin_bit_cast(float, hi ? (c.fld & 0xffff0000u) : (c.fld << 16))
                MIX(0, x, 0); MIX(1, x, 1); MIX(2, y, 0); MIX(3, y, 1); MIX(4, z, 0); MIX(5, z, 1); MIX(6, w, 0); MIX(7, w, 1);
#undef MIX
                dst = Ya + (size_t)row * 512 + col;
            } else {
                dst = (u.pn < 6) ? (Yb + (size_t)row * 1024 + (col - 512)) : (Yc + (size_t)row * 1024 + (col - 1536));
                const u32x4 a = *(const u32x4*)dst;
                raw[0] = __builtin_bit_cast(float, a.x << 16); raw[1] = __builtin_bit_cast(float, a.x & 0xffff0000u);
                raw[2] = __builtin_bit_cast(float, a.y << 16); raw[3] = __builtin_bit_cast(float, a.y & 0xffff0000u);
                raw[4] = __builtin_bit_cast(float, a.z << 16); raw[5] = __builtin_bit_cast(float, a.z & 0xffff0000u);
                raw[6] = __builtin_bit_cast(float, a.w << 16); raw[7] = __builtin_bit_cast(float, a.w & 0xffff0000u);
            }
            u32x4 w; w.x = pk2(raw[0] * sl[0], raw[1] * sl[1]); w.y = pk2(raw[2] * sl[2], raw[3] * sl[3]); w.z = pk2(raw[4] * sl[4], raw[5] * sl[5]); w.w = pk2(raw[6] * sl[6], raw[7] * sl[7]);
            *(u32x4*)dst = w;
        EPI_LOOP_END
    }
};

constexpr int KP = 136;
struct AttnSrc { const bf16_t* Kg; const bf16_t* Vg; const bf16_t* Qrow; long tok0; int dil, kbase, L; };
template <int NKK, int NKV> struct StageRegs { bf16x8 k[(NKK * 16 + 511) / 512]; bf16x8 v[((NKV / 16) * 4 + 7) / 8]; bf16x8 q[4]; };
template <int NKK, int NKV, bool WITHQ>
__device__ __forceinline__ void stage_load(StageRegs<NKK, NKV>& R, const AttnSrc& A, int tid) {
    constexpr int KI = (NKK * 16 + 511) / 512, VI = ((NKV / 16) * 4 + 7) / 8;
    const int wave = tid >> 6, lane = tid & 63;
#pragma unroll
    for (int i = 0; i < KI; ++i) { const int task = tid + i * 512; const int row = task >> 4, c = task & 15; const int ki = A.kbase + row;
        bf16x8 v = (bf16x8){0, 0, 0, 0, 0, 0, 0, 0};
        if (task < NKK * 16 && ki >= 0 && ki < A.L) v = *(const bf16x8*)(A.Kg + (size_t)(A.tok0 + (long)ki * A.dil) * PC + c * 8);
        R.k[i] = v; }
#pragma unroll
    for (int i = 0; i < VI; ++i) { const int it = wave + 8 * i; const int row = (it >> 2) * 16 + (lane & 15), c = (it & 3) * 4 + (lane >> 4); const int ki = A.kbase + row;
        bf16x8 v = (bf16x8){0, 0, 0, 0, 0, 0, 0, 0};
        if (it < (NKV / 16) * 4 && ki >= 0 && ki < A.L) v = *(const bf16x8*)(A.Vg + (size_t)(A.tok0 + (long)ki * A.dil) * PC + c * 8);
        R.v[i] = v; }
    if (WITHQ) {
#pragma unroll
        for (int ks = 0; ks < 4; ++ks) R.q[ks] = *(const bf16x8*)(A.Qrow + ks * 32 + (lane >> 4) * 8); }
}
template <int NKK, int NKV, int VP>
__device__ __forceinline__ void stage_store(const StageRegs<NKK, NKV>& R, LAS bf16_t* Ks, LAS bf16_t* Vt, int tid) {
    constexpr int KI = (NKK * 16 + 511) / 512, VI = ((NKV / 16) * 4 + 7) / 8;
    const int wave = tid >> 6, lane = tid & 63;
#pragma unroll
    for (int i = 0; i < KI; ++i) { const int task = tid + i * 512; const int row = task >> 4, c = task & 15;
        if (task < NKK * 16) *(LAS bf16x8*)(Ks + row * KP + c * 8) = R.k[i]; }
#pragma unroll
    for (int i = 0; i < VI; ++i) { const int it = wave + 8 * i; const int row = (it >> 2) * 16 + (lane & 15), c = (it & 3) * 4 + (lane >> 4);
        if (it < (NKV / 16) * 4) {
#pragma unroll
            for (int e = 0; e < 8; ++e) Vt[(c * 8 + e) * VP + row] = (bf16_t)R.v[i][e]; } }
}
template <int NT, int VP>
__device__ __forceinline__ void attn_wave(const LAS bf16_t* Ks, const LAS bf16_t* Vt, int kt0, const bf16x8 (&qf)[4], int qi, int kbase, int L, int hw,
                                          bool has_sink, float sink, f32x4 (&o)[8], float& lse_out, int lane) {
    const int lr = lane & 15, lq = lane >> 4;
    f32x4 s[NT];
#pragma unroll
    for (int kt = 0; kt < NT - 1; ++kt) { f32x4 a = (f32x4){0.f, 0.f, 0.f, 0.f}; const LAS bf16_t* kp = Ks + (kt0 + 16 * kt + lr) * KP + lq * 8;
#pragma unroll
        for (int ks = 0; ks < 4; ++ks) a = mfma16(*(const LAS bf16x8*)(kp + ks * 32), qf[ks], a);
        s[kt] = a; }
    s[NT - 1] = (f32x4){-INFINITY, -INFINITY, -INFINITY, -INFINITY};
    const bool edge = (kbase + kt0 < 0) || (kbase + kt0 + 16 * NT > L);
#pragma unroll
    for (int kt = 0; kt < NT - 1; ++kt) {
        if (kt == 0 || kt == NT - 2 || edge) {
#pragma unroll
            for (int j = 0; j < 4; ++j) { const int ki = kbase + kt0 + 16 * kt + lq * 4 + j; const int rel = ki - qi;
                const bool ok = (ki >= 0) && (ki < L) && (rel <= hw) && (rel >= -hw);
                s[kt][j] = ok ? s[kt][j] : -INFINITY; } }
    }
    float m = -INFINITY;
#pragma unroll
    for (int kt = 0; kt < NT - 1; ++kt) m = fmaxf(fmaxf(m, fmaxf(s[kt][0], s[kt][1])), fmaxf(s[kt][2], s[kt][3]));
    m = fmaxf(m, __shfl_xor(m, 16)); m = fmaxf(m, __shfl_xor(m, 32));
    const float sc = 0.08838834764831845f * 1.4426950408889634f;
    float m2 = m * sc;
    if (has_sink) m2 = fmaxf(m2, sink * 1.4426950408889634f);
    float den = 0.f;
#pragma unroll
    for (int kt = 0; kt < NT - 1; ++kt)
#pragma unroll
        for (int j = 0; j < 4; ++j) { const float p = __builtin_amdgcn_exp2f(s[kt][j] * sc - m2); s[kt][j] = p; den += p; }
    s[NT - 1] = (f32x4){0.f, 0.f, 0.f, 0.f};
    den += __shfl_xor(den, 16); den += __shfl_xor(den, 32);
    if (has_sink) den += __builtin_amdgcn_exp2f(sink * 1.4426950408889634f - m2);
#pragma unroll
    for (int dt = 0; dt < 8; ++dt) o[dt] = (f32x4){0.f, 0.f, 0.f, 0.f};
#pragma unroll
    for (int t = 0; t < NT / 2; ++t) {
        u32x4 pw; pw.x = pk2(s[2 * t][0], s[2 * t][1]); pw.y = pk2(s[2 * t][2], s[2 * t][3]); pw.z = pk2(s[2 * t + 1][0], s[2 * t + 1][1]); pw.w = pk2(s[2 * t + 1][2], s[2 * t + 1][3]);
        const bf16x8 p = __builtin_bit_cast(bf16x8, pw);
#pragma unroll
        for (int dt = 0; dt < 8; ++dt) { const LAS bf16_t* vp = Vt + (dt * 16 + lr) * VP + kt0 + 32 * t + lq * 4;
            const u32x2 a0 = *(const LAS u32x2*)vp, a1 = *(const LAS u32x2*)(vp + 16);
            u32x4 aw; aw.x = a0.x; aw.y = a0.y; aw.z = a1.x; aw.w = a1.y;
            o[dt] = mfma16(__builtin_bit_cast(bf16x8, aw), p, o[dt]); }
    }
    const float inv = 1.0f / den;
#pragma unroll
    for (int dt = 0; dt < 8; ++dt) o[dt] = o[dt] * inv;
    lse_out = (m2 + __builtin_amdgcn_logf(den)) * 0.6931471805599453f;
}
constexpr int A_NK = 272, A_VP = 280, B_NKK = 288, B_NKV = 304, B_VP = 312;
struct AUnit { int g, slot, dil, phase, jb, L; long tok0; };
__device__ __forceinline__ AUnit decodeA(int u) { AUnit a; const int b = u / 1536, r = u % 1536; a.g = r >> 9; const int r2 = r & 511; a.slot = r2 >> 7; const int blk = r2 & 127;
    const int sh = 2 * a.g; a.dil = 1 << sh; const int nbp = 128 >> sh; a.phase = blk / nbp; a.jb = blk % nbp; a.L = S >> sh; a.tok0 = (long)b * S + a.phase; return a; }
__device__ __forceinline__ AttnSrc srcA(const AUnit& a, const bf16_t* P, int tid) { const int head = a.g * 4 + a.slot; const int w = tid >> 6, lr = tid & 15;
    const int qi = a.jb * 128 + 16 * w + lr;
    AttnSrc s; s.Kg = P + PA_K + head * 128; s.Vg = P + PA_V + head * 128; s.Qrow = P + (size_t)(a.tok0 + (long)qi * a.dil) * PC + PA_Q + head * 128; s.tok0 = a.tok0; s.dil = a.dil; s.kbase = a.jb * 128 - 64; s.L = a.L; return s; }
__device__ __forceinline__ void attnA_phase(bf16_t* P, float* lse, LAS unsigned char* lds, int tid, int bx, int G) {
    LAS bf16_t* Ks = (LAS bf16_t*)lds; LAS bf16_t* Vt = (LAS bf16_t*)(lds + A_NK * KP * 2);
    StageRegs<A_NK, A_NK> R;
    int u = bx;
    if (u < 3072) { const AUnit a = decodeA(u); stage_load<A_NK, A_NK, true>(R, srcA(a, P, tid), tid); }
    for (; u < 3072; u += G) {
        const AUnit a = decodeA(u);
        stage_store<A_NK, A_NK, A_VP>(R, Ks, Vt, tid);
        bf16x8 qf[4];
#pragma unroll
        for (int ks = 0; ks < 4; ++ks) qf[ks] = R.q[ks];
        __syncthreads();
        if (u + G < 3072) { const AUnit an = decodeA(u + G); stage_load<A_NK, A_NK, true>(R, srcA(an, P, tid), tid); }
        const int w = tid >> 6, lane = tid & 63, lr = lane & 15, lq = lane >> 4;
        const int qi = a.jb * 128 + 16 * w + lr; const long token = a.tok0 + (long)qi * a.dil; const int head = a.g * 4 + a.slot;
        f32x4 o[8]; float lv;
        attn_wave<10, A_VP>(Ks, Vt, 16 * w, qf, qi, a.jb * 128 - 64, a.L, 64, false, 0.f, o, lv, lane);
        bf16_t* qrow = P + (size_t)token * PC + PA_Q + head * 128;
#pragma unroll
        for (int dt = 0; dt < 8; ++dt) { u32x2 wv; wv.x = pk2(o[dt][0], o[dt][1]); wv.y = pk2(o[dt][2], o[dt][3]); *(u32x2*)(qrow + dt * 16 + lq * 4) = wv; }
        if (lq == 0) lse[((size_t)a.g * T + token) * 4 + a.slot] = lv;
        __syncthreads();
    }
}
__device__ __forceinline__ AttnSrc srcB(int u, const bf16_t* P, int tid) { const int b = u >> 10, r = u & 1023, kvh = r >> 9, blk = r & 511; const int w = tid >> 6, lr = tid & 15;
    const int head = kvh * 4 + (w >> 1), qi = blk * 32 + 16 * (w & 1) + lr;
    AttnSrc s; s.Kg = P + PB_K + kvh * 128; s.Vg = P + PB_V + kvh * 128; s.tok0 = (long)b * S; s.Qrow = P + (size_t)(s.tok0 + qi) * PC + PB_Q + head * 128; s.dil = 1; s.kbase = blk * 32 - 128; s.L = S; return s; }
__device__ __forceinline__ void attnB_phase(const bf16_t* P, bf16_t* Yb, const float* sinks, LAS unsigned char* lds, int tid, int bx, int G) {
    LAS bf16_t* Ks = (LAS bf16_t*)lds; LAS bf16_t* Vt = (LAS bf16_t*)(lds + B_NKK * KP * 2);
    StageRegs<B_NKK, B_NKV> R;
    int u = bx;
    if (u < 2048) stage_load<B_NKK, B_NKV, false>(R, srcB(u, P, tid), tid);
    for (; u < 2048; u += G) {
        bf16x8 qf[4];
        { const AttnSrc sq = srcB(u, P, tid);
#pragma unroll
          for (int ks = 0; ks < 4; ++ks) qf[ks] = *(const bf16x8*)(sq.Qrow + ks * 32 + ((tid & 63) >> 4) * 8); }
        stage_store<B_NKK, B_NKV, B_VP>(R, Ks, Vt, tid);
        __syncthreads();
        if (u + G < 2048) stage_load<B_NKK, B_NKV, false>(R, srcB(u + G, P, tid), tid);
        const int b = u >> 10, r = u & 1023, kvh = r >> 9, blk = r & 511;
        const int w = tid >> 6, lane = tid & 63, lr = lane & 15, lq = lane >> 4;
        const int head = kvh * 4 + (w >> 1), rg = w & 1;
        const int qi = blk * 32 + 16 * rg + lr; const long token = (long)b * S + qi;
        f32x4 o[8]; float lv;
        attn_wave<18, B_VP>(Ks, Vt, 16 * rg, qf, qi, blk * 32 - 128, S, 128, true, sinks[head], o, lv, lane);
        bf16_t* orow = Yb + (size_t)token * 1024 + head * 128;
#pragma unroll
        for (int dt = 0; dt < 8; ++dt) { u32x2 wv; wv.x = pk2(o[dt][0], o[dt][1]); wv.y = pk2(o[dt][2], o[dt][3]); *(u32x2*)(orow + dt * 16 + lq * 4) = wv; }
        __syncthreads();
    }
}

constexpr int H_QT = 0, H_KT = 17408, H_QH = 34816, H_KHT = 52224, H_VT = 70656, H_ST = 89088, H_SC = 123904, H_QS = 133120, H_DEC = 135168;
__device__ __forceinline__ void hgrn_unit(int b, int h, int seg, int dir, int mode, bf16_t* P, const float* lb, float* SUM, float* LSUM, LAS unsigned char* lds, int tid) {
    const int w = tid >> 6, lane = tid & 63, lr = lane & 15, lq = lane >> 4;
    const int k = tid & 127, tq = tid >> 7;
    LAS bf16_t* Qt = (LAS bf16_t*)(lds + H_QT); LAS bf16_t* Kt = (LAS bf16_t*)(lds + H_KT); LAS bf16_t* Qh = (LAS bf16_t*)(lds + H_QH);
    LAS bf16_t* KhT = (LAS bf16_t*)(lds + H_KHT); LAS bf16_t* VT = (LAS bf16_t*)(lds + H_VT); LAS bf16_t* ST = (LAS bf16_t*)(lds + H_ST);
    LAS bf16_t* Sc = (LAS bf16_t*)(lds + H_SC); LAS float* QS = (LAS float*)(lds + H_QS); LAS float* DEC = (LAS float*)(lds + H_DEC);
    const float lbv = lb[h * 128 + k], oml = 1.0f - lbv;
    f32x4 Sacc[8];
#pragma unroll
    for (int vt = 0; vt < 8; ++vt) Sacc[vt] = (f32x4){0.f, 0.f, 0.f, 0.f};
    float lsum = 0.f;
    const int chain = ((b * 8 + h) * 2 + dir) * 16;
    if (mode == 1) {
        const int nprev = dir ? 15 - seg : seg;
        for (int jj = 0; jj < nprev; ++jj) { const int su = chain + (dir ? 15 - jj : jj);
            const float* sp = SUM + (size_t)su * 16384; const float* lp = LSUM + su * 128 + 16 * w + lq * 4;
            const f32x4 lv = *(const f32x4*)lp; f32x4 dv; dv.x = __expf(lv.x); dv.y = __expf(lv.y); dv.z = __expf(lv.z); dv.w = __expf(lv.w);
#pragma unroll
            for (int vt = 0; vt < 8; ++vt) { const f32x4 x = *(const f32x4*)(sp + ((w * 8 + vt) * 64 + lane) * 4); Sacc[vt] = Sacc[vt] * dv + x; } }
    }
    const bf16_t* fbase = P + (dir ? PC_FB : PC_FF) + h * 128 + k;
    for (int cc = 0; cc < 16; ++cc) {
        const int c = seg * 16 + (dir ? 15 - cc : cc); const long btok = (long)b * S + c * 64;
        float lf[16], kk[16];
#pragma unroll
        for (int ii = 0; ii < 16; ++ii) { const int i = tq * 16 + ii; const long tok = btok + (dir ? 63 - i : i);
            const float fz = bf2f(fbase[(size_t)tok * PC]); const float e = __expf(-fz), sg = __builtin_amdgcn_rcpf(1.0f + e);
            lf[ii] = __logf(lbv + oml * sg); kk[ii] = oml * e * sg; }
#pragma unroll
        for (int ii = 1; ii < 16; ++ii) lf[ii] += lf[ii - 1];
        QS[tq * 128 + k] = lf[15];
        __syncthreads();
        const float q0 = QS[k], q1 = QS[128 + k], q2 = QS[256 + k], q3 = QS[384 + k];
        const float off = (tq > 0 ? q0 : 0.f) + (tq > 1 ? q1 : 0.f) + (tq > 2 ? q2 : 0.f);
        const float rref = q0 + q1, bl = (q0 + q1) + (q2 + q3);
        if (tq == 0) { DEC[k] = __expf(bl); lsum += bl; }
        u32x4 kh0, kh1, vv0, vv1;
        {
            float khat[16]; unsigned short vraw[16];
#pragma unroll
            for (int ii = 0; ii < 16; ++ii) { const int i = tq * 16 + ii; const long tok = btok + (dir ? 63 - i : i); const float bt = off + lf[ii];
                khat[ii] = kk[ii] * __expf(bl - bt);
                vraw[ii] = P[(size_t)tok * PC + PC_I + h * 128 + k];
                if (mode == 1) { const float qv = bf2f(P[(size_t)tok * PC + PC_Q + h * 128 + k]); const float qh = qv * fast_sigmoid(qv);
                    const float eq = __expf(fminf(bt - rref, 80.f)), ek = __expf(fminf(rref - bt, 80.f));
                    Qt[i * KP + k] = (bf16_t)(pk2(qh * eq, 0.f) & 0xffffu); Kt[i * KP + k] = (bf16_t)(pk2(kk[ii] * ek, 0.f) & 0xffffu); Qh[i * KP + k] = (bf16_t)(pk2(qh * __expf(bt), 0.f) & 0xffffu); } }
            kh0.x = pk2(khat[0], khat[1]); kh0.y = pk2(khat[2], khat[3]); kh0.z = pk2(khat[4], khat[5]); kh0.w = pk2(khat[6], khat[7]);
            kh1.x = pk2(khat[8], khat[9]); kh1.y = pk2(khat[10], khat[11]); kh1.z = pk2(khat[12], khat[13]); kh1.w = pk2(khat[14], khat[15]);
            vv0.x = vraw[0] | ((unsigned)vraw[1] << 16); vv0.y = vraw[2] | ((unsigned)vraw[3] << 16); vv0.z = vraw[4] | ((unsigned)vraw[5] << 16); vv0.w = vraw[6] | ((unsigned)vraw[7] << 16);
            vv1.x = vraw[8] | ((unsigned)vraw[9] << 16); vv1.y = vraw[10] | ((unsigned)vraw[11] << 16); vv1.z = vraw[12] | ((unsigned)vraw[13] << 16); vv1.w = vraw[14] | ((unsigned)vraw[15] << 16);
        }
        *(LAS u32x4*)(KhT + k * 72 + tq * 16) = kh0; *(LAS u32x4*)(KhT + k * 72 + tq * 16 + 8) = kh1;
        *(LAS u32x4*)(VT + k * 72 + tq * 16) = vv0; *(LAS u32x4*)(VT + k * 72 + tq * 16 + 8) = vv1;
        if (mode == 1) {
#pragma unroll
            for (int vt = 0; vt < 8; ++vt) { u32x2 sv; sv.x = pk2(Sacc[vt][0], Sacc[vt][1]); sv.y = pk2(Sacc[vt][2], Sacc[vt][3]); *(LAS u32x2*)(ST + (16 * vt + lr) * KP + 16 * w + lq * 4) = sv; }
        }
        __syncthreads();
        if (mode == 1) {
#pragma unroll
            for (int e = 0; e < 2; ++e) { const int ti = 2 * w + e, st = ti >> 2, tt = ti & 3;
                f32x4 a = (f32x4){0.f, 0.f, 0.f, 0.f};
                if (st <= tt) {
#pragma unroll
                    for (int ks = 0; ks < 4; ++ks) a = mfma16(*(const LAS bf16x8*)(Kt + (16 * st + lr) * KP + ks * 32 + lq * 8), *(const LAS bf16x8*)(Qt + (16 * tt + lr) * KP + ks * 32 + lq * 8), a);
                }
                const int t = 16 * tt + lr, s0 = 16 * st + lq * 4;
                float x0 = (t >= s0 && st <= tt) ? a[0] : 0.f, x1 = (t >= s0 + 1 && st <= tt) ? a[1] : 0.f, x2 = (t >= s0 + 2 && st <= tt) ? a[2] : 0.f, x3 = (t >= s0 + 3 && st <= tt) ? a[3] : 0.f;
                u32x2 sv; sv.x = pk2(x0, x1); sv.y = pk2(x2, x3); *(LAS u32x2*)(Sc + t * 72 + s0) = sv; }
            __syncthreads();
            const int tt = w & 3, vh = w >> 2;
            bf16x8 scf[2], qhf[4];
#pragma unroll
            for (int ks = 0; ks < 2; ++ks) scf[ks] = *(const LAS bf16x8*)(Sc + (16 * tt + lr) * 72 + ks * 32 + lq * 8);
#pragma unroll
            for (int ks = 0; ks < 4; ++ks) qhf[ks] = *(const LAS bf16x8*)(Qh + (16 * tt + lr) * KP + ks * 32 + lq * 8);
            const int il = 16 * tt + lr; const long tok = btok + (dir ? 63 - il : il);
#pragma unroll
            for (int vi = 0; vi < 4; ++vi) { const int vt = vh * 4 + vi; f32x4 a = (f32x4){0.f, 0.f, 0.f, 0.f};
#pragma unroll
                for (int ks = 0; ks < 2; ++ks) a = mfma16(*(const LAS bf16x8*)(VT + (16 * vt + lr) * 72 + ks * 32 + lq * 8), scf[ks], a);
#pragma unroll
                for (int ks = 0; ks < 4; ++ks) a = mfma16(*(const LAS bf16x8*)(ST + (16 * vt + lr) * KP + ks * 32 + lq * 8), qhf[ks], a);
                bf16_t* of = P + (size_t)tok * PC + PC_FF + h * 128 + 16 * vt + lq * 4;
                if (dir == 0) { u32x2 sv; sv.x = pk2(a[0], a[1]); sv.y = pk2(a[2], a[3]); *(u32x2*)of = sv; }
                else { const u32x2 pv = *(const u32x2*)of;
                    a[0] += __builtin_bit_cast(float, pv.x << 16); a[1] += __builtin_bit_cast(float, pv.x & 0xffff0000u); a[2] += __builtin_bit_cast(float, pv.y << 16); a[3] += __builtin_bit_cast(float, pv.y & 0xffff0000u);
                    u32x2 sv; sv.x = pk2(a[0], a[1]); sv.y = pk2(a[2], a[3]); *(u32x2*)(P + (size_t)tok * PC + PC_FB + h * 128 + 16 * vt + lq * 4) = sv; } }
        }
        { const f32x4 dv = *(const LAS f32x4*)(DEC + 16 * w + lq * 4);
          bf16x8 af[2];
#pragma unroll
          for (int ks = 0; ks < 2; ++ks) af[ks] = *(const LAS bf16x8*)(KhT + (16 * w + lr) * 72 + ks * 32 + lq * 8);
#pragma unroll
          for (int vt = 0; vt < 8; ++vt) { f32x4 a = Sacc[vt] * dv;
#pragma unroll
              for (int ks = 0; ks < 2; ++ks) a = mfma16(af[ks], *(const LAS bf16x8*)(VT + (16 * vt + lr) * 72 + ks * 32 + lq * 8), a);
              Sacc[vt] = a; } }
        __syncthreads();
    }
    if (mode == 0) { const int su = chain + seg; float* sp = SUM + (size_t)su * 16384;
#pragma unroll
        for (int vt = 0; vt < 8; ++vt) *(f32x4*)(sp + ((w * 8 + vt) * 64 + lane) * 4) = Sacc[vt];
        if (tq == 0) LSUM[su * 128 + k] = lsum; }
}
__device__ __forceinline__ void hgrn_full_unit(int u, bf16_t* P, const float* lb, const float* hnorm, float* SUM, float* LSUM, bf16_t* Yc, LAS unsigned char* lds, int tid) {
    const int b = u >> 7, h = (u >> 4) & 7, seg = u & 15;
    hgrn_unit(b, h, seg, 0, 1, P, lb, SUM, LSUM, lds, tid);
    __threadfence(); __syncthreads();
#if defined(PROBE_HG) && PROBE_HG == 1
    return;
#endif
    hgrn_unit(b, h, seg, 1, 1, P, lb, SUM, LSUM, lds, tid);
    __threadfence(); __syncthreads();
#if defined(PROBE_HG) && PROBE_HG == 2
    return;
#endif
    const int w = tid >> 6, lane = tid & 63;
    const float g0 = hnorm[h * 128 + 2 * lane], g1 = hnorm[h * 128 + 2 * lane + 1];
    for (int r = w; r < 1024; r += 8) { const long tok = (long)b * S + seg * 1024 + r;
        const unsigned pv = *(const unsigned*)(P + (size_t)tok * PC + PC_FB + h * 128 + 2 * lane);
        const float x0 = __builtin_bit_cast(float, pv << 16), x1 = __builtin_bit_cast(float, pv & 0xffff0000u);
        const float ss = wave_sum(x0 * x0 + x1 * x1); const float rs = 1.0f / sqrtf(ss * (1.0f / 128.f) + NORM_EPS);
        *(unsigned*)(Yc + (size_t)tok * 1024 + h * 128 + 2 * lane) = pk2(x0 * rs * g0, x1 * rs * g1); }
    __syncthreads();
}

#define XB_TMO      128
#define XB_XCNT(j)  (256  + 64 * (j))
#define XB_XSUB(j)  (1280 + 64 * (j))
#define XB_XGEN(j)  (2304 + 64 * (j))
#define XB_TOP      3328
#define XB_TOPGEN   3392
#define XCD_BAR_WORDS 3456
#define XB_SPIN_CAP (1u << 18)

__device__ __forceinline__ unsigned xb_ld(unsigned* p)              { return __hip_atomic_load(p, __ATOMIC_RELAXED, __HIP_MEMORY_SCOPE_AGENT); }
__device__ __forceinline__ unsigned xb_add(unsigned* p, unsigned v) { return __hip_atomic_fetch_add(p, v, __ATOMIC_RELAXED, __HIP_MEMORY_SCOPE_AGENT); }
__device__ __forceinline__ unsigned xb_xcc_id() { return (unsigned)__builtin_amdgcn_s_getreg((3 << 11) | 20) & 0xFu; }
#define XB_SPIN(cond, bar) do { unsigned _sp = 0; while (cond) { __builtin_amdgcn_s_sleep(1); \
    if ((++_sp & 255u) == 0u) { if (xb_ld(&(bar)[XB_TMO])) break; if (_sp > XB_SPIN_CAP) { atomicAdd(&(bar)[XB_TMO], 1u); break; } } } } while (0)

struct XcdBarrier {
    unsigned* bar; unsigned x;
    volatile LAS unsigned* st;
};

__device__ __forceinline__ XcdBarrier xcd_barrier_post(unsigned* bar, volatile LAS unsigned* st) {
    XcdBarrier b; b.bar = bar; b.x = xb_xcc_id(); b.st = st;
    if (threadIdx.x == 0) (void)xb_add(&bar[XB_XCNT(b.x)], 1u);
    return b;
}
__device__ __forceinline__ void xcd_barrier_complete(unsigned* bar, unsigned x, unsigned& nloc, unsigned& nx) {
    const unsigned G = gridDim.x * gridDim.y * gridDim.z;
    unsigned sum, cnt, mine, sp = 0u;
    for (;;) {
        sum = 0u; cnt = 0u; mine = 0u;
#pragma unroll
        for (unsigned j = 0; j < 16; ++j) { const unsigned c = xb_ld(&bar[XB_XCNT(j)]); sum += c; cnt += (c > 0u) ? 1u : 0u; mine = (j == x) ? c : mine; }
        if (sum == G) break;
        __builtin_amdgcn_s_sleep(1);
        if ((++sp & 255u) == 0u) { if (xb_ld(&bar[XB_TMO])) break; if (sp > XB_SPIN_CAP) { atomicAdd(&bar[XB_TMO], 1u); break; } }
    }
    nloc = mine > 0u ? mine : 1u; nx = cnt > 0u ? cnt : 1u;
}

__device__ __forceinline__ void xcd_barrier(const XcdBarrier& b) {
    asm volatile("s_waitcnt vmcnt(0)" ::: "memory");
    __syncthreads();
    if (threadIdx.x == 0) {
        unsigned* bar = b.bar;
        __builtin_amdgcn_s_waitcnt(0);
        unsigned nloc = b.st[0], nx = b.st[1];
        if (nloc == 0u) { xcd_barrier_complete(bar, b.x, nloc, nx); b.st[0] = nloc; b.st[1] = nx; }
        const unsigned old = xb_add(&bar[XB_XSUB(b.x)], 1u);
        const unsigned gen = old / nloc;
        if (old + 1u == (gen + 1u) * nloc) {
            __builtin_amdgcn_fence(__ATOMIC_RELEASE, "agent");
            asm volatile("s_waitcnt vmcnt(0)" ::: "memory");
            const unsigned og = xb_add(&bar[XB_TOP], 1u);
            const unsigned tg = og / nx;
            if (og + 1u == (tg + 1u) * nx) xb_add(&bar[XB_TOPGEN], 1u);
            else XB_SPIN(xb_ld(&bar[XB_TOPGEN]) == tg, bar);
            __builtin_amdgcn_fence(__ATOMIC_ACQUIRE, "agent");
            xb_add(&bar[XB_XGEN(b.x)], 1u);
            asm volatile("s_waitcnt vmcnt(0)" ::: "memory");
        } else {
            XB_SPIN(xb_ld(&bar[XB_XGEN(b.x)]) == gen, bar);
            __builtin_amdgcn_fence(__ATOMIC_ACQUIRE, "agent");
            asm volatile("s_waitcnt vmcnt(0)" ::: "memory");
        }
    }
    __syncthreads();
}


struct Args { const float* in[11]; float* out; unsigned char* ws; int ph_lo, ph_hi; };
#define DERIVE_PTRS \
    int tid = threadIdx.x; asm volatile("" : "+v"(tid)); const int lane = tid & 63, wave = __builtin_amdgcn_readfirstlane(tid >> 6); \
    int G = gridDim.x, bx = blockIdx.x; asm volatile("" : "+s"(G), "+s"(bx)); \
    const int gw = bx * 8 + wave, NGW = G * 8; \
    unsigned char* ws = args.ws; asm volatile("" : "+s"(ws)); \
    const float* x0 = args.in[0]; const float* pre_norm = args.in[1]; const float* post_norm = args.in[2]; const float* sink_logits = args.in[4]; \
    const float* hlb = args.in[5]; const float* hnorm = args.in[6]; float* outp = args.out; \
    asm volatile("" : "+s"(x0), "+s"(pre_norm), "+s"(post_norm), "+s"(sink_logits), "+s"(hlb), "+s"(hnorm), "+s"(outp)); \
    float2* rope = (float2*)(ws + WS_ROPE); float* lse = (float*)(ws + WS_LSE); float* LB = (float*)(ws + WS_LB); float* LSUM = (float*)(ws + WS_LSUM); \
    bf16_t* WinT = (bf16_t*)(ws + WS_WIN); bf16_t* WaT = (bf16_t*)(ws + WS_WA); bf16_t* WbT = (bf16_t*)(ws + WS_WB); bf16_t* WcT = (bf16_t*)(ws + WS_WC); bf16_t* WoT = (bf16_t*)(ws + WS_WO); \
    bf16_t* XN = (bf16_t*)(ws + WS_XN); bf16_t* Ya = (bf16_t*)(ws + WS_YA); bf16_t* Yb = (bf16_t*)(ws + WS_YB); bf16_t* Yc = (bf16_t*)(ws + WS_YC); \
    float* SUM = (float*)(ws + WS_SUM); bf16_t* P = (bf16_t*)(ws + WS_P); bf16_t* Gm = (bf16_t*)(ws + WS_G); bf16_t* YM = (bf16_t*)(ws + WS_YM); float* OUT = (float*)(ws + WS_OUT); \
    (void)tid; (void)lane; (void)gw; (void)NGW; (void)x0; (void)pre_norm; (void)post_norm; (void)sink_logits; (void)hlb; (void)hnorm; (void)outp; (void)rope; (void)lse; (void)LB; (void)LSUM; \
    (void)WinT; (void)WaT; (void)WbT; (void)WcT; (void)WoT; (void)XN; (void)Ya; (void)Yb; (void)Yc; (void)SUM; (void)P; (void)Gm; (void)YM; (void)OUT;
#ifndef REPEAT_MASK
#define REPEAT_MASK 0
#endif
#define NREP(j) (1 + ((REPEAT_MASK >> (j)) & 1))
#define IN(k) (args.ph_lo <= (k) && (k) < args.ph_hi)
#define XB_ST_OFF (LDS_BYTES - 64)
#define GRID_SYNC(k) do { if (IN(k) && IN((k) + 1)) { if ((k) == 0) cg::this_grid().sync(); else { XcdBarrier xb_; xb_.bar = (unsigned*)args.ws; xb_.x = xb_xcc_id(); xb_.st = (volatile LAS unsigned*)(lds + XB_ST_OFF); xcd_barrier(xb_); } } } while (0)
template <int layer> __device__ __forceinline__ void run_layer(const Args& args, LAS unsigned char* lds) {
#ifndef SKIP_P1
        for (int rep = 0; rep < NREP(0); ++rep) if (IN(1 + 8 * layer + 0)) { DERIVE_PTRS pg8::Gemm g{XN, WinT, T, PC, D}; pg8::StaticOrder So; So.init(T, PC, G, bx); EpiStoreRope E{P, PC, rope};
          pg8::gemm_phase<EpiStoreRope, pg8::StaticOrder, true, true>(lds, g, So, E); }
#endif
        GRID_SYNC(1 + 8 * layer + 0);
#ifndef SKIP_P2
        if (IN(1 + 8 * layer + 1)) { DERIVE_PTRS const float* lbL = LB + layer * 1024;
          for (int rep = 0; rep < NREP(8); ++rep) for (int u = bx; u < 512; u += G) { const int dir = u & 1, seg = (u >> 1) & 15, h = (u >> 5) & 7, b = u >> 8; hgrn_unit(b, h, seg, dir, 0, P, lbL, SUM, LSUM, lds, tid); }
          __syncthreads();
          attnA_phase(P, lse, lds, tid, bx, G);
          for (int rep = 0; rep < NREP(9); ++rep) attnB_phase(P, Yb, sink_logits + layer * 8, lds, tid, bx, G); }
#endif
        GRID_SYNC(1 + 8 * layer + 1);
#ifndef SKIP_P3
        if (IN(1 + 8 * layer + 2)) { DERIVE_PTRS for (int u = bx; u < 256; u += G) hgrn_full_unit(u, P, LB + layer * 1024, hnorm + layer * 1024, SUM, LSUM, Yc, lds, tid); }
#endif
        GRID_SYNC(1 + 8 * layer + 2);
#ifndef SKIP_P4
        if (IN(1 + 8 * layer + 3)) { DERIVE_PTRS pg8::Gemm g{XN, WinT + (size_t)PC * D, T, NGATE, D}; pg8::StaticOrder So; So.init(T, NGATE, G, bx); EpiGate E{Ya, Yb, Yc, P, lse};
          pg8::gemm_phase<EpiGate, pg8::StaticOrder, true, true>(lds, g, So, E); }
#endif
        GRID_SYNC(1 + 8 * layer + 3);
#ifndef SKIP_P5
        for (int rep = 0; rep < NREP(4); ++rep) if (IN(1 + 8 * layer + 4)) { DERIVE_PTRS pg8::Gemm g{XN, WinT + (size_t)(PC + NGATE) * D, T, NMERGE, D}; pg8::StaticOrder So; So.init(T, NMERGE, G, bx); EpiSigmoidBf16 E{Gm, NMERGE};
          pg8::gemm_phase<EpiSigmoidBf16, pg8::StaticOrder, true, true>(lds, g, So, E); }
#endif
        GRID_SYNC(1 + 8 * layer + 4);
#ifndef SKIP_P6
        for (int rep = 0; rep < NREP(5); ++rep) if (IN(1 + 8 * layer + 5)) { DERIVE_PTRS pg8::StaticOrder So; So.init(T, D, G, bx);
          { pg8::Gemm g{Ya, WaT, T, D, 512}; EpiBranch<true> E{YM, Gm, 0}; pg8::gemm_phase<EpiBranch<true>, pg8::StaticOrder, true, true>(lds, g, So, E); }
          { pg8::Gemm g{Yb, WbT, T, D, 1024}; EpiBranch<false> E{YM, Gm, 1}; pg8::gemm_phase<EpiBranch<false>, pg8::StaticOrder, true, true>(lds, g, So, E); }
          { pg8::Gemm g{Yc, WcT, T, D, 1024}; EpiBranch<false> E{YM, Gm, 2}; pg8::gemm_phase<EpiBranch<false>, pg8::StaticOrder, true, true>(lds, g, So, E); } }
#endif
        GRID_SYNC(1 + 8 * layer + 5);
#ifndef SKIP_P7
        for (int rep = 0; rep < NREP(6); ++rep) if (IN(1 + 8 * layer + 6)) { DERIVE_PTRS pg8::Gemm g{YM, WoT, T, D, D}; pg8::StaticOrder So; So.init(T, D, G, bx); EpiStoreF32 E{OUT, D};
          pg8::gemm_phase<EpiStoreF32, pg8::StaticOrder, true, true>(lds, g, So, E); }
#endif
        GRID_SYNC(1 + 8 * layer + 6);
        if (IN(1 + 8 * layer + 7)) { DERIVE_PTRS const float* xold = layer == 0 ? x0 : outp;
          for (int m = gw; m < T; m += NGW) final_row(OUT + (size_t)m * D, post_norm + layer * D, xold + (size_t)m * D, outp + (size_t)m * D,
                                                     layer == 0 ? pre_norm + D : nullptr, layer == 0 ? XN + (size_t)m * D : nullptr, lane);
          if (layer == 0) { Weights Wt{args.in[3] + (size_t)D * NIN, args.in[7] + (size_t)512 * D, args.in[8] + (size_t)1024 * D, args.in[9] + (size_t)1024 * D, args.in[10] + (size_t)D * D};
              __syncthreads(); transpose_weights(Wt, ws, lds, gw, NGW, wave, lane); GRID_SYNC(1 + 8 * layer + 7); } }
}
__global__ void __launch_bounds__(NTHREADS, 2) fwd_megakernel(Args args) {
    extern __shared__ __attribute__((aligned(16))) unsigned char lds_raw[];
    LAS unsigned char* lds = (LAS unsigned char*)lds_raw;
    if (threadIdx.x < 16) ((LAS unsigned*)(lds + XB_ST_OFF))[threadIdx.x] = 0u;
    __syncthreads();
    if (args.ph_hi - args.ph_lo > 1) (void)xcd_barrier_post((unsigned*)args.ws, (volatile LAS unsigned*)(lds + XB_ST_OFF));
    if (IN(0)) { DERIVE_PTRS
    for (int i = bx * NTHREADS + tid; i < S * 16; i += G * NTHREADS) { const int pos = i >> 4, j = i & 15;
        const float inv = exp2f(-(float)j * (18.931568569324174f / 16.0f)); const float ang = (float)pos * inv;
        const double rev = (double)ang * 0.15915494309189535; const float fr = (float)(rev - floor(rev));
        rope[i] = make_float2(__builtin_amdgcn_cosf(fr), __builtin_amdgcn_sinf(fr)); }
    for (int i = bx * NTHREADS + tid; i < 1024; i += G * NTHREADS) { const float h0 = hlb[i], h1 = hlb[1024 + i]; const float mx = fmaxf(h0, h1);
        const float e0 = expf(h0 - mx), e1 = expf(h1 - mx); LB[i] = 0.f; LB[1024 + i] = e1 / (e0 + e1); }
    { Weights Wt{args.in[3], args.in[7], args.in[8], args.in[9], args.in[10]}; transpose_weights(Wt, ws, lds, gw, NGW, wave, lane); }
    for (int m = gw; m < T; m += NGW) prenorm_row(x0 + (size_t)m * D, pre_norm, XN + (size_t)m * D, lane);
    }
    GRID_SYNC(0);

    run_layer<0>(args, lds);
#if NLAYER > 1
    run_layer<1>(args, lds);
#endif
}

__global__ void dump_bf16(const bf16_t* src, size_t pitch, float* out) {
    const size_t i = (size_t)blockIdx.x * blockDim.x + threadIdx.x; const size_t r = i / 2048, c = i % 2048;
    out[i] = bf2f(src[r * pitch + c]);
}
__global__ void dump_f32(const float* src, float* out) { const size_t i = (size_t)blockIdx.x * blockDim.x + threadIdx.x; out[i] = src[i]; }
__global__ void dump_mix(const unsigned char* ws, float* out) {
    const size_t i = (size_t)blockIdx.x * blockDim.x + threadIdx.x; const size_t r = i / 2048, c = i % 2048;
    const bf16_t* P = (const bf16_t*)(ws + WS_P); const bf16_t* Yb = (const bf16_t*)(ws + WS_YB); const bf16_t* Yc = (const bf16_t*)(ws + WS_YC); const float* SUM = (const float*)(ws + WS_SUM); const float* lse = (const float*)(ws + WS_LSE);
    float v = 0.f;
#if PROBE_SEL & 1
    v += bf2f(P[r * PC + c]);
#endif
#if PROBE_SEL & 2
    v += bf2f(Yb[r * 1024 + (c & 1023)]);
#endif
#if PROBE_SEL & 4
    v += SUM[i % ((size_t)512 * 16384)];
#endif
#if PROBE_SEL & 8
    v += lse[i % ((size_t)3 * T * 4)];
#endif
#if PROBE_SEL & 16
    v += bf2f(Yc[r * 1024 + (c & 1023)]);
#endif
#if PROBE_SEL & 32
    v += bf2f(P[r * PC + PC_FF + (c & 1023)]);
#endif
#if PROBE_SEL & 64
    v += bf2f(P[r * PC + PC_FB + (c & 1023)]);
#endif
    if (!(v == v) || fabsf(v) > 1e30f) v = 12345.f;
    out[i] = v;
}
extern "C" void kernel_launch(void* const* d_in, const int* in_sizes, int n_in, void* d_out, int out_size, void* d_ws, size_t ws_size, hipStream_t stream) {
    static int grid = 0;
    if (grid == 0) {
        if (n_in != 11 || ws_size < WS_END) { fprintf(stderr, "kernel_launch: unexpected inputs (n_in %d, ws %zu)\n", n_in, ws_size); grid = -1; return; }
        int dev = 0, cus = 0, per_cu = 0;
        hipGetDevice(&dev); hipDeviceGetAttribute(&cus, hipDeviceAttributeMultiprocessorCount, dev);
        hipFuncSetAttribute((const void*)fwd_megakernel, hipFuncAttributeMaxDynamicSharedMemorySize, LDS_BYTES);
        hipOccupancyMaxActiveBlocksPerMultiprocessor(&per_cu, (const void*)fwd_megakernel, NTHREADS, LDS_BYTES);
        if (per_cu < 1) per_cu = 1;
        grid = cus * per_cu;
    }
    if (grid < 0) return;
    Args a{};
    for (int i = 0; i < 11; ++i) a.in[i] = (const float*)d_in[i];
    a.out = (float*)d_out; a.ws = (unsigned char*)d_ws;
#ifdef PROBE_PHASES
    for (int ph = 0; ph < PROBE_PHASES; ++ph) { a.ph_lo = ph; a.ph_hi = ph + 1; hipLaunchKernelGGL(fwd_megakernel, dim3(grid), dim3(NTHREADS), LDS_BYTES, stream, a); }
    PROBE_DUMP
#elif defined(MULTI_LAUNCH)
    for (int ph = 0; ph < 17; ++ph) { a.ph_lo = ph; a.ph_hi = ph + 1; hipLaunchKernelGGL(fwd_megakernel, dim3(grid), dim3(NTHREADS), LDS_BYTES, stream, a); }
#else
    a.ph_lo = 0; a.ph_hi = 17;
    (void)hipMemsetAsync(d_ws, 0, 16384, stream);
    void* kargs[] = {&a};
    hipError_t e = hipLaunchCooperativeKernel((const void*)fwd_megakernel, dim3(grid), dim3(NTHREADS), kargs, LDS_BYTES, stream);
    if (e != hipSuccess) fprintf(stderr, "cooperative launch failed: %s (grid %d)\n", hipGetErrorString(e), grid);
#endif
}
```

```cpp
#include <hip/hip_runtime.h>
#include <hip/hip_cooperative_groups.h>
#include <cstdio>
#include <cstdint>
namespace cg = cooperative_groups;
namespace pg8 {
#define PG8_LAS __attribute__((address_space(3)))
typedef unsigned short bf16_t;
typedef short bf16x8 __attribute__((ext_vector_type(8)));
typedef float f32x4 __attribute__((ext_vector_type(4)));
typedef unsigned u32x4 __attribute__((ext_vector_type(4)));
constexpr int BM = 256, BK = 64, HALF = 128, HTB = HALF * BK * 2  , STAGE_BYTES = 8 * HTB, NXCD = 8, WGM = 8;

__host__ __device__ __forceinline__ int lds_byte(int r, int c) { const int st = (r >> 4) * 2 + (c >> 5), rr = r & 15, cc = c & 31, ob = rr * 64 + cc * 2; return st * 1024 + (ob ^ (((ob >> 9) & 1) << 5)); }
__host__ __device__ __forceinline__ void stage_rc(int b, int& R, int& C) { const int st = b / 1024, sb = b % 1024, swz = sb ^ (((sb >> 9) & 1) << 5); R = (st >> 1) * 16 + swz / 64; C = (st & 1) * 32 + (swz % 64) / 2; }
__host__ __device__ __forceinline__ int perm32(int rho) { const int n = rho >> 4, i = rho & 15; return 8 * (i >> 2) + 4 * n + (i & 3); }

struct Unit { int pm, pn; };
struct Gemm { const bf16_t* A; const bf16_t* Bt; int M, N, K; };

struct StaticOrder {
    int nM, nN, nwg, G, c;
    __host__ __device__ void init(int M, int N, int G_, int c_) { nM = M / BM; nN = N / BM; nwg = nM * nN; G = G_; c = c_; }
    __host__ __device__ bool next(int i, Unit& u) const {
        const long L = (long)i * G + c; if (L >= nwg) return false;
        int wgid = (int)L; { const int q = nwg / NXCD, r = nwg % NXCD, xcd = wgid % NXCD, off = wgid / NXCD; wgid = (xcd < r ? xcd * (q + 1) : r * (q + 1) + (xcd - r) * q) + off; }
        const int nig = WGM * nN, gid = wgid / nig, fm = gid * WGM, gsz = (nM - fm) < WGM ? (nM - fm) : WGM;
        u.pm = fm + ((wgid % nig) % gsz); u.pn = (wgid % nig) / gsz; return true;
    }
    __device__ __forceinline__ void a_ready(const Unit&) const {}
    __device__ __forceinline__ void done(const Unit&) const {}
};

__device__ __forceinline__ unsigned cvt_pk_bf16(float lo, float hi) { unsigned r; asm volatile("v_cvt_pk_bf16_f32 %0, %1, %2" : "=v"(r) : "v"(lo), "v"(hi)); return r; }
typedef int i32x4 __attribute__((ext_vector_type(4)));
template <int ES> __device__ __forceinline__ f32x4 pg8_mma(bf16x8 a, bf16x8 b, f32x4 c) {
    if constexpr (ES == 2) return __builtin_amdgcn_mfma_f32_16x16x32_bf16(a, b, c, 0, 0, 0);
    else return __builtin_bit_cast(f32x4, __builtin_amdgcn_mfma_i32_16x16x64_i8(__builtin_bit_cast(i32x4, a), __builtin_bit_cast(i32x4, b), __builtin_bit_cast(i32x4, c), 0, 0, 0));
}
template <class Epi, class Sched, bool ALIGN_EPI = false, bool SP2 = false, int ES = 2>
__device__ __forceinline__ void gemm_phase(PG8_LAS unsigned char* lds, const Gemm g, const Sched& S, const Epi& E) {
    int tid = threadIdx.x; asm volatile("" : "+v"(tid));
    const int wid = __builtin_amdgcn_readfirstlane(tid >> 6), lane = tid & 63, wr = wid >> 2, wc = wid & 3, fr = lane & 15, fq = lane >> 4;
    const int K = g.K, nt = (K * ES) / (BK * 2);
    unsigned voffA[2], voffB[2];
#pragma unroll
    for (int i = 0; i < 2; ++i) { int R, C; stage_rc(tid * 16 + i * 8192, R, C); const int Rb = Epi::PERM ? ((R & ~31) + perm32(R & 31)) : R;
        voffA[i] = (unsigned)(R * K * ES + C * 2); voffB[i] = (unsigned)(Rb * K * ES + C * 2); }
    const size_t kstep = (size_t)(BK * 2);
    const size_t hstep = (size_t)HALF * K * ES;
    const size_t tstep = 2 * hstep;
    const unsigned ldsw = (unsigned)wid * 1024u;
    const int aoff = lds_byte(wr * 64 + fr, fq * 8), boff = lds_byte(wc * 32 + fr, fq * 8);
#define PG8_SA(b, h) (((b) * 2 + (h)) * HTB)
#define PG8_SB(b, h) ((4 + (b) * 2 + (h)) * HTB)
#define PG8_STAGE(bufoff, gbase, voff) do { _Pragma("unroll") for (int _i = 0; _i < 2; ++_i) \
        __builtin_amdgcn_global_load_lds((const unsigned*)((const char*)(gbase) + (voff)[_i]), (PG8_LAS unsigned*)(lds + (bufoff) + ldsw + _i * 8192), 16, 0, 0); } while (0)
#define PG8_LDA(dst, b, h) do { _Pragma("unroll") for (int m = 0; m < 4; ++m) _Pragma("unroll") for (int k = 0; k < 2; ++k) dst[m][k] = *(const PG8_LAS bf16x8*)(lds + PG8_SA(b, h) + aoff + m * 2048 + k * 1024); } while (0)
#define PG8_LDB(dst, b, h) do { _Pragma("unroll") for (int n = 0; n < 2; ++n) _Pragma("unroll") for (int k = 0; k < 2; ++k) dst[n][k] = *(const PG8_LAS bf16x8*)(lds + PG8_SB(b, h) + boff + n * 2048 + k * 1024); } while (0)
#define PG8_MMA(ai, bj, At, Bt) do { __builtin_amdgcn_s_setprio(1); _Pragma("unroll") for (int m = 0; m < 4; ++m) _Pragma("unroll") for (int n = 0; n < 2; ++n) _Pragma("unroll") for (int k = 0; k < 2; ++k) \
        acc[ai][bj][m][n] = pg8_mma<ES>(Bt[n][k], At[m][k], acc[ai][bj][m][n]); __builtin_amdgcn_s_setprio(0); } while (0)
#define PG8_WAIT_V(n) asm volatile("s_waitcnt vmcnt(" #n ")" ::: "memory")
#define PG8_WAIT_L(n) asm volatile("s_waitcnt lgkmcnt(" #n ")" ::: "memory")
#define PG8_BAR __builtin_amdgcn_s_barrier()
#define PG8_SCHED __builtin_amdgcn_sched_barrier(0)
    Unit cur, nxt; int ui = 0;
    if (!S.next(0, cur)) return;
    f32x4 acc[2][2][4][2];
#pragma unroll
    for (int a = 0; a < 2; ++a)
#pragma unroll
        for (int b = 0; b < 2; ++b)
#pragma unroll
            for (int m = 0; m < 4; ++m)
#pragma unroll
                for (int n = 0; n < 2; ++n) acc[a][b][m][n] = (f32x4){0.f, 0.f, 0.f, 0.f};
    bf16x8 At[4][2], B0[2][2], B1[2][2];
    const char* cA = (const char*)g.A + (size_t)cur.pm * tstep; const char* cB = (const char*)g.Bt + (size_t)cur.pn * tstep;
    S.a_ready(cur);
    if constexpr (SP2) {
        PG8_STAGE(PG8_SB(0, 0), cB, voffB); PG8_STAGE(PG8_SB(0, 1), cB + hstep, voffB); PG8_STAGE(PG8_SA(0, 0), cA, voffA); PG8_STAGE(PG8_SA(0, 1), cA + hstep, voffA);
        if (wr == 1) PG8_BAR;
        PG8_WAIT_V(2); PG8_BAR;
        PG8_STAGE(PG8_SB(1, 0), cB + kstep, voffB); PG8_STAGE(PG8_SA(1, 0), cA + kstep, voffA); PG8_STAGE(PG8_SB(1, 1), cB + hstep + kstep, voffB);
        PG8_WAIT_V(6); PG8_BAR;
    } else {
        PG8_STAGE(PG8_SB(0, 0), cB, voffB); PG8_STAGE(PG8_SA(0, 0), cA, voffA); PG8_STAGE(PG8_SB(0, 1), cB + hstep, voffB); PG8_STAGE(PG8_SA(0, 1), cA + hstep, voffA);
        if (wr == 1) PG8_BAR;
        PG8_WAIT_V(4); PG8_BAR;
        PG8_STAGE(PG8_SB(1, 0), cB + kstep, voffB); PG8_STAGE(PG8_SA(1, 0), cA + kstep, voffA); PG8_STAGE(PG8_SB(1, 1), cB + hstep + kstep, voffB);
        PG8_WAIT_V(6); PG8_BAR;
    }
    for (;;) {
        const bool has_next = S.next(ui + 1, nxt);
        const char* nA = has_next ? (const char*)g.A + (size_t)nxt.pm * tstep : cA; const char* nB = has_next ? (const char*)g.Bt + (size_t)nxt.pn * tstep : cB;
        for (int t = 0; t < nt; t += 2) {
            const bool last = (t == nt - 2);
            const char* a1 = cA + (size_t)(t + 1) * kstep;
            const char* a2 = last ? nA : cA + (size_t)(t + 2) * kstep; const char* b2 = last ? nB : cB + (size_t)(t + 2) * kstep;
            const char* a3 = a2 + kstep; const char* b3 = b2 + kstep;
            if (last && has_next) S.a_ready(nxt);
            if constexpr (SP2) {
            PG8_LDB(B0, 0, 0); PG8_LDB(B1, 0, 1); PG8_SCHED; PG8_LDA(At, 0, 0); PG8_STAGE(PG8_SA(1, 1), a1 + hstep, voffA);
            PG8_WAIT_V(8); PG8_WAIT_L(0); PG8_BAR; PG8_MMA(0, 0, At, B0); PG8_MMA(0, 1, At, B1); PG8_BAR; PG8_SCHED;
            PG8_LDA(At, 0, 1); PG8_STAGE(PG8_SB(0, 0), b2, voffB); PG8_STAGE(PG8_SB(0, 1), b2 + hstep, voffB); PG8_STAGE(PG8_SA(0, 0), a2, voffA);
            PG8_WAIT_V(8); PG8_WAIT_L(0); PG8_BAR; PG8_MMA(1, 0, At, B0); PG8_MMA(1, 1, At, B1); PG8_BAR; PG8_SCHED;
            PG8_LDB(B0, 1, 0); PG8_LDB(B1, 1, 1); PG8_SCHED; PG8_LDA(At, 1, 0); PG8_STAGE(PG8_SA(0, 1), a2 + hstep, voffA);
            PG8_WAIT_V(8); PG8_WAIT_L(0); PG8_BAR; PG8_MMA(0, 0, At, B0); PG8_MMA(0, 1, At, B1); PG8_BAR; PG8_SCHED;
            PG8_LDA(At, 1, 1); PG8_STAGE(PG8_SB(1, 0), b3, voffB); PG8_STAGE(PG8_SB(1, 1), b3 + hstep, voffB); PG8_STAGE(PG8_SA(1, 0), a3, voffA);
            PG8_WAIT_V(8); PG8_WAIT_L(0); PG8_BAR; PG8_MMA(1, 0, At, B0); PG8_MMA(1, 1, At, B1); PG8_BAR; PG8_SCHED;
            } else {
            PG8_LDB(B0, 0, 0); PG8_SCHED; PG8_LDA(At, 0, 0); PG8_STAGE(PG8_SA(1, 1), a1 + hstep, voffA);
            PG8_WAIT_L(8); PG8_BAR; PG8_WAIT_L(0); PG8_MMA(0, 0, At, B0); PG8_BAR; PG8_SCHED;
            PG8_LDB(B1, 0, 1); PG8_STAGE(PG8_SB(0, 0), b2, voffB);
            PG8_BAR; PG8_WAIT_L(0); PG8_MMA(0, 1, At, B1); PG8_BAR;
            PG8_LDA(At, 0, 1); PG8_STAGE(PG8_SA(0, 0), a2, voffA);
            PG8_BAR; PG8_WAIT_L(0); PG8_MMA(1, 0, At, B0); PG8_BAR; PG8_SCHED;
            PG8_STAGE(PG8_SB(0, 1), b2 + hstep, voffB);
            PG8_WAIT_V(6); PG8_BAR; PG8_MMA(1, 1, At, B1); PG8_BAR;
            PG8_LDB(B0, 1, 0); PG8_SCHED; PG8_LDA(At, 1, 0); PG8_STAGE(PG8_SA(0, 1), a2 + hstep, voffA);
            PG8_WAIT_L(8); PG8_BAR; PG8_WAIT_L(0); PG8_MMA(0, 0, At, B0); PG8_BAR; PG8_SCHED;
            PG8_LDB(B1, 1, 1); PG8_STAGE(PG8_SB(1, 0), b3, voffB);
            PG8_BAR; PG8_WAIT_L(0); PG8_MMA(0, 1, At, B1); PG8_BAR;
            PG8_LDA(At, 1, 1); PG8_STAGE(PG8_SA(1, 0), a3, voffA);
            PG8_BAR; PG8_WAIT_L(0); PG8_MMA(1, 0, At, B0); PG8_BAR; PG8_SCHED;
            PG8_STAGE(PG8_SB(1, 1), b3 + hstep, voffB);
            PG8_WAIT_V(6); PG8_BAR; PG8_MMA(1, 1, At, B1); PG8_BAR;
            }
        }
        if constexpr (ALIGN_EPI) { if (wr == 0) PG8_BAR; }
        if constexpr (!Epi::AFTER_DRAIN) { E(acc, cur, wr, wc, fr, fq); S.done(cur); }
        if (!has_next) break;
#pragma unroll
        for (int a = 0; a < 2; ++a)
#pragma unroll
            for (int b = 0; b < 2; ++b)
#pragma unroll
                for (int m = 0; m < 4; ++m)
#pragma unroll
                    for (int n = 0; n < 2; ++n) acc[a][b][m][n] = (f32x4){0.f, 0.f, 0.f, 0.f};
        cur = nxt; cA = nA; cB = nB; ++ui;
        if constexpr (ALIGN_EPI) { if (wr == 1) PG8_BAR; }
    }
    PG8_WAIT_V(0);
    if constexpr (!ALIGN_EPI) { if (wr == 0) PG8_BAR; }
    PG8_BAR;
    if constexpr (Epi::AFTER_DRAIN) { E.fused(acc, cur, wr, wc, fr, fq, lds, wid, lane); S.done(cur); }
#undef PG8_SA
#undef PG8_SB
#undef PG8_STAGE
#undef PG8_LDA
#undef PG8_LDB
#undef PG8_MMA
#undef PG8_WAIT_V
#undef PG8_WAIT_L
#undef PG8_BAR
#undef PG8_SCHED
}
}

#define LAS __attribute__((address_space(3)))
typedef unsigned short bf16_t;
typedef short bf16x8 __attribute__((ext_vector_type(8)));
typedef short bf16x4 __attribute__((ext_vector_type(4)));
typedef float f32x4 __attribute__((ext_vector_type(4)));
typedef unsigned u32x4 __attribute__((ext_vector_type(4)));
typedef unsigned u32x2 __attribute__((ext_vector_type(2)));

constexpr int T = 32768, S = 16384, D = 2048;
constexpr int PC = 10240;
constexpr int NGATE = 2560, NMERGE = 6144, NIN = 18944;
constexpr int PA_Q = 0, PA_K = 1536, PA_V = 3072, PB_Q = 4608, PB_K = 5632, PB_V = 5888, PC_Q = 6144, PC_FF = 7168, PC_FB = 8192, PC_I = 9216;
constexpr float NORM_EPS = 1e-6f;
constexpr size_t MiB = 1u << 20;
constexpr size_t WS_ROPE = 1 * MiB, WS_LSE = 3 * MiB, WS_LB = 5 * MiB, WS_LSUM = 5 * MiB + 65536;
constexpr size_t WS_WIN = 6 * MiB, WS_WA = 80 * MiB, WS_WB = 82 * MiB, WS_WC = 86 * MiB, WS_WO = 90 * MiB;
constexpr size_t WS_XN = 98 * MiB, WS_YA = 226 * MiB, WS_YB = 258 * MiB, WS_YC = 322 * MiB, WS_SUM = 386 * MiB, WS_P = 418 * MiB, WS_END = 1058 * MiB;
constexpr size_t WS_G = WS_P + 3072, WS_YM = WS_XN, WS_OUT = WS_P;
constexpr int G_PITCH = PC * 2;
constexpr size_t WS_XN8 = 1058 * MiB, WS_WM8 = 1122 * MiB, WS_END8 = 1134 * MiB;
constexpr float Q_SX = 21.0f, Q_SW = 960.0f;
constexpr int LDS_BYTES = 163840;
constexpr int NTHREADS = 512;
#ifndef NLAYER
#define NLAYER 2
#endif

__device__ __forceinline__ float bf2f(unsigned short b) { return __builtin_bit_cast(float, (unsigned)b << 16); }
__device__ __forceinline__ float bf2f_s(short b) { return __builtin_bit_cast(float, ((unsigned)(unsigned short)b) << 16); }
typedef float f32x2_t __attribute__((ext_vector_type(2))); typedef __bf16 bf16x2_t __attribute__((ext_vector_type(2)));
__device__ __forceinline__ unsigned pk2(float lo, float hi) { f32x2_t v = {lo, hi}; bf16x2_t b = __builtin_convertvector(v, bf16x2_t); return __builtin_bit_cast(unsigned, b); }
__device__ __forceinline__ float wave_sum(float v) {
#pragma unroll
    for (int o = 1; o < 64; o <<= 1) v += __shfl_xor(v, o);
    return v;
}
__device__ __forceinline__ f32x4 mfma16(bf16x8 a, bf16x8 b, f32x4 c) { return __builtin_amdgcn_mfma_f32_16x16x32_bf16(a, b, c, 0, 0, 0); }
__device__ __forceinline__ float fast_sigmoid(float x) { return __builtin_amdgcn_rcpf(1.0f + __expf(-x)); }

__device__ __forceinline__ unsigned q8x4(float a, float b, float c, float d, float sc) {
    const int ia = __builtin_amdgcn_fmed3f(rintf(a * sc), -127.f, 127.f), ib = __builtin_amdgcn_fmed3f(rintf(b * sc), -127.f, 127.f);
    const int ic = __builtin_amdgcn_fmed3f(rintf(c * sc), -127.f, 127.f), id = __builtin_amdgcn_fmed3f(rintf(d * sc), -127.f, 127.f);
    return (unsigned)(ia & 0xff) | ((unsigned)(ib & 0xff) << 8) | ((unsigned)(ic & 0xff) << 16) | ((unsigned)(id & 0xff) << 24);
}
__device__ __forceinline__ void transpose_item(const float* W, int K, int N, bf16_t* WT, int drow, LAS float* scr, int k0, int n0, int lane, signed char* WT8 = nullptr) {
#pragma unroll
    for (int i = 0; i < 32; ++i) { const int kk = 2 * i + (lane >> 5); scr[kk * 33 + (lane & 31)] = W[(size_t)(k0 + kk) * N + n0 + (lane & 31)]; }
    asm volatile("s_waitcnt lgkmcnt(0)" ::: "memory");
    const int c = lane & 7;
#pragma unroll
    for (int j = 0; j < 4; ++j) { const int n = (lane >> 3) + 8 * j; const LAS float* s = scr + (8 * c) * 33 + n;
        u32x4 o; o.x = pk2(s[0 * 33], s[1 * 33]); o.y = pk2(s[2 * 33], s[3 * 33]); o.z = pk2(s[4 * 33], s[5 * 33]); o.w = pk2(s[6 * 33], s[7 * 33]);
        *(u32x4*)(WT + (size_t)(drow + n) * K + k0 + 8 * c) = o;
        if (WT8) { u32x2 q; q.x = q8x4(s[0 * 33], s[1 * 33], s[2 * 33], s[3 * 33], Q_SW); q.y = q8x4(s[4 * 33], s[5 * 33], s[6 * 33], s[7 * 33], Q_SW); *(u32x2*)(WT8 + (size_t)(drow - 12800 + n) * K + k0 + 8 * c) = q; } }
    asm volatile("s_waitcnt lgkmcnt(0)" ::: "memory");
}
__device__ __forceinline__ int win_dst(int n) {
    if (n < 4608) return n;
    if (n < 5120) return 10240 + (n - 4608);
    if (n < 6656) return 4608 + (n - 5120);
    if (n < 7680) return 10240 + 512 + (n - 6656);
    if (n < 11776) return 6144 + (n - 7680);
    if (n < 12800) return 10240 + 1536 + (n - 11776);
    return n;
}
struct Weights { const float *win, *wa, *wb, *wc, *wo; };
__device__ __forceinline__ void transpose_weights(const Weights& Wt, unsigned char* ws, LAS unsigned char* lds, int gw, int NGW, int wave, int lane) {
    LAS float* scr = (LAS float*)(lds + wave * 8448);
    constexpr int I_IN = 32 * (NIN / 32), I_A = 8 * 64, I_B = 16 * 64, I_C = 16 * 64, I_O = 32 * 64;
    constexpr int NITEMS = I_IN + I_A + I_B + I_C + I_O;
    for (int it = gw; it < NITEMS; it += NGW) {
        int r = it;
        if (r < I_IN) { const int nb = r % (NIN / 32), kb = r / (NIN / 32); transpose_item(Wt.win, D, NIN, (bf16_t*)(ws + WS_WIN), win_dst(nb * 32), scr, kb * 64, nb * 32, lane, nb * 32 >= 12800 ? (signed char*)(ws + WS_WM8) : nullptr); continue; } r -= I_IN;
        if (r < I_A) { const int nb = r % 64, kb = r / 64; transpose_item(Wt.wa, 512, D, (bf16_t*)(ws + WS_WA), nb * 32, scr, kb * 64, nb * 32, lane); continue; } r -= I_A;
        if (r < I_B) { const int nb = r % 64, kb = r / 64; transpose_item(Wt.wb, 1024, D, (bf16_t*)(ws + WS_WB), nb * 32, scr, kb * 64, nb * 32, lane); continue; } r -= I_B;
        if (r < I_C) { const int nb = r % 64, kb = r / 64; transpose_item(Wt.wc, 1024, D, (bf16_t*)(ws + WS_WC), nb * 32, scr, kb * 64, nb * 32, lane); continue; } r -= I_C;
        { const int nb = r % 64, kb = r / 64; transpose_item(Wt.wo, D, D, (bf16_t*)(ws + WS_WO), nb * 32, scr, kb * 64, nb * 32, lane); }
    }
}
__device__ __forceinline__ void prenorm_row(const float* xrow, const float* gain, bf16_t* orow, unsigned* orow8, int lane) {
    f32x4 v[8]; float s = 0.f;
#pragma unroll
    for (int j = 0; j < 8; ++j) { v[j] = ((const f32x4*)xrow)[lane + 64 * j]; s += (v[j].x * v[j].x + v[j].y * v[j].y) + (v[j].z * v[j].z + v[j].w * v[j].w); }
    const float r = 1.0f / sqrtf(wave_sum(s) * (1.0f / D) + NORM_EPS);
#pragma unroll
    for (int j = 0; j < 8; ++j) { const f32x4 g = ((const f32x4*)gain)[lane + 64 * j]; const float a = v[j].x * r * g.x, b = v[j].y * r * g.y, c = v[j].z * r * g.z, d = v[j].w * r * g.w;
        u32x2 o; o.x = pk2(a, b); o.y = pk2(c, d); ((u32x2*)orow)[lane + 64 * j] = o; orow8[lane + 64 * j] = q8x4(a, b, c, d, Q_SX); }
}
template <int NR>
__device__ __forceinline__ void final_rows(const bf16_t* const (&orow)[NR], const float* post, const float* const (&xold)[NR], float* const (&xnew)[NR], const float* pre_next, bf16_t* const (&xn_next)[NR], unsigned* const (&xn8_next)[NR], int lane) {
    f32x4 v[NR][8], xo[NR][8]; float s[NR];
#pragma unroll
    for (int q = 0; q < NR; ++q) { s[q] = 0.f;
#pragma unroll
        for (int j = 0; j < 8; ++j) { const u32x2 r = ((const u32x2*)orow[q])[lane + 64 * j];
            v[q][j].x = __builtin_bit_cast(float, r.x << 16); v[q][j].y = __builtin_bit_cast(float, r.x & 0xffff0000u); v[q][j].z = __builtin_bit_cast(float, r.y << 16); v[q][j].w = __builtin_bit_cast(float, r.y & 0xffff0000u);
            s[q] += (v[q][j].x * v[q][j].x + v[q][j].y * v[q][j].y) + (v[q][j].z * v[q][j].z + v[q][j].w * v[q][j].w); }
#pragma unroll
        for (int j = 0; j < 8; ++j) xo[q][j] = ((const f32x4*)xold[q])[lane + 64 * j]; }
#pragma unroll
    for (int q = 0; q < NR; ++q) {
        const float r = 1.0f / sqrtf(wave_sum(s[q]) * (1.0f / D) + NORM_EPS);
        float s2 = 0.f;
#pragma unroll
        for (int j = 0; j < 8; ++j) { const f32x4 g = ((const f32x4*)post)[lane + 64 * j];
            f32x4 y; y.x = xo[q][j].x + v[q][j].x * r * g.x; y.y = xo[q][j].y + v[q][j].y * r * g.y; y.z = xo[q][j].z + v[q][j].z * r * g.z; y.w = xo[q][j].w + v[q][j].w * r * g.w;
            v[q][j] = y; s2 += (y.x * y.x + y.y * y.y) + (y.z * y.z + y.w * y.w); ((f32x4*)xnew[q])[lane + 64 * j] = y; }
        if (pre_next) {
            const float r2 = 1.0f / sqrtf(wave_sum(s2) * (1.0f / D) + NORM_EPS);
#pragma unroll
            for (int j = 0; j < 8; ++j) { const f32x4 g = ((const f32x4*)pre_next)[lane + 64 * j]; const float a = v[q][j].x * r2 * g.x, b = v[q][j].y * r2 * g.y, c = v[q][j].z * r2 * g.z, d = v[q][j].w * r2 * g.w;
                u32x2 o; o.x = pk2(a, b); o.y = pk2(c, d); ((u32x2*)xn_next[q])[lane + 64 * j] = o; xn8_next[q][lane + 64 * j] = q8x4(a, b, c, d, Q_SX); }
        }
    }
}

#define EPI_LOOP_BEGIN \
    const int row0 = u.pm * 256 + wr * 64 + fr; const int colb = u.pn * 256 + wc * 32 + 8 * fq; \
    _Pragma("unroll") for (int ai = 0; ai < 2; ++ai) _Pragma("unroll") for (int m = 0; m < 4; ++m) { const int row = row0 + ai * 128 + m * 16; \
    _Pragma("unroll") for (int bj = 0; bj < 2; ++bj) { const int col = colb + bj * 128; const f32x4 v0 = acc[ai][bj][m][0], v1 = acc[ai][bj][m][1];
#define EPI_LOOP_END } }

struct EpiStoreBf16 {
    static constexpr bool PERM = true, AFTER_DRAIN = false;
    bf16_t* O; int ldc;
    __device__ __forceinline__ void operator()(const f32x4 (&acc)[2][2][4][2], const pg8::Unit& u, int wr, int wc, int fr, int fq) const {
        EPI_LOOP_BEGIN
            u32x4 w; w.x = pk2(v0[0], v0[1]); w.y = pk2(v0[2], v0[3]); w.z = pk2(v1[0], v1[1]); w.w = pk2(v1[2], v1[3]);
            *(u32x4*)(O + (size_t)row * ldc + col) = w;
        EPI_LOOP_END
    }
};
struct EpiStoreRope {
    static constexpr bool PERM = true, AFTER_DRAIN = false;
    bf16_t* O; int ldc;
    __device__ __forceinline__ void operator()(const f32x4 (&acc)[2][2][4][2], const pg8::Unit& u, int wr, int wc, int fr, int fq) const {
        const bool rt = (wc == 0) && ((u.pn < 12) || (u.pn >= 18 && u.pn < 23));
        const float sgn = (fq < 2) ? -1.f : 1.f;
        const int row0 = u.pm * 256 + wr * 64 + fr; const int colb = u.pn * 256 + wc * 32 + 8 * fq;
        float irev[8];
        if (rt) {
#pragma unroll
            for (int i = 0; i < 8; ++i) irev[i] = __builtin_amdgcn_exp2f(-(float)((fq & 1) * 8 + i) * (18.931568569324174f / 16.0f) - 2.651496129472319f);
        }
#pragma unroll
        for (int ai = 0; ai < 2; ++ai)
#pragma unroll
            for (int m = 0; m < 4; ++m) { const int row = row0 + ai * 128 + m * 16;
                float cs[8], sn[8];
                if (rt) { const float pos = (float)(row & (S - 1));
#pragma unroll
                    for (int i = 0; i < 8; ++i) { const float fr_ = __builtin_amdgcn_fractf(pos * irev[i]); cs[i] = __builtin_amdgcn_cosf(fr_); sn[i] = sgn * __builtin_amdgcn_sinf(fr_); } }
#pragma unroll
                for (int bj = 0; bj < 2; ++bj) { const int col = colb + bj * 128; const f32x4 v0 = acc[ai][bj][m][0], v1 = acc[ai][bj][m][1];
                    float y[8] = {v0[0], v0[1], v0[2], v0[3], v1[0], v1[1], v1[2], v1[3]};
                    if (rt) {
#pragma unroll
                        for (int i = 0; i < 8; ++i) { const float pt = __shfl_xor(y[i], 32); y[i] = y[i] * cs[i] + pt * sn[i]; } }
                    if (u.pn >= 24 && u.pn < 28) {
#pragma unroll
                        for (int i = 0; i < 8; ++i) y[i] = y[i] * fast_sigmoid(y[i]); }
                    u32x4 w; w.x = pk2(y[0], y[1]); w.y = pk2(y[2], y[3]); w.z = pk2(y[4], y[5]); w.w = pk2(y[6], y[7]);
                    *(u32x4*)(O + (size_t)row * ldc + col) = w; } }
    }
};
struct EpiSigmoidBf16 {
    static constexpr bool PERM = true, AFTER_DRAIN = false;
    bf16_t* O; int ldc;
    __device__ __forceinline__ void operator()(const f32x4 (&acc)[2][2][4][2], const pg8::Unit& u, int wr, int wc, int fr, int fq) const {
        EPI_LOOP_BEGIN
            u32x4 w; w.x = pk2(fast_sigmoid(v0[0]), fast_sigmoid(v0[1])); w.y = pk2(fast_sigmoid(v0[2]), fast_sigmoid(v0[3]));
            w.z = pk2(fast_sigmoid(v1[0]), fast_sigmoid(v1[1])); w.w = pk2(fast_sigmoid(v1[2]), fast_sigmoid(v1[3]));
            *(u32x4*)(O + (size_t)row * ldc + col) = w;
        EPI_LOOP_END
    }
};
struct EpiSigmoidI8 {
    static constexpr bool PERM = true, AFTER_DRAIN = false;
    unsigned char* O; int ldc; float dq;
    __device__ __forceinline__ void operator()(const f32x4 (&acc)[2][2][4][2], const pg8::Unit& u, int wr, int wc, int fr, int fq) const {
        EPI_LOOP_BEGIN
            const pg8::i32x4 i0 = __builtin_bit_cast(pg8::i32x4, v0), i1 = __builtin_bit_cast(pg8::i32x4, v1);
            unsigned b[8];
#pragma unroll
            for (int i = 0; i < 4; ++i) { b[i] = (unsigned)(255.0f * fast_sigmoid((float)i0[i] * dq) + 0.5f); b[4 + i] = (unsigned)(255.0f * fast_sigmoid((float)i1[i] * dq) + 0.5f); }
            u32x2 w; w.x = b[0] | (b[1] << 8) | (b[2] << 16) | (b[3] << 24); w.y = b[4] | (b[5] << 8) | (b[6] << 16) | (b[7] << 24);
            *(u32x2*)(O + (size_t)row * ldc + col) = w;
        EPI_LOOP_END
    }
};
struct EpiStoreF32 {
    static constexpr bool PERM = true, AFTER_DRAIN = false;
    float* O; int ldc;
    __device__ __forceinline__ void operator()(const f32x4 (&acc)[2][2][4][2], const pg8::Unit& u, int wr, int wc, int fr, int fq) const {
        EPI_LOOP_BEGIN
            float* p = O + (size_t)row * ldc + col; *(f32x4*)p = v0; *(f32x4*)(p + 4) = v1;
        EPI_LOOP_END
    }
};
__device__ __forceinline__ void unpack8(const u32x4 g, float (&f)[8]) {
    f[0] = __builtin_bit_cast(float, g.x << 16); f[1] = __builtin_bit_cast(float, g.x & 0xffff0000u); f[2] = __builtin_bit_cast(float, g.y << 16); f[3] = __builtin_bit_cast(float, g.y & 0xffff0000u);
    f[4] = __builtin_bit_cast(float, g.z << 16); f[5] = __builtin_bit_cast(float, g.z & 0xffff0000u); f[6] = __builtin_bit_cast(float, g.w << 16); f[7] = __builtin_bit_cast(float, g.w & 0xffff0000u);
}
template <bool FIRST> struct EpiBranch {
    static constexpr bool PERM = true, AFTER_DRAIN = false;
    bf16_t* YM; const unsigned char* G; int br;
    __device__ __forceinline__ void operator()(const f32x4 (&acc)[2][2][4][2], const pg8::Unit& u, int wr, int wc, int fr, int fq) const {
        const int row0 = u.pm * 256 + wr * 64 + fr; const int colb = u.pn * 256 + wc * 32 + 8 * fq;
#pragma unroll
        for (int ai = 0; ai < 2; ++ai) {
            u32x2 gv[4][2]; u32x4 yv[4][2];
#pragma unroll
            for (int m = 0; m < 4; ++m)
#pragma unroll
                for (int bj = 0; bj < 2; ++bj) { const int row = row0 + ai * 128 + m * 16, col = colb + bj * 128;
                    gv[m][bj] = *(const u32x2*)(G + (size_t)row * G_PITCH + br * 2048 + col);
                    if (!FIRST) yv[m][bj] = *(const u32x4*)(YM + (size_t)row * D + col); }
#pragma unroll
            for (int m = 0; m < 4; ++m)
#pragma unroll
                for (int bj = 0; bj < 2; ++bj) { const int row = row0 + ai * 128 + m * 16, col = colb + bj * 128; const f32x4 v0 = acc[ai][bj][m][0], v1 = acc[ai][bj][m][1];
                    float g[8], y[8];
#pragma unroll
                    for (int i = 0; i < 4; ++i) { g[i] = (float)((gv[m][bj].x >> (8 * i)) & 0xffu) * (1.0f / 255.0f); g[4 + i] = (float)((gv[m][bj].y >> (8 * i)) & 0xffu) * (1.0f / 255.0f); }
                    y[0] = v0[0] * g[0]; y[1] = v0[1] * g[1]; y[2] = v0[2] * g[2]; y[3] = v0[3] * g[3]; y[4] = v1[0] * g[4]; y[5] = v1[1] * g[5]; y[6] = v1[2] * g[6]; y[7] = v1[3] * g[7];
                    if (!FIRST) { float o[8]; unpack8(yv[m][bj], o);
#pragma unroll
                        for (int i = 0; i < 8; ++i) y[i] += o[i]; }
                    u32x4 w; w.x = pk2(y[0], y[1]); w.y = pk2(y[2], y[3]); w.z = pk2(y[4], y[5]); w.w = pk2(y[6], y[7]);
                    *(u32x4*)(YM + (size_t)row * D + col) = w; }
        }
    }
};
struct EpiGate {
    static constexpr bool PERM = true, AFTER_DRAIN = false;
    bf16_t *Ya, *Yb, *Yc; const bf16_t* P; const float* lse;
    __device__ __forceinline__ void operator()(const f32x4 (&acc)[2][2][4][2], const pg8::Unit& u, int wr, int wc, int fr, int fq) const {
        const int row0 = u.pm * 256 + wr * 64 + fr; const int colb = u.pn * 256 + wc * 32 + 8 * fq;
        if (u.pn >= 2) {
            bf16_t* Y = (u.pn < 6) ? Yb : Yc; const int cofs = (u.pn < 6) ? 512 : 1536;
#pragma unroll
            for (int ai = 0; ai < 2; ++ai) {
                u32x4 rv[4][2];
#pragma unroll
                for (int m = 0; m < 4; ++m)
#pragma unroll
                    for (int bj = 0; bj < 2; ++bj) rv[m][bj] = *(const u32x4*)(Y + (size_t)(row0 + ai * 128 + m * 16) * 1024 + (colb + bj * 128 - cofs));
#pragma unroll
                for (int m = 0; m < 4; ++m)
#pragma unroll
                    for (int bj = 0; bj < 2; ++bj) { const f32x4 v0 = acc[ai][bj][m][0], v1 = acc[ai][bj][m][1];
                        float raw[8]; unpack8(rv[m][bj], raw);
                        const float a[8] = {v0[0], v0[1], v0[2], v0[3], v1[0], v1[1], v1[2], v1[3]};
                        float y[8];
#pragma unroll
                        for (int i = 0; i < 8; ++i) y[i] = raw[i] * a[i] * fast_sigmoid(a[i]);
                        u32x4 w; w.x = pk2(y[0], y[1]); w.y = pk2(y[2], y[3]); w.z = pk2(y[4], y[5]); w.w = pk2(y[6], y[7]);
                        *(u32x4*)(Y + (size_t)(row0 + ai * 128 + m * 16) * 1024 + (colb + bj * 128 - cofs)) = w; }
            }
        } else {
#pragma unroll
            for (int ai = 0; ai < 2; ++ai)
#pragma unroll
                for (int mp = 0; mp < 4; ++mp) {
                    u32x4 ov[1][2][3]; float lv[1][2][3];
#pragma unroll
                    for (int mm = 0; mm < 1; ++mm)
#pragma unroll
                        for (int bj = 0; bj < 2; ++bj) { const int row = row0 + ai * 128 + (mp + mm) * 16, col = colb + bj * 128, slot = col >> 7;
#pragma unroll
                            for (int g = 0; g < 3; ++g) { ov[mm][bj][g] = *(const u32x4*)(P + (size_t)row * PC + g * 512 + col); lv[mm][bj][g] = lse[((size_t)g * T + row) * 4 + slot]; } }
#pragma unroll
                    for (int mm = 0; mm < 1; ++mm)
#pragma unroll
                        for (int bj = 0; bj < 2; ++bj) { const int m = mp + mm; const int row = row0 + ai * 128 + m * 16, col = colb + bj * 128; const f32x4 v0 = acc[ai][bj][m][0], v1 = acc[ai][bj][m][1];
                            const float l0 = lv[mm][bj][0], l1 = lv[mm][bj][1], l2 = lv[mm][bj][2];
                            const float mx = fmaxf(l0, fmaxf(l1, l2)); float e0 = __expf(l0 - mx), e1 = __expf(l1 - mx), e2 = __expf(l2 - mx);
                            const float inv = 1.0f / (e0 + e1 + e2); e0 *= inv; e1 *= inv; e2 *= inv;
                            float o0[8], o1[8], o2[8]; unpack8(ov[mm][bj][0], o0); unpack8(ov[mm][bj][1], o1); unpack8(ov[mm][bj][2], o2);
                            const float a[8] = {v0[0], v0[1], v0[2], v0[3], v1[0], v1[1], v1[2], v1[3]};
                            float y[8];
#pragma unroll
                            for (int i = 0; i < 8; ++i) y[i] = (e0 * o0[i] + e1 * o1[i] + e2 * o2[i]) * a[i] * fast_sigmoid(a[i]);
                            u32x4 w; w.x = pk2(y[0], y[1]); w.y = pk2(y[2], y[3]); w.z = pk2(y[4], y[5]); w.w = pk2(y[6], y[7]);
                            *(u32x4*)(Ya + (size_t)row * 512 + col) = w; }
                }
        }
    }
};

constexpr int KP = 136;
struct AttnSrc { const bf16_t* Kg; const bf16_t* Vg; const bf16_t* Qrow; long tok0; int dil, kbase, L; };
template <int NKK, int NKV> struct StageRegs { bf16x8 k[(NKK * 16 + 511) / 512]; bf16x8 v[((NKV / 16) * 4 + 7) / 8]; bf16x8 q[4]; };
template <int NKK, int NKV, bool WITHQ>
__device__ __forceinline__ void stage_load(StageRegs<NKK, NKV>& R, const AttnSrc& A, int tid) {
    constexpr int KI = (NKK * 16 + 511) / 512, VI = ((NKV / 16) * 4 + 7) / 8;
    const int wave = tid >> 6, lane = tid & 63;
#pragma unroll
    for (int i = 0; i < KI; ++i) { const int task = tid + i * 512; const int row = task >> 4, c = task & 15; const int ki = A.kbase + row;
        bf16x8 v = (bf16x8){0, 0, 0, 0, 0, 0, 0, 0};
        if (task < NKK * 16 && ki >= 0 && ki < A.L) v = *(const bf16x8*)(A.Kg + (size_t)(A.tok0 + (long)ki * A.dil) * PC + c * 8);
        R.k[i] = v; }
#pragma unroll
    for (int i = 0; i < VI; ++i) { const int it = wave + 8 * i; const int row = (it >> 2) * 16 + (lane & 15), c = (it & 3) * 4 + (lane >> 4); const int ki = A.kbase + row;
        bf16x8 v = (bf16x8){0, 0, 0, 0, 0, 0, 0, 0};
        if (it < (NKV / 16) * 4 && ki >= 0 && ki < A.L) v = *(const bf16x8*)(A.Vg + (size_t)(A.tok0 + (long)ki * A.dil) * PC + c * 8);
        R.v[i] = v; }
    if (WITHQ) {
#pragma unroll
        for (int ks = 0; ks < 4; ++ks) R.q[ks] = *(const bf16x8*)(A.Qrow + ks * 32 + (lane >> 4) * 8); }
}
template <int NKK, int NKV, int VP>
__device__ __forceinline__ void stage_store(const StageRegs<NKK, NKV>& R, LAS bf16_t* Ks, LAS bf16_t* Vt, int tid) {
    constexpr int KI = (NKK * 16 + 511) / 512, VI = ((NKV / 16) * 4 + 7) / 8;
    const int wave = tid >> 6, lane = tid & 63;
#pragma unroll
    for (int i = 0; i < KI; ++i) { const int task = tid + i * 512; const int row = task >> 4, c = task & 15;
        if (task < NKK * 16) *(LAS bf16x8*)(Ks + row * KP + c * 8) = R.k[i]; }
#pragma unroll
    for (int i = 0; i < VI; ++i) { const int it = wave + 8 * i; const int row = (it >> 2) * 16 + (lane & 15), c = (it & 3) * 4 + (lane >> 4);
        if (it < (NKV / 16) * 4) {
            const u32x4 wv = __builtin_bit_cast(u32x4, R.v[i]); const bool odd = lane & 1;
            const unsigned rx = __shfl_xor(odd ? wv.x : wv.z, 1), ry = __shfl_xor(odd ? wv.y : wv.w, 1);
            const unsigned a0 = odd ? rx : wv.x, b0 = odd ? wv.z : rx, a1 = odd ? ry : wv.y, b1 = odd ? wv.w : ry;
            LAS unsigned* vp = (LAS unsigned*)(Vt + (c * 8 + (odd ? 4 : 0)) * VP + (row & ~1));
            vp[0] = (a0 & 0xffffu) | (b0 << 16); vp[VP / 2] = (a0 >> 16) | (b0 & 0xffff0000u);
            vp[VP] = (a1 & 0xffffu) | (b1 << 16); vp[VP + VP / 2] = (a1 >> 16) | (b1 & 0xffff0000u); } }
}
template <int NT, int VP>
__device__ __forceinline__ void attn_wave(const LAS bf16_t* Ks, const LAS bf16_t* Vt, int kt0, const bf16x8 (&qf)[4], int qi, int kbase, int L, int hw,
                                          bool has_sink, float sink, f32x4 (&o)[8], float& lse_out, int lane) {
    const int lr = lane & 15, lq = lane >> 4;
    f32x4 s[NT];
#pragma unroll
    for (int kt = 0; kt < NT - 1; ++kt) { f32x4 a = (f32x4){0.f, 0.f, 0.f, 0.f}; const LAS bf16_t* kp = Ks + (kt0 + 16 * kt + lr) * KP + lq * 8;
#pragma unroll
        for (int ks = 0; ks < 4; ++ks) a = mfma16(*(const LAS bf16x8*)(kp + ks * 32), qf[ks], a);
        s[kt] = a; }
    s[NT - 1] = (f32x4){-INFINITY, -INFINITY, -INFINITY, -INFINITY};
    const bool edge = (kbase + kt0 < 0) || (kbase + kt0 + 16 * NT > L);
#pragma unroll
    for (int kt = 0; kt < NT - 1; ++kt) {
        if (kt == 0 || kt == NT - 2 || edge) {
#pragma unroll
            for (int j = 0; j < 4; ++j) { const int ki = kbase + kt0 + 16 * kt + lq * 4 + j; const int rel = ki - qi;
                const bool ok = (ki >= 0) && (ki < L) && (rel <= hw) && (rel >= -hw);
                s[kt][j] = ok ? s[kt][j] : -INFINITY; } }
    }
    float m = -INFINITY;
#pragma unroll
    for (int kt = 0; kt < NT - 1; ++kt) m = fmaxf(fmaxf(m, fmaxf(s[kt][0], s[kt][1])), fmaxf(s[kt][2], s[kt][3]));
    m = fmaxf(m, __shfl_xor(m, 16)); m = fmaxf(m, __shfl_xor(m, 32));
    const float sc = 0.08838834764831845f * 1.4426950408889634f;
    float m2 = m * sc;
    if (has_sink) m2 = fmaxf(m2, sink * 1.4426950408889634f);
    float den = 0.f;
#pragma unroll
    for (int kt = 0; kt < NT - 1; ++kt)
#pragma unroll
        for (int j = 0; j < 4; ++j) { const float p = __builtin_amdgcn_exp2f(s[kt][j] * sc - m2); s[kt][j] = p; den += p; }
    s[NT - 1] = (f32x4){0.f, 0.f, 0.f, 0.f};
    den += __shfl_xor(den, 16); den += __shfl_xor(den, 32);
    if (has_sink) den += __builtin_amdgcn_exp2f(sink * 1.4426950408889634f - m2);
#pragma unroll
    for (int dt = 0; dt < 8; ++dt) o[dt] = (f32x4){0.f, 0.f, 0.f, 0.f};
#pragma unroll
    for (int t = 0; t < NT / 2; ++t) {
        u32x4 pw; pw.x = pk2(s[2 * t][0], s[2 * t][1]); pw.y = pk2(s[2 * t][2], s[2 * t][3]); pw.z = pk2(s[2 * t + 1][0], s[2 * t + 1][1]); pw.w = pk2(s[2 * t + 1][2], s[2 * t + 1][3]);
        const bf16x8 p = __builtin_bit_cast(bf16x8, pw);
#pragma unroll
        for (int dt = 0; dt < 8; ++dt) { const LAS bf16_t* vp = Vt + (dt * 16 + lr) * VP + kt0 + 32 * t + lq * 4;
            const u32x2 a0 = *(const LAS u32x2*)vp, a1 = *(const LAS u32x2*)(vp + 16);
            u32x4 aw; aw.x = a0.x; aw.y = a0.y; aw.z = a1.x; aw.w = a1.y;
            o[dt] = mfma16(__builtin_bit_cast(bf16x8, aw), p, o[dt]); }
    }
    const float inv = 1.0f / den;
#pragma unroll
    for (int dt = 0; dt < 8; ++dt) o[dt] = o[dt] * inv;
    lse_out = (m2 + __builtin_amdgcn_logf(den)) * 0.6931471805599453f;
}
constexpr int A_NK = 272, A_VP = 280, B_NKK = 288, B_NKV = 304, B_VP = 312;
struct AUnit { int g, slot, dil, phase, jb, L; long tok0; };
__device__ __forceinline__ AUnit decodeA(int u) { AUnit a; const int b = u / 1536, r = u % 1536; a.g = r >> 9; const int r2 = r & 511; a.slot = r2 >> 7; const int blk = r2 & 127;
    const int sh = 2 * a.g; a.dil = 1 << sh; const int nbp = 128 >> sh; a.phase = blk / nbp; a.jb = blk % nbp; a.L = S >> sh; a.tok0 = (long)b * S + a.phase; return a; }
__device__ __forceinline__ AttnSrc srcA(const AUnit& a, const bf16_t* P, int tid) { const int head = a.g * 4 + a.slot; const int w = tid >> 6, lr = tid & 15;
    const int qi = a.jb * 128 + 16 * w + lr;
    AttnSrc s; s.Kg = P + PA_K + head * 128; s.Vg = P + PA_V + head * 128; s.Qrow = P + (size_t)(a.tok0 + (long)qi * a.dil) * PC + PA_Q + head * 128; s.tok0 = a.tok0; s.dil = a.dil; s.kbase = a.jb * 128 - 64; s.L = a.L; return s; }
__device__ __forceinline__ void attnA_phase(bf16_t* P, float* lse, LAS unsigned char* lds, int tid, int bx, int G) {
    LAS bf16_t* Ks = (LAS bf16_t*)lds; LAS bf16_t* Vt = (LAS bf16_t*)(lds + A_NK * KP * 2);
    StageRegs<A_NK, A_NK> R;
    int u = bx;
    if (u < 3072) { const AUnit a = decodeA(u); stage_load<A_NK, A_NK, true>(R, srcA(a, P, tid), tid); }
    for (; u < 3072; u += G) {
        const AUnit a = decodeA(u);
        stage_store<A_NK, A_NK, A_VP>(R, Ks, Vt, tid);
        bf16x8 qf[4];
#pragma unroll
        for (int ks = 0; ks < 4; ++ks) qf[ks] = R.q[ks];
        __syncthreads();
        if (u + G < 3072) { const AUnit an = decodeA(u + G); stage_load<A_NK, A_NK, true>(R, srcA(an, P, tid), tid); }
        const int w = tid >> 6, lane = tid & 63, lr = lane & 15, lq = lane >> 4;
        const int qi = a.jb * 128 + 16 * w + lr; const long token = a.tok0 + (long)qi * a.dil; const int head = a.g * 4 + a.slot;
        f32x4 o[8]; float lv;
        attn_wave<10, A_VP>(Ks, Vt, 16 * w, qf, qi, a.jb * 128 - 64, a.L, 64, false, 0.f, o, lv, lane);
        bf16_t* qrow = P + (size_t)token * PC + PA_Q + head * 128;
#pragma unroll
        for (int dt = 0; dt < 8; ++dt) { u32x2 wv; wv.x = pk2(o[dt][0], o[dt][1]); wv.y = pk2(o[dt][2], o[dt][3]); *(u32x2*)(qrow + dt * 16 + lq * 4) = wv; }
        if (lq == 0) lse[((size_t)a.g * T + token) * 4 + a.slot] = lv;
        __syncthreads();
    }
}
__device__ __forceinline__ AttnSrc srcB(int u, const bf16_t* P, int tid) { const int b = u >> 10, r = u & 1023, kvh = r >> 9, blk = r & 511; const int w = tid >> 6, lr = tid & 15;
    const int head = kvh * 4 + (w >> 1), qi = blk * 32 + 16 * (w & 1) + lr;
    AttnSrc s; s.Kg = P + PB_K + kvh * 128; s.Vg = P + PB_V + kvh * 128; s.tok0 = (long)b * S; s.Qrow = P + (size_t)(s.tok0 + qi) * PC + PB_Q + head * 128; s.dil = 1; s.kbase = blk * 32 - 128; s.L = S; return s; }
__device__ __forceinline__ void attnB_phase(const bf16_t* P, bf16_t* Yb, const float* sinks, LAS unsigned char* lds, int tid, int bx, int G) {
    LAS bf16_t* Ks = (LAS bf16_t*)lds; LAS bf16_t* Vt = (LAS bf16_t*)(lds + B_NKK * KP * 2);
    StageRegs<B_NKK, B_NKV> R;
    int u = bx;
    if (u < 2048) stage_load<B_NKK, B_NKV, false>(R, srcB(u, P, tid), tid);
    for (; u < 2048; u += G) {
        bf16x8 qf[4];
        { const AttnSrc sq = srcB(u, P, tid);
#pragma unroll
          for (int ks = 0; ks < 4; ++ks) qf[ks] = *(const bf16x8*)(sq.Qrow + ks * 32 + ((tid & 63) >> 4) * 8); }
        stage_store<B_NKK, B_NKV, B_VP>(R, Ks, Vt, tid);
        __syncthreads();
        if (u + G < 2048) stage_load<B_NKK, B_NKV, false>(R, srcB(u + G, P, tid), tid);
        const int b = u >> 10, r = u & 1023, kvh = r >> 9, blk = r & 511;
        const int w = tid >> 6, lane = tid & 63, lr = lane & 15, lq = lane >> 4;
        const int head = kvh * 4 + (w >> 1), rg = w & 1;
        const int qi = blk * 32 + 16 * rg + lr; const long token = (long)b * S + qi;
        f32x4 o[8]; float lv;
        attn_wave<18, B_VP>(Ks, Vt, 16 * rg, qf, qi, blk * 32 - 128, S, 128, true, sinks[head], o, lv, lane);
        bf16_t* orow = Yb + (size_t)token * 1024 + head * 128;
#pragma unroll
        for (int dt = 0; dt < 8; ++dt) { u32x2 wv; wv.x = pk2(o[dt][0], o[dt][1]); wv.y = pk2(o[dt][2], o[dt][3]); *(u32x2*)(orow + dt * 16 + lq * 4) = wv; }
        __syncthreads();
    }
}

constexpr int H_QT = 0, H_KT = 17408, H_QH = 34816, H_KHT = 52224, H_VT = 70656, H_ST = 89088, H_SC = 123904, H_QS = 133120, H_DEC = 135168;
__device__ __forceinline__ void hgrn_unit(int b, int h, int seg, int dir, int mode, bf16_t* P, const float* lb, float* SUM, float* LSUM, LAS unsigned char* lds, int tid) {
    const int w = tid >> 6, lane = tid & 63, lr = lane & 15, lq = lane >> 4;
    const int k = tid & 127, tq = tid >> 7;
    LAS bf16_t* Qt = (LAS bf16_t*)(lds + H_QT); LAS bf16_t* Kt = (LAS bf16_t*)(lds + H_KT);
    LAS bf16_t* KhT = (LAS bf16_t*)(lds + H_KHT); LAS bf16_t* VT = (LAS bf16_t*)(lds + H_VT); LAS bf16_t* ST = (LAS bf16_t*)(lds + H_ST);
    LAS bf16_t* Sc = (LAS bf16_t*)(lds + H_SC); LAS float* QS = (LAS float*)(lds + H_QS); LAS float* DEC = (LAS float*)(lds + H_DEC);
    const float lbv = lb[h * 128 + k], oml = 1.0f - lbv;
    f32x4 Sacc[8];
#pragma unroll
    for (int vt = 0; vt < 8; ++vt) Sacc[vt] = (f32x4){0.f, 0.f, 0.f, 0.f};
    float lsum = 0.f;
    const int chain = ((b * 8 + h) * 2 + dir) * 16;
    if (mode == 1) {
        const int nprev = dir ? 15 - seg : seg;
        f32x4 nx[8], nl;
        if (nprev > 0) { const int su = chain + (dir ? 15 : 0); const float* sp = SUM + (size_t)su * 16384; nl = *(const f32x4*)(LSUM + su * 128 + 16 * w + lq * 4);
#pragma unroll
            for (int vt = 0; vt < 8; ++vt) nx[vt] = *(const f32x4*)(sp + ((w * 8 + vt) * 64 + lane) * 4); }
        for (int jj = 0; jj < nprev; ++jj) {
            f32x4 cx[8]; const f32x4 lv = nl;
#pragma unroll
            for (int vt = 0; vt < 8; ++vt) cx[vt] = nx[vt];
            if (jj + 1 < nprev) { const int su = chain + (dir ? 14 - jj : jj + 1); const float* sp = SUM + (size_t)su * 16384; nl = *(const f32x4*)(LSUM + su * 128 + 16 * w + lq * 4);
#pragma unroll
                for (int vt = 0; vt < 8; ++vt) nx[vt] = *(const f32x4*)(sp + ((w * 8 + vt) * 64 + lane) * 4); }
            f32x4 dv; dv.x = __expf(lv.x); dv.y = __expf(lv.y); dv.z = __expf(lv.z); dv.w = __expf(lv.w);
#pragma unroll
            for (int vt = 0; vt < 8; ++vt) Sacc[vt] = Sacc[vt] * dv + cx[vt]; }
    }
    typedef __attribute__((address_space(1))) const bf16_t gbf16_t;
    gbf16_t* Pg = (gbf16_t*)P;
    const unsigned colF = (dir ? PC_FB : PC_FF) + h * 128 + k, colV = PC_I + h * 128 + k, colQ = PC_Q + h * 128 + k;
    unsigned short nfz[16], nv[16], nq[16];
#define HG_ROW0(cc_) ((unsigned)((b * S + (seg * 16 + (dir ? 15 - (cc_) : (cc_))) * 64 + (dir ? 63 - tq * 16 : tq * 16)) * PC))
#define HG_LOAD_F(cc_) do { unsigned vo_ = HG_ROW0(cc_) + colF; asm volatile("" : "+v"(vo_)); \
        _Pragma("unroll") for (int ii = 0; ii < 16; ++ii) nfz[ii] = Pg[dir ? vo_ - (unsigned)(ii * PC) : vo_ + (unsigned)(ii * PC)]; } while (0)
#define HG_LOAD_QV(cc_) do { unsigned vo_ = HG_ROW0(cc_); asm volatile("" : "+v"(vo_)); \
        _Pragma("unroll") for (int ii = 0; ii < 16; ++ii) { const unsigned ro_ = dir ? vo_ - (unsigned)(ii * PC) : vo_ + (unsigned)(ii * PC); \
            nv[ii] = Pg[ro_ + colV]; if (mode == 1) nq[ii] = Pg[ro_ + colQ]; } } while (0)
    float lf[16], kk[16];
#define HG_STAGE1(qb_) do { \
        _Pragma("unroll") for (int ii = 0; ii < 16; ++ii) { const float fz = bf2f(nfz[ii]); const float e = __expf(-fz), sg = __builtin_amdgcn_rcpf(1.0f + e); \
            lf[ii] = __logf(lbv + oml * sg); kk[ii] = oml * e * sg; } \
        _Pragma("unroll") for (int ii = 1; ii < 16; ++ii) lf[ii] += lf[ii - 1]; \
        QS[(qb_) * 640 + tq * 128 + k] = lf[15]; } while (0)
    HG_LOAD_F(0); HG_LOAD_QV(0);
    HG_STAGE1(0);
    HG_LOAD_F(1);
    __syncthreads();
    for (int cc = 0; cc < 16; ++cc) {
        const int c = seg * 16 + (dir ? 15 - cc : cc); const long btok = (long)b * S + c * 64;
        LAS float* QSc = QS + (cc & 1) * 640;
        const float q0 = QSc[k], q1 = QSc[128 + k], q2 = QSc[256 + k], q3 = QSc[384 + k];
        const float off = (tq > 0 ? q0 : 0.f) + (tq > 1 ? q1 : 0.f) + (tq > 2 ? q2 : 0.f);
        const float rref = q0 + q1, bl = (q0 + q1) + (q2 + q3);
        if (tq == 0) { DEC[k] = __expf(bl); lsum += bl; }
        u32x4 kh0, kh1, vv0, vv1;
        {
            float khat[16];
            const float ebr = __expf(bl - rref);
#pragma unroll
            for (int ii = 0; ii < 16; ++ii) { const int i = tq * 16 + ii; const float bt = off + lf[ii];
                if (mode == 1) { const float qh = bf2f(nq[ii]);
                    const float eq = __expf(fminf(fmaxf(bt - rref, -80.f), 80.f)), ek = __builtin_amdgcn_rcpf(eq);
                    const float kt = kk[ii] * ek; khat[ii] = kt * ebr;
                    Qt[i * KP + k] = (bf16_t)(pk2(qh * eq, 0.f) & 0xffffu); Kt[i * KP + k] = (bf16_t)(pk2(kt, 0.f) & 0xffffu); }
                else khat[ii] = kk[ii] * __expf(bl - bt); }
            kh0.x = pk2(khat[0], khat[1]); kh0.y = pk2(khat[2], khat[3]); kh0.z = pk2(khat[4], khat[5]); kh0.w = pk2(khat[6], khat[7]);
            kh1.x = pk2(khat[8], khat[9]); kh1.y = pk2(khat[10], khat[11]); kh1.z = pk2(khat[12], khat[13]); kh1.w = pk2(khat[14], khat[15]);
            vv0.x = nv[0] | ((unsigned)nv[1] << 16); vv0.y = nv[2] | ((unsigned)nv[3] << 16); vv0.z = nv[4] | ((unsigned)nv[5] << 16); vv0.w = nv[6] | ((unsigned)nv[7] << 16);
            vv1.x = nv[8] | ((unsigned)nv[9] << 16); vv1.y = nv[10] | ((unsigned)nv[11] << 16); vv1.z = nv[12] | ((unsigned)nv[13] << 16); vv1.w = nv[14] | ((unsigned)nv[15] << 16);
        }
        *(LAS u32x4*)(KhT + k * 72 + tq * 16) = kh0; *(LAS u32x4*)(KhT + k * 72 + tq * 16 + 8) = kh1;
        *(LAS u32x4*)(VT + k * 72 + tq * 16) = vv0; *(LAS u32x4*)(VT + k * 72 + tq * 16 + 8) = vv1;
        if (mode == 1) {
            const f32x4 ra = *(const LAS f32x4*)(QSc + 16 * w + lq * 4), rb = *(const LAS f32x4*)(QSc + 128 + 16 * w + lq * 4);
            f32x4 er; er.x = __expf(ra.x + rb.x); er.y = __expf(ra.y + rb.y); er.z = __expf(ra.z + rb.z); er.w = __expf(ra.w + rb.w);
#pragma unroll
            for (int vt = 0; vt < 8; ++vt) { const f32x4 sx = Sacc[vt] * er; u32x2 sv; sv.x = pk2(sx[0], sx[1]); sv.y = pk2(sx[2], sx[3]); *(LAS u32x2*)(ST + (16 * vt + lr) * KP + 16 * w + lq * 4) = sv; }
        }
        __syncthreads();
        if (cc < 15) { HG_STAGE1((cc + 1) & 1); HG_LOAD_QV(cc + 1); if (cc < 14) HG_LOAD_F(cc + 2); }
        if (mode == 1) {
#pragma unroll
            for (int e = 0; e < 2; ++e) { const int ti = 2 * w + e, st = ti >> 2, tt = ti & 3;
                f32x4 a = (f32x4){0.f, 0.f, 0.f, 0.f};
                if (st <= tt) {
#pragma unroll
                    for (int ks = 0; ks < 4; ++ks) a = mfma16(*(const LAS bf16x8*)(Kt + (16 * st + lr) * KP + ks * 32 + lq * 8), *(const LAS bf16x8*)(Qt + (16 * tt + lr) * KP + ks * 32 + lq * 8), a);
                }
                const int t = 16 * tt + lr, s0 = 16 * st + lq * 4;
                float x0 = (t >= s0 && st <= tt) ? a[0] : 0.f, x1 = (t >= s0 + 1 && st <= tt) ? a[1] : 0.f, x2 = (t >= s0 + 2 && st <= tt) ? a[2] : 0.f, x3 = (t >= s0 + 3 && st <= tt) ? a[3] : 0.f;
                u32x2 sv; sv.x = pk2(x0, x1); sv.y = pk2(x2, x3); *(LAS u32x2*)(Sc + t * 72 + s0) = sv; }
            __syncthreads();
            const int tt = w & 3, vh = w >> 2;
            bf16x8 scf[2], qhf[4];
#pragma unroll
            for (int ks = 0; ks < 2; ++ks) scf[ks] = *(const LAS bf16x8*)(Sc + (16 * tt + lr) * 72 + ks * 32 + lq * 8);
#pragma unroll
            for (int ks = 0; ks < 4; ++ks) qhf[ks] = *(const LAS bf16x8*)(Qt + (16 * tt + lr) * KP + ks * 32 + lq * 8);
            const int il = 16 * tt + lr; const long tok = btok + (dir ? 63 - il : il);
#pragma unroll
            for (int vi = 0; vi < 4; ++vi) { const int vt = vh * 4 + vi; f32x4 a = (f32x4){0.f, 0.f, 0.f, 0.f};
#pragma unroll
                for (int ks = 0; ks < 2; ++ks) a = mfma16(*(const LAS bf16x8*)(VT + (16 * vt + lr) * 72 + ks * 32 + lq * 8), scf[ks], a);
#pragma unroll
                for (int ks = 0; ks < 4; ++ks) a = mfma16(*(const LAS bf16x8*)(ST + (16 * vt + lr) * KP + ks * 32 + lq * 8), qhf[ks], a);
                bf16_t* of = P + (size_t)tok * PC + PC_FF + h * 128 + 16 * vt + lq * 4;
                if (dir == 0) { u32x2 sv; sv.x = pk2(a[0], a[1]); sv.y = pk2(a[2], a[3]); *(u32x2*)of = sv; }
                else { const u32x2 pv = *(const u32x2*)of;
                    a[0] += __builtin_bit_cast(float, pv.x << 16); a[1] += __builtin_bit_cast(float, pv.x & 0xffff0000u); a[2] += __builtin_bit_cast(float, pv.y << 16); a[3] += __builtin_bit_cast(float, pv.y & 0xffff0000u);
                    u32x2 sv; sv.x = pk2(a[0], a[1]); sv.y = pk2(a[2], a[3]); *(u32x2*)(P + (size_t)tok * PC + PC_FB + h * 128 + 16 * vt + lq * 4) = sv; } }
        }
        { const f32x4 dv = *(const LAS f32x4*)(DEC + 16 * w + lq * 4);
          bf16x8 af[2];
#pragma unroll
          for (int ks = 0; ks < 2; ++ks) af[ks] = *(const LAS bf16x8*)(KhT + (16 * w + lr) * 72 + ks * 32 + lq * 8);
#pragma unroll
          for (int vt = 0; vt < 8; ++vt) { f32x4 a = Sacc[vt] * dv;
#pragma unroll
              for (int ks = 0; ks < 2; ++ks) a = mfma16(af[ks], *(const LAS bf16x8*)(VT + (16 * vt + lr) * 72 + ks * 32 + lq * 8), a);
              Sacc[vt] = a; } }
        __syncthreads();
    }
#undef HG_STAGE1
#undef HG_LOAD_F
#undef HG_LOAD_QV
#undef HG_ROW0
    if (mode == 0) { const int su = chain + seg; float* sp = SUM + (size_t)su * 16384;
#pragma unroll
        for (int vt = 0; vt < 8; ++vt) *(f32x4*)(sp + ((w * 8 + vt) * 64 + lane) * 4) = Sacc[vt];
        if (tq == 0) LSUM[su * 128 + k] = lsum; }
}
__device__ __forceinline__ void hgrn_full_unit(int u, bf16_t* P, const float* lb, const float* hnorm, float* SUM, float* LSUM, bf16_t* Yc, LAS unsigned char* lds, int tid) {
    const int b = u >> 7, h = (u >> 4) & 7, seg = u & 15;
    hgrn_unit(b, h, seg, 0, 1, P, lb, SUM, LSUM, lds, tid);
    __threadfence(); __syncthreads();
#if defined(PROBE_HG) && PROBE_HG == 1
    return;
#endif
    hgrn_unit(b, h, seg, 1, 1, P, lb, SUM, LSUM, lds, tid);
    __threadfence(); __syncthreads();
#if defined(PROBE_HG) && PROBE_HG == 2
    return;
#endif
    const int w = tid >> 6, lane = tid & 63;
    const float g0 = hnorm[h * 128 + 2 * lane], g1 = hnorm[h * 128 + 2 * lane + 1];
    for (int r0 = w * 128; r0 < w * 128 + 128; r0 += 16) {
        unsigned pv[16];
#pragma unroll
        for (int i = 0; i < 16; ++i) pv[i] = *(const unsigned*)(P + (size_t)((long)b * S + seg * 1024 + r0 + i) * PC + PC_FB + h * 128 + 2 * lane);
#pragma unroll
        for (int i = 0; i < 16; ++i) { const long tok = (long)b * S + seg * 1024 + r0 + i;
            const float x0 = __builtin_bit_cast(float, pv[i] << 16), x1 = __builtin_bit_cast(float, pv[i] & 0xffff0000u);
            const float ss = wave_sum(x0 * x0 + x1 * x1); const float rs = 1.0f / sqrtf(ss * (1.0f / 128.f) + NORM_EPS);
            *(unsigned*)(Yc + (size_t)tok * 1024 + h * 128 + 2 * lane) = pk2(x0 * rs * g0, x1 * rs * g1); }
    }
    __syncthreads();
}

#define XB_TMO      128
#define XB_XCNT(j)  (256  + 64 * (j))
#define XB_XSUB(j)  (1280 + 64 * (j))
#define XB_XGEN(j)  (2304 + 64 * (j))
#define XB_TOP      3328
#define XB_TOPGEN   3392
#define XCD_BAR_WORDS 3456
#define XB_SPIN_CAP (1u << 18)

__device__ __forceinline__ unsigned xb_ld(unsigned* p)              { return __hip_atomic_load(p, __ATOMIC_RELAXED, __HIP_MEMORY_SCOPE_AGENT); }
__device__ __forceinline__ unsigned xb_add(unsigned* p, unsigned v) { return __hip_atomic_fetch_add(p, v, __ATOMIC_RELAXED, __HIP_MEMORY_SCOPE_AGENT); }
__device__ __forceinline__ unsigned xb_xcc_id() { return (unsigned)__builtin_amdgcn_s_getreg((3 << 11) | 20) & 0xFu; }
#define XB_SPIN(cond, bar) do { unsigned _sp = 0; while (cond) { __builtin_amdgcn_s_sleep(1); \
    if ((++_sp & 255u) == 0u) { if (xb_ld(&(bar)[XB_TMO])) break; if (_sp > XB_SPIN_CAP) { atomicAdd(&(bar)[XB_TMO], 1u); break; } } } } while (0)

struct XcdBarrier {
    unsigned* bar; unsigned x;
    volatile LAS unsigned* st;
};

__device__ __forceinline__ XcdBarrier xcd_barrier_post(unsigned* bar, volatile LAS unsigned* st) {
    XcdBarrier b; b.bar = bar; b.x = xb_xcc_id(); b.st = st;
    if (threadIdx.x == 0) (void)xb_add(&bar[XB_XCNT(b.x)], 1u);
    return b;
}
__device__ __forceinline__ void xcd_barrier_complete(unsigned* bar, unsigned x, unsigned& nloc, unsigned& nx) {
    const unsigned G = gridDim.x * gridDim.y * gridDim.z;
    unsigned sum, cnt, mine, sp = 0u;
    for (;;) {
        sum = 0u; cnt = 0u; mine = 0u;
#pragma unroll
        for (unsigned j = 0; j < 16; ++j) { const unsigned c = xb_ld(&bar[XB_XCNT(j)]); sum += c; cnt += (c > 0u) ? 1u : 0u; mine = (j == x) ? c : mine; }
        if (sum == G) break;
        __builtin_amdgcn_s_sleep(1);
        if ((++sp & 255u) == 0u) { if (xb_ld(&bar[XB_TMO])) break; if (sp > XB_SPIN_CAP) { atomicAdd(&bar[XB_TMO], 1u); break; } }
    }
    nloc = mine > 0u ? mine : 1u; nx = cnt > 0u ? cnt : 1u;
}

__device__ __forceinline__ void xcd_barrier(const XcdBarrier& b) {
    asm volatile("s_waitcnt vmcnt(0)" ::: "memory");
    __syncthreads();
    if (threadIdx.x == 0) {
        unsigned* bar = b.bar;
        __builtin_amdgcn_s_waitcnt(0);
        unsigned nloc = b.st[0], nx = b.st[1];
        if (nloc == 0u) { xcd_barrier_complete(bar, b.x, nloc, nx); b.st[0] = nloc; b.st[1] = nx; }
        const unsigned old = xb_add(&bar[XB_XSUB(b.x)], 1u);
        const unsigned gen = old / nloc;
        if (old + 1u == (gen + 1u) * nloc) {
            __builtin_amdgcn_fence(__ATOMIC_RELEASE, "agent");
            asm volatile("s_waitcnt vmcnt(0)" ::: "memory");
            const unsigned og = xb_add(&bar[XB_TOP], 1u);
            const unsigned tg = og / nx;
            if (og + 1u == (tg + 1u) * nx) xb_add(&bar[XB_TOPGEN], 1u);
            else XB_SPIN(xb_ld(&bar[XB_TOPGEN]) == tg, bar);
            __builtin_amdgcn_fence(__ATOMIC_ACQUIRE, "agent");
            xb_add(&bar[XB_XGEN(b.x)], 1u);
            asm volatile("s_waitcnt vmcnt(0)" ::: "memory");
        } else {
            XB_SPIN(xb_ld(&bar[XB_XGEN(b.x)]) == gen, bar);
            __builtin_amdgcn_fence(__ATOMIC_ACQUIRE, "agent");
            asm volatile("s_waitcnt vmcnt(0)" ::: "memory");
        }
    }
    __syncthreads();
}


struct Args { const float* in[11]; float* out; unsigned char* ws; int ph_lo, ph_hi; };
#define DERIVE_PTRS \
    int tid = threadIdx.x; asm volatile("" : "+v"(tid)); const int lane = tid & 63, wave = __builtin_amdgcn_readfirstlane(tid >> 6); \
    int G = gridDim.x, bx = blockIdx.x; asm volatile("" : "+s"(G), "+s"(bx)); \
    const int gw = bx * 8 + wave, NGW = G * 8; \
    unsigned char* ws = args.ws; asm volatile("" : "+s"(ws)); \
    const float* x0 = args.in[0]; const float* pre_norm = args.in[1]; const float* post_norm = args.in[2]; const float* sink_logits = args.in[4]; \
    const float* hlb = args.in[5]; const float* hnorm = args.in[6]; float* outp = args.out; \
    asm volatile("" : "+s"(x0), "+s"(pre_norm), "+s"(post_norm), "+s"(sink_logits), "+s"(hlb), "+s"(hnorm), "+s"(outp)); \
    float2* rope = (float2*)(ws + WS_ROPE); float* lse = (float*)(ws + WS_LSE); float* LB = (float*)(ws + WS_LB); float* LSUM = (float*)(ws + WS_LSUM); \
    bf16_t* WinT = (bf16_t*)(ws + WS_WIN); bf16_t* WaT = (bf16_t*)(ws + WS_WA); bf16_t* WbT = (bf16_t*)(ws + WS_WB); bf16_t* WcT = (bf16_t*)(ws + WS_WC); bf16_t* WoT = (bf16_t*)(ws + WS_WO); \
    bf16_t* XN = (bf16_t*)(ws + WS_XN); bf16_t* Ya = (bf16_t*)(ws + WS_YA); bf16_t* Yb = (bf16_t*)(ws + WS_YB); bf16_t* Yc = (bf16_t*)(ws + WS_YC); \
    float* SUM = (float*)(ws + WS_SUM); bf16_t* P = (bf16_t*)(ws + WS_P); bf16_t* Gm = (bf16_t*)(ws + WS_G); bf16_t* YM = (bf16_t*)(ws + WS_YM); float* OUT = (float*)(ws + WS_OUT); \
    (void)tid; (void)lane; (void)gw; (void)NGW; (void)x0; (void)pre_norm; (void)post_norm; (void)sink_logits; (void)hlb; (void)hnorm; (void)outp; (void)rope; (void)lse; (void)LB; (void)LSUM; \
    (void)WinT; (void)WaT; (void)WbT; (void)WcT; (void)WoT; (void)XN; (void)Ya; (void)Yb; (void)Yc; (void)SUM; (void)P; (void)Gm; (void)YM; (void)OUT;
#ifndef REPEAT_MASK
#define REPEAT_MASK 0
#endif
#define NREP(j) (1 + ((REPEAT_MASK >> (j)) & 1))
#define IN(k) (args.ph_lo <= (k) && (k) < args.ph_hi)
#define XB_ST_OFF (LDS_BYTES - 64)
#ifdef PROBE_TS
#define STAMP(k) do { if (blockIdx.x == 0 && threadIdx.x == 0) ((unsigned long long*)(args.ws + 65536))[k] = __builtin_amdgcn_s_memrealtime(); } while (0)
#else
#define STAMP(k) do { } while (0)
#endif
#define GRID_SYNC(k) do { if (IN(k) && IN((k) + 1)) { if ((k) == 0) cg::this_grid().sync(); else { XcdBarrier xb_; xb_.bar = (unsigned*)args.ws; xb_.x = xb_xcc_id(); xb_.st = (volatile LAS unsigned*)(lds + XB_ST_OFF); xcd_barrier(xb_); } } STAMP((k) + 1); } while (0)
template <int layer> __device__ __forceinline__ void run_layer(const Args& args, LAS unsigned char* lds) {
#ifndef SKIP_P1
        for (int rep = 0; rep < NREP(0); ++rep) if (IN(1 + 8 * layer + 0)) { DERIVE_PTRS pg8::Gemm g{XN, WinT, T, PC, D}; pg8::StaticOrder So; So.init(T, PC, G, bx); EpiStoreRope E{P, PC};
          pg8::gemm_phase<EpiStoreRope, pg8::StaticOrder, true, true>(lds, g, So, E); }
#endif
        GRID_SYNC(1 + 8 * layer + 0);
#ifndef SKIP_P2
        if (IN(1 + 8 * layer + 1)) { DERIVE_PTRS const float* lbL = LB + layer * 1024;
          for (int rep = 0; rep < NREP(8); ++rep) for (int u = bx; u < 512; u += G) { const int dir = u & 1, seg = (u >> 1) & 15, h = (u >> 5) & 7, b = u >> 8; hgrn_unit(b, h, seg, dir, 0, P, lbL, SUM, LSUM, lds, tid); }
          __syncthreads();
          const int vb = (G % 8 == 0) ? (bx % 8) * (G / 8) + bx / 8 : bx;
          attnA_phase(P, lse, lds, tid, vb, G);
          for (int rep = 0; rep < NREP(9); ++rep) attnB_phase(P, Yb, sink_logits + layer * 8, lds, tid, vb, G); }
#endif
        GRID_SYNC(1 + 8 * layer + 1);
#ifndef SKIP_P3
        if (IN(1 + 8 * layer + 2)) { DERIVE_PTRS const int vb3 = (G % 8 == 0) ? (bx % 8) * (G / 8) + bx / 8 : bx;
            for (int u = vb3; u < 256; u += G) hgrn_full_unit(u, P, LB + layer * 1024, hnorm + layer * 1024, SUM, LSUM, Yc, lds, tid); }
#endif
        GRID_SYNC(1 + 8 * layer + 2);
#ifndef SKIP_P4
        if (IN(1 + 8 * layer + 3)) { DERIVE_PTRS pg8::Gemm g{XN, WinT + (size_t)PC * D, T, NGATE, D}; pg8::StaticOrder So; So.init(T, NGATE, G, bx); EpiGate E{Ya, Yb, Yc, P, lse};
          pg8::gemm_phase<EpiGate, pg8::StaticOrder, true, true>(lds, g, So, E); }
#endif
#if defined(MULTI_LAUNCH) || defined(PROBE_PHASES)
        GRID_SYNC(1 + 8 * layer + 3);
#endif
#ifndef SKIP_P5
        for (int rep = 0; rep < NREP(4); ++rep) if (IN(1 + 8 * layer + 4)) { DERIVE_PTRS pg8::Gemm g{(const bf16_t*)(ws + WS_XN8), (const bf16_t*)(ws + WS_WM8), T, NMERGE, D}; pg8::StaticOrder So; So.init(T, NMERGE, G, bx); EpiSigmoidI8 E{(unsigned char*)Gm, G_PITCH, 1.0f / (Q_SX * Q_SW)};
          pg8::gemm_phase<EpiSigmoidI8, pg8::StaticOrder, true, true, 1>(lds, g, So, E); }
#endif
        GRID_SYNC(1 + 8 * layer + 4);
#ifndef SKIP_P6
        for (int rep = 0; rep < NREP(5); ++rep) if (IN(1 + 8 * layer + 5)) { DERIVE_PTRS pg8::StaticOrder So; So.init(T, D, G, bx);
          { pg8::Gemm g{Ya, WaT, T, D, 512}; EpiBranch<true> E{YM, (const unsigned char*)Gm, 0}; pg8::gemm_phase<EpiBranch<true>, pg8::StaticOrder, true, true>(lds, g, So, E); }
          { pg8::Gemm g{Yb, WbT, T, D, 1024}; EpiBranch<false> E{YM, (const unsigned char*)Gm, 1}; pg8::gemm_phase<EpiBranch<false>, pg8::StaticOrder, true, true>(lds, g, So, E); }
          { pg8::Gemm g{Yc, WcT, T, D, 1024}; EpiBranch<false> E{YM, (const unsigned char*)Gm, 2}; pg8::gemm_phase<EpiBranch<false>, pg8::StaticOrder, true, true>(lds, g, So, E); } }
#endif
        GRID_SYNC(1 + 8 * layer + 5);
#ifndef SKIP_P7
        for (int rep = 0; rep < NREP(6); ++rep) if (IN(1 + 8 * layer + 6)) { DERIVE_PTRS pg8::Gemm g{YM, WoT, T, D, D}; pg8::StaticOrder So; So.init(T, D, G, bx); EpiStoreBf16 E{(bf16_t*)OUT, D};
          pg8::gemm_phase<EpiStoreBf16, pg8::StaticOrder, true, true>(lds, g, So, E); }
#endif
        GRID_SYNC(1 + 8 * layer + 6);
        for (int rep8 = 0; rep8 < (layer == 0 ? NREP(11) : 1); ++rep8) if (IN(1 + 8 * layer + 7)) { DERIVE_PTRS const float* xold = layer == 0 ? x0 : outp;
          for (int m = gw; m < T; m += 2 * NGW) { const int m2 = (m + NGW < T) ? m + NGW : m;
              const bf16_t* const orow[2] = {(const bf16_t*)OUT + (size_t)m * D, (const bf16_t*)OUT + (size_t)m2 * D};
              const float* const xo[2] = {xold + (size_t)m * D, xold + (size_t)m2 * D}; float* const xn[2] = {outp + (size_t)m * D, outp + (size_t)m2 * D};
              bf16_t* const xq[2] = {XN + (size_t)m * D, XN + (size_t)m2 * D}; unsigned* const xq8[2] = {(unsigned*)(ws + WS_XN8) + (size_t)m * (D / 4), (unsigned*)(ws + WS_XN8) + (size_t)m2 * (D / 4)};
              final_rows<2>(orow, post_norm + layer * D, xo, xn, layer == 0 ? pre_norm + D : nullptr, xq, xq8, lane); }
          if (layer == 0) { Weights Wt{args.in[3] + (size_t)D * NIN, args.in[7] + (size_t)512 * D, args.in[8] + (size_t)1024 * D, args.in[9] + (size_t)1024 * D, args.in[10] + (size_t)D * D};
              __syncthreads(); transpose_weights(Wt, ws, lds, gw, NGW, wave, lane); GRID_SYNC(1 + 8 * layer + 7); } }
}
__global__ void __launch_bounds__(NTHREADS, 2) fwd_megakernel(Args args) {
    extern __shared__ __attribute__((aligned(16))) unsigned char lds_raw[];
    LAS unsigned char* lds = (LAS unsigned char*)lds_raw;
    if (threadIdx.x < 16) ((LAS unsigned*)(lds + XB_ST_OFF))[threadIdx.x] = 0u;
    __syncthreads();
    if (args.ph_hi - args.ph_lo > 1 && blockIdx.x == 0) { for (int i = threadIdx.x; i < XCD_BAR_WORDS; i += NTHREADS) ((unsigned*)args.ws)[i] = 0u; }
    STAMP(0);
    for (int rep0 = 0; rep0 < NREP(10); ++rep0) if (IN(0)) { DERIVE_PTRS
    for (int i = bx * NTHREADS + tid; i < 1024; i += G * NTHREADS) { const float h0 = hlb[i], h1 = hlb[1024 + i]; const float mx = fmaxf(h0, h1);
        const float e0 = expf(h0 - mx), e1 = expf(h1 - mx); LB[i] = 0.f; LB[1024 + i] = e1 / (e0 + e1); }
    { Weights Wt{args.in[3], args.in[7], args.in[8], args.in[9], args.in[10]}; transpose_weights(Wt, ws, lds, gw, NGW, wave, lane); }
    for (int m = gw; m < T; m += NGW) prenorm_row(x0 + (size_t)m * D, pre_norm, XN + (size_t)m * D, (unsigned*)(ws + WS_XN8) + (size_t)m * (D / 4), lane);
    }
    GRID_SYNC(0);
    if (args.ph_hi - args.ph_lo > 1) (void)xcd_barrier_post((unsigned*)args.ws, (volatile LAS unsigned*)(lds + XB_ST_OFF));

    run_layer<0>(args, lds);
#if NLAYER > 1
    run_layer<1>(args, lds);
#endif
#ifdef PROBE_TS
    STAMP(17);
    if (blockIdx.x == 0 && threadIdx.x == 0) { const unsigned long long* ts = (const unsigned long long*)(args.ws + 65536); const float dus_ = 0.01f * (float)(ts[PROBE_TS + 1] - ts[PROBE_TS]); args.out[0] = 1000.0f * floorf(dus_ / (float)PROBE_BUCKET) + 1000.0f; }
#endif
}

__global__ void dump_bf16(const bf16_t* src, size_t pitch, float* out) {
    const size_t i = (size_t)blockIdx.x * blockDim.x + threadIdx.x; const size_t r = i / 2048, c = i % 2048;
    out[i] = bf2f(src[r * pitch + c]);
}
__global__ void dump_f32(const float* src, float* out) { const size_t i = (size_t)blockIdx.x * blockDim.x + threadIdx.x; out[i] = src[i]; }
__global__ void dump_mix(const unsigned char* ws, float* out) {
    const size_t i = (size_t)blockIdx.x * blockDim.x + threadIdx.x; const size_t r = i / 2048, c = i % 2048;
    const bf16_t* P = (const bf16_t*)(ws + WS_P); const bf16_t* Yb = (const bf16_t*)(ws + WS_YB); const bf16_t* Yc = (const bf16_t*)(ws + WS_YC); const float* SUM = (const float*)(ws + WS_SUM); const float* lse = (const float*)(ws + WS_LSE);
    float v = 0.f;
#if PROBE_SEL & 1
    v += bf2f(P[r * PC + c]);
#endif
#if PROBE_SEL & 2
    v += bf2f(Yb[r * 1024 + (c & 1023)]);
#endif
#if PROBE_SEL & 4
    v += SUM[i % ((size_t)512 * 16384)];
#endif
#if PROBE_SEL & 8
    v += lse[i % ((size_t)3 * T * 4)];
#endif
#if PROBE_SEL & 16
    v += bf2f(Yc[r * 1024 + (c & 1023)]);
#endif
#if PROBE_SEL & 32
    v += bf2f(P[r * PC + PC_FF + (c & 1023)]);
#endif
#if PROBE_SEL & 64
    v += bf2f(P[r * PC + PC_FB + (c & 1023)]);
#endif
    if (!(v == v) || fabsf(v) > 1e30f) v = 12345.f;
    out[i] = v;
}
extern "C" void kernel_launch(void* const* d_in, const int* in_sizes, int n_in, void* d_out, int out_size, void* d_ws, size_t ws_size, hipStream_t stream) {
    static int grid = 0;
    if (grid == 0) {
        if (n_in != 11 || ws_size < WS_END8) { fprintf(stderr, "kernel_launch: unexpected inputs (n_in %d, ws %zu)\n", n_in, ws_size); grid = -1; return; }
        int dev = 0, cus = 0, per_cu = 0;
        hipGetDevice(&dev); hipDeviceGetAttribute(&cus, hipDeviceAttributeMultiprocessorCount, dev);
        hipFuncSetAttribute((const void*)fwd_megakernel, hipFuncAttributeMaxDynamicSharedMemorySize, LDS_BYTES);
        hipOccupancyMaxActiveBlocksPerMultiprocessor(&per_cu, (const void*)fwd_megakernel, NTHREADS, LDS_BYTES);
        if (per_cu < 1) per_cu = 1;
        grid = cus * per_cu;
    }
    if (grid < 0) return;
    Args a{};
    for (int i = 0; i < 11; ++i) a.in[i] = (const float*)d_in[i];
    a.out = (float*)d_out; a.ws = (unsigned char*)d_ws;
#ifdef PROBE_PHASES
    for (int ph = 0; ph < PROBE_PHASES; ++ph) { a.ph_lo = ph; a.ph_hi = ph + 1; hipLaunchKernelGGL(fwd_megakernel, dim3(grid), dim3(NTHREADS), LDS_BYTES, stream, a); }
    PROBE_DUMP
#elif defined(MULTI_LAUNCH)
    for (int ph = 0; ph < 17; ++ph) { a.ph_lo = ph; a.ph_hi = ph + 1; hipLaunchKernelGGL(fwd_megakernel, dim3(grid), dim3(NTHREADS), LDS_BYTES, stream, a); }
#else
    a.ph_lo = 0; a.ph_hi = 17;
    void* kargs[] = {&a};
    hipError_t e = hipLaunchCooperativeKernel((const void*)fwd_megakernel, dim3(grid), dim3(NTHREADS), kargs, LDS_BYTES, stream);
    if (e != hipSuccess) fprintf(stderr, "cooperative launch failed: %s (grid %d)\n", hipGetErrorString(e), grid);
#endif
}
```

```cpp
#include <hip/hip_runtime.h>
#include <hip/hip_cooperative_groups.h>
#include <cstdio>
#include <cstdint>
namespace cg = cooperative_groups;
namespace pg8 {
#define PG8_LAS __attribute__((address_space(3)))
typedef unsigned short bf16_t;
typedef short bf16x8 __attribute__((ext_vector_type(8)));
typedef float f32x4 __attribute__((ext_vector_type(4)));
typedef unsigned u32x4 __attribute__((ext_vector_type(4)));
constexpr int BM = 256, BK = 64, HALF = 128, HTB = HALF * BK * 2  , STAGE_BYTES = 8 * HTB, NXCD = 8, WGM = 8;

__host__ __device__ __forceinline__ int lds_byte(int r, int c) { const int st = (r >> 4) * 2 + (c >> 5), rr = r & 15, cc = c & 31, ob = rr * 64 + cc * 2; return st * 1024 + (ob ^ (((ob >> 9) & 1) << 5)); }
__host__ __device__ __forceinline__ void stage_rc(int b, int& R, int& C) { const int st = b / 1024, sb = b % 1024, swz = sb ^ (((sb >> 9) & 1) << 5); R = (st >> 1) * 16 + swz / 64; C = (st & 1) * 32 + (swz % 64) / 2; }
__host__ __device__ __forceinline__ int perm32(int rho) { const int n = rho >> 4, i = rho & 15; return 8 * (i >> 2) + 4 * n + (i & 3); }

struct Unit { int pm, pn; };
struct Gemm { const bf16_t* A; const bf16_t* Bt; int M, N, K; };

struct StaticOrder {
    int nM, nN, nwg, G, c;
    __host__ __device__ void init(int M, int N, int G_, int c_) { nM = M / BM; nN = N / BM; nwg = nM * nN; G = G_; c = c_; }
    __host__ __device__ bool next(int i, Unit& u) const {
        const long L = (long)i * G + c; if (L >= nwg) return false;
        int wgid = (int)L; { const int q = nwg / NXCD, r = nwg % NXCD, xcd = wgid % NXCD, off = wgid / NXCD; wgid = (xcd < r ? xcd * (q + 1) : r * (q + 1) + (xcd - r) * q) + off; }
        const int nig = WGM * nN, gid = wgid / nig, fm = gid * WGM, gsz = (nM - fm) < WGM ? (nM - fm) : WGM;
        u.pm = fm + ((wgid % nig) % gsz); u.pn = (wgid % nig) / gsz; return true;
    }
    __device__ __forceinline__ void a_ready(const Unit&) const {}
    __device__ __forceinline__ void done(const Unit&) const {}
};

__device__ __forceinline__ unsigned cvt_pk_bf16(float lo, float hi) { unsigned r; asm volatile("v_cvt_pk_bf16_f32 %0, %1, %2" : "=v"(r) : "v"(lo), "v"(hi)); return r; }
typedef int i32x4 __attribute__((ext_vector_type(4)));
template <int ES> __device__ __forceinline__ f32x4 pg8_mma(bf16x8 a, bf16x8 b, f32x4 c) {
    if constexpr (ES == 2) return __builtin_amdgcn_mfma_f32_16x16x32_bf16(a, b, c, 0, 0, 0);
    else return __builtin_bit_cast(f32x4, __builtin_amdgcn_mfma_i32_16x16x64_i8(__builtin_bit_cast(i32x4, a), __builtin_bit_cast(i32x4, b), __builtin_bit_cast(i32x4, c), 0, 0, 0));
}
template <class Epi, class Sched, bool ALIGN_EPI = false, bool SP2 = false, int ES = 2>
__device__ __forceinline__ void gemm_phase(PG8_LAS unsigned char* lds, const Gemm g, const Sched& S, const Epi& E) {
    int tid = threadIdx.x; asm volatile("" : "+v"(tid));
    const int wid = __builtin_amdgcn_readfirstlane(tid >> 6), lane = tid & 63, wr = wid >> 2, wc = wid & 3, fr = lane & 15, fq = lane >> 4;
    const int K = g.K, nt = (K * ES) / (BK * 2);
    unsigned voffA[2], voffB[2];
#pragma unroll
    for (int i = 0; i < 2; ++i) { int R, C; stage_rc(tid * 16 + i * 8192, R, C); const int Rb = Epi::PERM ? ((R & ~31) + perm32(R & 31)) : R;
        voffA[i] = (unsigned)(R * K * ES + C * 2); voffB[i] = (unsigned)(Rb * K * ES + C * 2); }
    const size_t kstep = (size_t)(BK * 2);
    const size_t hstep = (size_t)HALF * K * ES;
    const size_t tstep = 2 * hstep;
    const unsigned ldsw = (unsigned)wid * 1024u;
    const int aoff = lds_byte(wr * 64 + fr, fq * 8), boff = lds_byte(wc * 32 + fr, fq * 8);
#define PG8_SA(b, h) (((b) * 2 + (h)) * HTB)
#define PG8_SB(b, h) ((4 + (b) * 2 + (h)) * HTB)
#define PG8_STAGE(bufoff, gbase, voff) do { _Pragma("unroll") for (int _i = 0; _i < 2; ++_i) \
        __builtin_amdgcn_global_load_lds((const unsigned*)((const char*)(gbase) + (voff)[_i]), (PG8_LAS unsigned*)(lds + (bufoff) + ldsw + _i * 8192), 16, 0, 0); } while (0)
#define PG8_LDA(dst, b, h) do { _Pragma("unroll") for (int m = 0; m < 4; ++m) _Pragma("unroll") for (int k = 0; k < 2; ++k) dst[m][k] = *(const PG8_LAS bf16x8*)(lds + PG8_SA(b, h) + aoff + m * 2048 + k * 1024); } while (0)
#define PG8_LDB(dst, b, h) do { _Pragma("unroll") for (int n = 0; n < 2; ++n) _Pragma("unroll") for (int k = 0; k < 2; ++k) dst[n][k] = *(const PG8_LAS bf16x8*)(lds + PG8_SB(b, h) + boff + n * 2048 + k * 1024); } while (0)
#define PG8_MMA(ai, bj, At, Bt) do { __builtin_amdgcn_s_setprio(1); _Pragma("unroll") for (int m = 0; m < 4; ++m) _Pragma("unroll") for (int n = 0; n < 2; ++n) _Pragma("unroll") for (int k = 0; k < 2; ++k) \
        acc[ai][bj][m][n] = pg8_mma<ES>(Bt[n][k], At[m][k], acc[ai][bj][m][n]); __builtin_amdgcn_s_setprio(0); } while (0)
#define PG8_WAIT_V(n) asm volatile("s_waitcnt vmcnt(" #n ")" ::: "memory")
#define PG8_WAIT_L(n) asm volatile("s_waitcnt lgkmcnt(" #n ")" ::: "memory")
#define PG8_BAR __builtin_amdgcn_s_barrier()
#define PG8_SCHED __builtin_amdgcn_sched_barrier(0)
    Unit cur, nxt; int ui = 0;
    if (!S.next(0, cur)) return;
    f32x4 acc[2][2][4][2];
#pragma unroll
    for (int a = 0; a < 2; ++a)
#pragma unroll
        for (int b = 0; b < 2; ++b)
#pragma unroll
            for (int m = 0; m < 4; ++m)
#pragma unroll
                for (int n = 0; n < 2; ++n) acc[a][b][m][n] = (f32x4){0.f, 0.f, 0.f, 0.f};
    bf16x8 At[4][2], B0[2][2], B1[2][2];
    const char* cA = (const char*)g.A + (size_t)cur.pm * tstep; const char* cB = (const char*)g.Bt + (size_t)cur.pn * tstep;
    S.a_ready(cur);
    if constexpr (SP2) {
        PG8_STAGE(PG8_SB(0, 0), cB, voffB); PG8_STAGE(PG8_SB(0, 1), cB + hstep, voffB); PG8_STAGE(PG8_SA(0, 0), cA, voffA); PG8_STAGE(PG8_SA(0, 1), cA + hstep, voffA);
        if (wr == 1) PG8_BAR;
        PG8_WAIT_V(2); PG8_BAR;
        PG8_STAGE(PG8_SB(1, 0), cB + kstep, voffB); PG8_STAGE(PG8_SA(1, 0), cA + kstep, voffA); PG8_STAGE(PG8_SB(1, 1), cB + hstep + kstep, voffB);
        PG8_WAIT_V(6); PG8_BAR;
    } else {
        PG8_STAGE(PG8_SB(0, 0), cB, voffB); PG8_STAGE(PG8_SA(0, 0), cA, voffA); PG8_STAGE(PG8_SB(0, 1), cB + hstep, voffB); PG8_STAGE(PG8_SA(0, 1), cA + hstep, voffA);
        if (wr == 1) PG8_BAR;
        PG8_WAIT_V(4); PG8_BAR;
        PG8_STAGE(PG8_SB(1, 0), cB + kstep, voffB); PG8_STAGE(PG8_SA(1, 0), cA + kstep, voffA); PG8_STAGE(PG8_SB(1, 1), cB + hstep + kstep, voffB);
        PG8_WAIT_V(6); PG8_BAR;
    }
    for (;;) {
        const bool has_next = S.next(ui + 1, nxt);
        const char* nA = has_next ? (const char*)g.A + (size_t)nxt.pm * tstep : cA; const char* nB = has_next ? (const char*)g.Bt + (size_t)nxt.pn * tstep : cB;
        for (int t = 0; t < nt; t += 2) {
            const bool last = (t == nt - 2);
            const char* a1 = cA + (size_t)(t + 1) * kstep;
            const char* a2 = last ? nA : cA + (size_t)(t + 2) * kstep; const char* b2 = last ? nB : cB + (size_t)(t + 2) * kstep;
            const char* a3 = a2 + kstep; const char* b3 = b2 + kstep;
            if (last && has_next) S.a_ready(nxt);
            if constexpr (SP2) {
            PG8_LDB(B0, 0, 0); PG8_LDB(B1, 0, 1); PG8_SCHED; PG8_LDA(At, 0, 0); PG8_STAGE(PG8_SA(1, 1), a1 + hstep, voffA);
            PG8_WAIT_V(8); PG8_WAIT_L(0); PG8_BAR; PG8_MMA(0, 0, At, B0); PG8_MMA(0, 1, At, B1); PG8_BAR; PG8_SCHED;
            PG8_LDA(At, 0, 1); PG8_STAGE(PG8_SB(0, 0), b2, voffB); PG8_STAGE(PG8_SB(0, 1), b2 + hstep, voffB); PG8_STAGE(PG8_SA(0, 0), a2, voffA);
            PG8_WAIT_V(8); PG8_WAIT_L(0); PG8_BAR; PG8_MMA(1, 0, At, B0); PG8_MMA(1, 1, At, B1); PG8_BAR; PG8_SCHED;
            PG8_LDB(B0, 1, 0); PG8_LDB(B1, 1, 1); PG8_SCHED; PG8_LDA(At, 1, 0); PG8_STAGE(PG8_SA(0, 1), a2 + hstep, voffA);
            PG8_WAIT_V(8); PG8_WAIT_L(0); PG8_BAR; PG8_MMA(0, 0, At, B0); PG8_MMA(0, 1, At, B1); PG8_BAR; PG8_SCHED;
            PG8_LDA(At, 1, 1); PG8_STAGE(PG8_SB(1, 0), b3, voffB); PG8_STAGE(PG8_SB(1, 1), b3 + hstep, voffB); PG8_STAGE(PG8_SA(1, 0), a3, voffA);
            PG8_WAIT_V(8); PG8_WAIT_L(0); PG8_BAR; PG8_MMA(1, 0, At, B0); PG8_MMA(1, 1, At, B1); PG8_BAR; PG8_SCHED;
            } else {
            PG8_LDB(B0, 0, 0); PG8_SCHED; PG8_LDA(At, 0, 0); PG8_STAGE(PG8_SA(1, 1), a1 + hstep, voffA);
            PG8_WAIT_L(8); PG8_BAR; PG8_WAIT_L(0); PG8_MMA(0, 0, At, B0); PG8_BAR; PG8_SCHED;
            PG8_LDB(B1, 0, 1); PG8_STAGE(PG8_SB(0, 0), b2, voffB);
            PG8_BAR; PG8_WAIT_L(0); PG8_MMA(0, 1, At, B1); PG8_BAR;
            PG8_LDA(At, 0, 1); PG8_STAGE(PG8_SA(0, 0), a2, voffA);
            PG8_BAR; PG8_WAIT_L(0); PG8_MMA(1, 0, At, B0); PG8_BAR; PG8_SCHED;
            PG8_STAGE(PG8_SB(0, 1), b2 + hstep, voffB);
            PG8_WAIT_V(6); PG8_BAR; PG8_MMA(1, 1, At, B1); PG8_BAR;
            PG8_LDB(B0, 1, 0); PG8_SCHED; PG8_LDA(At, 1, 0); PG8_STAGE(PG8_SA(0, 1), a2 + hstep, voffA);
            PG8_WAIT_L(8); PG8_BAR; PG8_WAIT_L(0); PG8_MMA(0, 0, At, B0); PG8_BAR; PG8_SCHED;
            PG8_LDB(B1, 1, 1); PG8_STAGE(PG8_SB(1, 0), b3, voffB);
            PG8_BAR; PG8_WAIT_L(0); PG8_MMA(0, 1, At, B1); PG8_BAR;
            PG8_LDA(At, 1, 1); PG8_STAGE(PG8_SA(1, 0), a3, voffA);
            PG8_BAR; PG8_WAIT_L(0); PG8_MMA(1, 0, At, B0); PG8_BAR; PG8_SCHED;
            PG8_STAGE(PG8_SB(1, 1), b3 + hstep, voffB);
            PG8_WAIT_V(6); PG8_BAR; PG8_MMA(1, 1, At, B1); PG8_BAR;
            }
        }
        if constexpr (ALIGN_EPI) { if (wr == 0) PG8_BAR; }
        if constexpr (!Epi::AFTER_DRAIN) { E(acc, cur, wr, wc, fr, fq); S.done(cur); }
        if (!has_next) break;
#pragma unroll
        for (int a = 0; a < 2; ++a)
#pragma unroll
            for (int b = 0; b < 2; ++b)
#pragma unroll
                for (int m = 0; m < 4; ++m)
#pragma unroll
                    for (int n = 0; n < 2; ++n) acc[a][b][m][n] = (f32x4){0.f, 0.f, 0.f, 0.f};
        cur = nxt; cA = nA; cB = nB; ++ui;
        if constexpr (ALIGN_EPI) { if (wr == 1) PG8_BAR; }
    }
    PG8_WAIT_V(0);
    if constexpr (!ALIGN_EPI) { if (wr == 0) PG8_BAR; }
    PG8_BAR;
    if constexpr (Epi::AFTER_DRAIN) { E.fused(acc, cur, wr, wc, fr, fq, lds, wid, lane); S.done(cur); }
#undef PG8_SA
#undef PG8_SB
#undef PG8_STAGE
#undef PG8_LDA
#undef PG8_LDB
#undef PG8_MMA
#undef PG8_WAIT_V
#undef PG8_WAIT_L
#undef PG8_BAR
#undef PG8_SCHED
}
}

#define LAS __attribute__((address_space(3)))
typedef unsigned short bf16_t;
typedef short bf16x8 __attribute__((ext_vector_type(8)));
typedef short bf16x4 __attribute__((ext_vector_type(4)));
typedef float f32x4 __attribute__((ext_vector_type(4)));
typedef unsigned u32x4 __attribute__((ext_vector_type(4)));
typedef unsigned u32x2 __attribute__((ext_vector_type(2)));

constexpr int T = 32768, S = 16384, D = 2048;
constexpr int PC = 10240;
constexpr int NGATE = 2560, NMERGE = 6144, NIN = 18944;
constexpr int PA_Q = 0, PA_K = 1536, PA_V = 3072, PB_Q = 4608, PB_K = 5632, PB_V = 5888, PC_Q = 6144, PC_FF = 7168, PC_FB = 8192, PC_I = 9216;
constexpr float NORM_EPS = 1e-6f;
constexpr size_t MiB = 1u << 20;
constexpr size_t WS_ROPE = 1 * MiB, WS_LSE = 3 * MiB, WS_LB = 5 * MiB, WS_LSUM = 5 * MiB + 65536;
constexpr size_t WS_WIN = 6 * MiB, WS_WA = 80 * MiB, WS_WB = 82 * MiB, WS_WC = 86 * MiB, WS_WO = 90 * MiB;
constexpr size_t WS_XN = 98 * MiB, WS_YA = 226 * MiB, WS_YB = 258 * MiB, WS_YC = 322 * MiB, WS_SUM = 386 * MiB, WS_P = 418 * MiB, WS_END = 1058 * MiB;
constexpr size_t WS_G = WS_P + 3072, WS_YM = WS_XN, WS_OUT = WS_P;
constexpr int G_PITCH = PC * 2;
constexpr size_t WS_XN8 = 1058 * MiB, WS_WM8 = 1122 * MiB, WS_END8 = 1134 * MiB;
constexpr float Q_SX = 21.0f, Q_SW = 960.0f;
constexpr int LDS_BYTES = 163840;
constexpr int NTHREADS = 512;
#ifndef NLAYER
#define NLAYER 2
#endif

__device__ __forceinline__ float bf2f(unsigned short b) { return __builtin_bit_cast(float, (unsigned)b << 16); }
__device__ __forceinline__ float bf2f_s(short b) { return __builtin_bit_cast(float, ((unsigned)(unsigned short)b) << 16); }
typedef float f32x2_t __attribute__((ext_vector_type(2))); typedef __bf16 bf16x2_t __attribute__((ext_vector_type(2)));
__device__ __forceinline__ unsigned pk2(float lo, float hi) { f32x2_t v = {lo, hi}; bf16x2_t b = __builtin_convertvector(v, bf16x2_t); return __builtin_bit_cast(unsigned, b); }
__device__ __forceinline__ float wave_sum(float v) {
#pragma unroll
    for (int o = 1; o < 64; o <<= 1) v += __shfl_xor(v, o);
    return v;
}
__device__ __forceinline__ f32x4 mfma16(bf16x8 a, bf16x8 b, f32x4 c) { return __builtin_amdgcn_mfma_f32_16x16x32_bf16(a, b, c, 0, 0, 0); }
__device__ __forceinline__ float fast_sigmoid(float x) { return __builtin_amdgcn_rcpf(1.0f + __expf(-x)); }

__device__ __forceinline__ unsigned q8x4(float a, float b, float c, float d, float sc) {
    const int ia = __builtin_amdgcn_fmed3f(rintf(a * sc), -127.f, 127.f), ib = __builtin_amdgcn_fmed3f(rintf(b * sc), -127.f, 127.f);
    const int ic = __builtin_amdgcn_fmed3f(rintf(c * sc), -127.f, 127.f), id = __builtin_amdgcn_fmed3f(rintf(d * sc), -127.f, 127.f);
    return (unsigned)(ia & 0xff) | ((unsigned)(ib & 0xff) << 8) | ((unsigned)(ic & 0xff) << 16) | ((unsigned)(id & 0xff) << 24);
}
__device__ __forceinline__ void transpose_item(const float* W, int K, int N, bf16_t* WT, int drow, LAS float* scr, int k0, int n0, int lane, signed char* WT8 = nullptr) {
#pragma unroll
    for (int i = 0; i < 32; ++i) { const int kk = 2 * i + (lane >> 5); scr[kk * 33 + (lane & 31)] = W[(size_t)(k0 + kk) * N + n0 + (lane & 31)]; }
    asm volatile("s_waitcnt lgkmcnt(0)" ::: "memory");
    const int c = lane & 7;
#pragma unroll
    for (int j = 0; j < 4; ++j) { const int n = (lane >> 3) + 8 * j; const LAS float* s = scr + (8 * c) * 33 + n;
        u32x4 o; o.x = pk2(s[0 * 33], s[1 * 33]); o.y = pk2(s[2 * 33], s[3 * 33]); o.z = pk2(s[4 * 33], s[5 * 33]); o.w = pk2(s[6 * 33], s[7 * 33]);
        *(u32x4*)(WT + (size_t)(drow + n) * K + k0 + 8 * c) = o;
        if (WT8) { u32x2 q; q.x = q8x4(s[0 * 33], s[1 * 33], s[2 * 33], s[3 * 33], Q_SW); q.y = q8x4(s[4 * 33], s[5 * 33], s[6 * 33], s[7 * 33], Q_SW); *(u32x2*)(WT8 + (size_t)(drow - 12800 + n) * K + k0 + 8 * c) = q; } }
    asm volatile("s_waitcnt lgkmcnt(0)" ::: "memory");
}
__device__ __forceinline__ int win_dst(int n) {
    if (n < 4608) return n;
    if (n < 5120) return 10240 + (n - 4608);
    if (n < 6656) return 4608 + (n - 5120);
    if (n < 7680) return 10240 + 512 + (n - 6656);
    if (n < 11776) return 6144 + (n - 7680);
    if (n < 12800) return 10240 + 1536 + (n - 11776);
    return n;
}
struct Weights { const float *win, *wa, *wb, *wc, *wo; };
__device__ __forceinline__ void transpose_weights(const Weights& Wt, unsigned char* ws, LAS unsigned char* lds, int gw, int NGW, int wave, int lane) {
    LAS float* scr = (LAS float*)(lds + wave * 8448);
    constexpr int I_IN = 32 * (NIN / 32), I_A = 8 * 64, I_B = 16 * 64, I_C = 16 * 64, I_O = 32 * 64;
    constexpr int NITEMS = I_IN + I_A + I_B + I_C + I_O;
    for (int it = gw; it < NITEMS; it += NGW) {
        int r = it;
        if (r < I_IN) { const int nb = r % (NIN / 32), kb = r / (NIN / 32); transpose_item(Wt.win, D, NIN, (bf16_t*)(ws + WS_WIN), win_dst(nb * 32), scr, kb * 64, nb * 32, lane, nb * 32 >= 12800 ? (signed char*)(ws + WS_WM8) : nullptr); continue; } r -= I_IN;
        if (r < I_A) { const int nb = r % 64, kb = r / 64; transpose_item(Wt.wa, 512, D, (bf16_t*)(ws + WS_WA), nb * 32, scr, kb * 64, nb * 32, lane); continue; } r -= I_A;
        if (r < I_B) { const int nb = r % 64, kb = r / 64; transpose_item(Wt.wb, 1024, D, (bf16_t*)(ws + WS_WB), nb * 32, scr, kb * 64, nb * 32, lane); continue; } r -= I_B;
        if (r < I_C) { const int nb = r % 64, kb = r / 64; transpose_item(Wt.wc, 1024, D, (bf16_t*)(ws + WS_WC), nb * 32, scr, kb * 64, nb * 32, lane); continue; } r -= I_C;
        { const int nb = r % 64, kb = r / 64; transpose_item(Wt.wo, D, D, (bf16_t*)(ws + WS_WO), nb * 32, scr, kb * 64, nb * 32, lane); }
    }
}
__device__ __forceinline__ void prenorm_row(const float* xrow, const float* gain, bf16_t* orow, unsigned* orow8, int lane) {
    f32x4 v[8]; float s = 0.f;
#pragma unroll
    for (int j = 0; j < 8; ++j) { v[j] = ((const f32x4*)xrow)[lane + 64 * j]; s += (v[j].x * v[j].x + v[j].y * v[j].y) + (v[j].z * v[j].z + v[j].w * v[j].w); }
    const float r = 1.0f / sqrtf(wave_sum(s) * (1.0f / D) + NORM_EPS);
#pragma unroll
    for (int j = 0; j < 8; ++j) { const f32x4 g = ((const f32x4*)gain)[lane + 64 * j]; const float a = v[j].x * r * g.x, b = v[j].y * r * g.y, c = v[j].z * r * g.z, d = v[j].w * r * g.w;
        u32x2 o; o.x = pk2(a, b); o.y = pk2(c, d); ((u32x2*)orow)[lane + 64 * j] = o; orow8[lane + 64 * j] = q8x4(a, b, c, d, Q_SX); }
}
template <int NR>
__device__ __forceinline__ void final_rows(const bf16_t* const (&orow)[NR], const float* post, const float* const (&xold)[NR], float* const (&xnew)[NR], const float* pre_next, bf16_t* const (&xn_next)[NR], unsigned* const (&xn8_next)[NR], int lane) {
    f32x4 v[NR][8], xo[NR][8]; float s[NR];
#pragma unroll
    for (int q = 0; q < NR; ++q) { s[q] = 0.f;
#pragma unroll
        for (int j = 0; j < 8; ++j) { const u32x2 r = ((const u32x2*)orow[q])[lane + 64 * j];
            v[q][j].x = __builtin_bit_cast(float, r.x << 16); v[q][j].y = __builtin_bit_cast(float, r.x & 0xffff0000u); v[q][j].z = __builtin_bit_cast(float, r.y << 16); v[q][j].w = __builtin_bit_cast(float, r.y & 0xffff0000u);
            s[q] += (v[q][j].x * v[q][j].x + v[q][j].y * v[q][j].y) + (v[q][j].z * v[q][j].z + v[q][j].w * v[q][j].w); }
#pragma unroll
        for (int j = 0; j < 8; ++j) xo[q][j] = ((const f32x4*)xold[q])[lane + 64 * j]; }
#pragma unroll
    for (int q = 0; q < NR; ++q) {
        const float r = 1.0f / sqrtf(wave_sum(s[q]) * (1.0f / D) + NORM_EPS);
        float s2 = 0.f;
#pragma unroll
        for (int j = 0; j < 8; ++j) { const f32x4 g = ((const f32x4*)post)[lane + 64 * j];
            f32x4 y; y.x = xo[q][j].x + v[q][j].x * r * g.x; y.y = xo[q][j].y + v[q][j].y * r * g.y; y.z = xo[q][j].z + v[q][j].z * r * g.z; y.w = xo[q][j].w + v[q][j].w * r * g.w;
            v[q][j] = y; s2 += (y.x * y.x + y.y * y.y) + (y.z * y.z + y.w * y.w); ((f32x4*)xnew[q])[lane + 64 * j] = y; }
        if (pre_next) {
            const float r2 = 1.0f / sqrtf(wave_sum(s2) * (1.0f / D) + NORM_EPS);
#pragma unroll
            for (int j = 0; j < 8; ++j) { const f32x4 g = ((const f32x4*)pre_next)[lane + 64 * j]; const float a = v[q][j].x * r2 * g.x, b = v[q][j].y * r2 * g.y, c = v[q][j].z * r2 * g.z, d = v[q][j].w * r2 * g.w;
                u32x2 o; o.x = pk2(a, b); o.y = pk2(c, d); ((u32x2*)xn_next[q])[lane + 64 * j] = o; xn8_next[q][lane + 64 * j] = q8x4(a, b, c, d, Q_SX); }
        }
    }
}

#define EPI_LOOP_BEGIN \
    const int row0 = u.pm * 256 + wr * 64 + fr; const int colb = u.pn * 256 + wc * 32 + 8 * fq; \
    _Pragma("unroll") for (int ai = 0; ai < 2; ++ai) _Pragma("unroll") for (int m = 0; m < 4; ++m) { const int row = row0 + ai * 128 + m * 16; \
    _Pragma("unroll") for (int bj = 0; bj < 2; ++bj) { const int col = colb + bj * 128; const f32x4 v0 = acc[ai][bj][m][0], v1 = acc[ai][bj][m][1];
#define EPI_LOOP_END } }

struct EpiStoreBf16 {
    static constexpr bool PERM = true, AFTER_DRAIN = false;
    bf16_t* O; int ldc;
    __device__ __forceinline__ void operator()(const f32x4 (&acc)[2][2][4][2], const pg8::Unit& u, int wr, int wc, int fr, int fq) const {
        EPI_LOOP_BEGIN
            u32x4 w; w.x = pk2(v0[0], v0[1]); w.y = pk2(v0[2], v0[3]); w.z = pk2(v1[0], v1[1]); w.w = pk2(v1[2], v1[3]);
            *(u32x4*)(O + (size_t)row * ldc + col) = w;
        EPI_LOOP_END
    }
};
struct EpiStoreRope {
    static constexpr bool PERM = true, AFTER_DRAIN = false;
    bf16_t* O; int ldc;
    __device__ __forceinline__ void operator()(const f32x4 (&acc)[2][2][4][2], const pg8::Unit& u, int wr, int wc, int fr, int fq) const {
        const bool rt = (wc == 0) && ((u.pn < 12) || (u.pn >= 18 && u.pn < 23));
        const float sgn = (fq < 2) ? -1.f : 1.f;
        const int row0 = u.pm * 256 + wr * 64 + fr; const int colb = u.pn * 256 + wc * 32 + 8 * fq;
        float irev[8];
        if (rt) {
#pragma unroll
            for (int i = 0; i < 8; ++i) irev[i] = __builtin_amdgcn_exp2f(-(float)((fq & 1) * 8 + i) * (18.931568569324174f / 16.0f) - 2.651496129472319f);
        }
#pragma unroll
        for (int ai = 0; ai < 2; ++ai)
#pragma unroll
            for (int m = 0; m < 4; ++m) { const int row = row0 + ai * 128 + m * 16;
                float cs[8], sn[8];
                if (rt) { const float pos = (float)(row & (S - 1));
#pragma unroll
                    for (int i = 0; i < 8; ++i) { const float fr_ = __builtin_amdgcn_fractf(pos * irev[i]); cs[i] = __builtin_amdgcn_cosf(fr_); sn[i] = sgn * __builtin_amdgcn_sinf(fr_); } }
#pragma unroll
                for (int bj = 0; bj < 2; ++bj) { const int col = colb + bj * 128; const f32x4 v0 = acc[ai][bj][m][0], v1 = acc[ai][bj][m][1];
                    float y[8] = {v0[0], v0[1], v0[2], v0[3], v1[0], v1[1], v1[2], v1[3]};
                    if (rt) {
#pragma unroll
                        for (int i = 0; i < 8; ++i) { const float pt = __shfl_xor(y[i], 32); y[i] = y[i] * cs[i] + pt * sn[i]; } }
                    if (u.pn >= 24 && u.pn < 28) {
#pragma unroll
                        for (int i = 0; i < 8; ++i) y[i] = y[i] * fast_sigmoid(y[i]); }
                    u32x4 w; w.x = pk2(y[0], y[1]); w.y = pk2(y[2], y[3]); w.z = pk2(y[4], y[5]); w.w = pk2(y[6], y[7]);
                    *(u32x4*)(O + (size_t)row * ldc + col) = w; } }
    }
};
struct EpiSigmoidBf16 {
    static constexpr bool PERM = true, AFTER_DRAIN = false;
    bf16_t* O; int ldc;
    __device__ __forceinline__ void operator()(const f32x4 (&acc)[2][2][4][2], const pg8::Unit& u, int wr, int wc, int fr, int fq) const {
        EPI_LOOP_BEGIN
            u32x4 w; w.x = pk2(fast_sigmoid(v0[0]), fast_sigmoid(v0[1])); w.y = pk2(fast_sigmoid(v0[2]), fast_sigmoid(v0[3]));
            w.z = pk2(fast_sigmoid(v1[0]), fast_sigmoid(v1[1])); w.w = pk2(fast_sigmoid(v1[2]), fast_sigmoid(v1[3]));
            *(u32x4*)(O + (size_t)row * ldc + col) = w;
        EPI_LOOP_END
    }
};
struct EpiSigmoidI8 {
    static constexpr bool PERM = true, AFTER_DRAIN = false;
    unsigned char* O; int ldc; float dq;
    __device__ __forceinline__ void operator()(const f32x4 (&acc)[2][2][4][2], const pg8::Unit& u, int wr, int wc, int fr, int fq) const {
        EPI_LOOP_BEGIN
            const pg8::i32x4 i0 = __builtin_bit_cast(pg8::i32x4, v0), i1 = __builtin_bit_cast(pg8::i32x4, v1);
            unsigned b[8];
#pragma unroll
            for (int i = 0; i < 4; ++i) { b[i] = (unsigned)(255.0f * fast_sigmoid((float)i0[i] * dq) + 0.5f); b[4 + i] = (unsigned)(255.0f * fast_sigmoid((float)i1[i] * dq) + 0.5f); }
            u32x2 w; w.x = b[0] | (b[1] << 8) | (b[2] << 16) | (b[3] << 24); w.y = b[4] | (b[5] << 8) | (b[6] << 16) | (b[7] << 24);
            *(u32x2*)(O + (size_t)row * ldc + col) = w;
        EPI_LOOP_END
    }
};
struct EpiStoreF32 {
    static constexpr bool PERM = true, AFTER_DRAIN = false;
    float* O; int ldc;
    __device__ __forceinline__ void operator()(const f32x4 (&acc)[2][2][4][2], const pg8::Unit& u, int wr, int wc, int fr, int fq) const {
        EPI_LOOP_BEGIN
            float* p = O + (size_t)row * ldc + col; *(f32x4*)p = v0; *(f32x4*)(p + 4) = v1;
        EPI_LOOP_END
    }
};
__device__ __forceinline__ void unpack8(const u32x4 g, float (&f)[8]) {
    f[0] = __builtin_bit_cast(float, g.x << 16); f[1] = __builtin_bit_cast(float, g.x & 0xffff0000u); f[2] = __builtin_bit_cast(float, g.y << 16); f[3] = __builtin_bit_cast(float, g.y & 0xffff0000u);
    f[4] = __builtin_bit_cast(float, g.z << 16); f[5] = __builtin_bit_cast(float, g.z & 0xffff0000u); f[6] = __builtin_bit_cast(float, g.w << 16); f[7] = __builtin_bit_cast(float, g.w & 0xffff0000u);
}
template <bool FIRST> struct EpiBranch {
    static constexpr bool PERM = true, AFTER_DRAIN = false;
    bf16_t* YM; const unsigned char* G; int br;
    __device__ __forceinline__ void operator()(const f32x4 (&acc)[2][2][4][2], const pg8::Unit& u, int wr, int wc, int fr, int fq) const {
        const int row0 = u.pm * 256 + wr * 64 + fr; const int colb = u.pn * 256 + wc * 32 + 8 * fq;
#pragma unroll
        for (int ai = 0; ai < 2; ++ai) {
            u32x2 gv[4][2]; u32x4 yv[4][2];
#pragma unroll
            for (int m = 0; m < 4; ++m)
#pragma unroll
                for (int bj = 0; bj < 2; ++bj) { const int row = row0 + ai * 128 + m * 16, col = colb + bj * 128;
                    gv[m][bj] = *(const u32x2*)(G + (size_t)row * G_PITCH + br * 2048 + col);
                    if (!FIRST) yv[m][bj] = *(const u32x4*)(YM + (size_t)row * D + col); }
#pragma unroll
            for (int m = 0; m < 4; ++m)
#pragma unroll
                for (int bj = 0; bj < 2; ++bj) { const int row = row0 + ai * 128 + m * 16, col = colb + bj * 128; const f32x4 v0 = acc[ai][bj][m][0], v1 = acc[ai][bj][m][1];
                    float g[8], y[8];
#pragma unroll
                    for (int i = 0; i < 4; ++i) { g[i] = (float)((gv[m][bj].x >> (8 * i)) & 0xffu) * (1.0f / 255.0f); g[4 + i] = (float)((gv[m][bj].y >> (8 * i)) & 0xffu) * (1.0f / 255.0f); }
                    y[0] = v0[0] * g[0]; y[1] = v0[1] * g[1]; y[2] = v0[2] * g[2]; y[3] = v0[3] * g[3]; y[4] = v1[0] * g[4]; y[5] = v1[1] * g[5]; y[6] = v1[2] * g[6]; y[7] = v1[3] * g[7];
                    if (!FIRST) { float o[8]; unpack8(yv[m][bj], o);
#pragma unroll
                        for (int i = 0; i < 8; ++i) y[i] += o[i]; }
                    u32x4 w; w.x = pk2(y[0], y[1]); w.y = pk2(y[2], y[3]); w.z = pk2(y[4], y[5]); w.w = pk2(y[6], y[7]);
                    *(u32x4*)(YM + (size_t)row * D + col) = w; }
        }
    }
};
struct EpiGate {
    static constexpr bool PERM = true, AFTER_DRAIN = false;
    bf16_t *Ya, *Yb, *Yc; const bf16_t* P; const float* lse;
    __device__ __forceinline__ void operator()(const f32x4 (&acc)[2][2][4][2], const pg8::Unit& u, int wr, int wc, int fr, int fq) const {
        const int row0 = u.pm * 256 + wr * 64 + fr; const int colb = u.pn * 256 + wc * 32 + 8 * fq;
        if (u.pn >= 2) {
            bf16_t* Y = (u.pn < 6) ? Yb : Yc; const int cofs = (u.pn < 6) ? 512 : 1536;
#pragma unroll
            for (int ai = 0; ai < 2; ++ai) {
                u32x4 rv[4][2];
#pragma unroll
                for (int m = 0; m < 4; ++m)
#pragma unroll
                    for (int bj = 0; bj < 2; ++bj) rv[m][bj] = *(const u32x4*)(Y + (size_t)(row0 + ai * 128 + m * 16) * 1024 + (colb + bj * 128 - cofs));
#pragma unroll
                for (int m = 0; m < 4; ++m)
#pragma unroll
                    for (int bj = 0; bj < 2; ++bj) { const f32x4 v0 = acc[ai][bj][m][0], v1 = acc[ai][bj][m][1];
                        float raw[8]; unpack8(rv[m][bj], raw);
                        const float a[8] = {v0[0], v0[1], v0[2], v0[3], v1[0], v1[1], v1[2], v1[3]};
                        float y[8];
#pragma unroll
                        for (int i = 0; i < 8; ++i) y[i] = raw[i] * a[i] * fast_sigmoid(a[i]);
                        u32x4 w; w.x = pk2(y[0], y[1]); w.y = pk2(y[2], y[3]); w.z = pk2(y[4], y[5]); w.w = pk2(y[6], y[7]);
                        *(u32x4*)(Y + (size_t)(row0 + ai * 128 + m * 16) * 1024 + (colb + bj * 128 - cofs)) = w; }
            }
        } else {
#pragma unroll
            for (int ai = 0; ai < 2; ++ai)
#pragma unroll
                for (int mp = 0; mp < 4; ++mp) {
                    u32x4 ov[1][2][3]; float lv[1][2][3];
#pragma unroll
                    for (int mm = 0; mm < 1; ++mm)
#pragma unroll
                        for (int bj = 0; bj < 2; ++bj) { const int row = row0 + ai * 128 + (mp + mm) * 16, col = colb + bj * 128, slot = col >> 7;
#pragma unroll
                            for (int g = 0; g < 3; ++g) { ov[mm][bj][g] = *(const u32x4*)(P + (size_t)row * PC + g * 512 + col); lv[mm][bj][g] = lse[((size_t)g * T + row) * 4 + slot]; } }
#pragma unroll
                    for (int mm = 0; mm < 1; ++mm)
#pragma unroll
                        for (int bj = 0; bj < 2; ++bj) { const int m = mp + mm; const int row = row0 + ai * 128 + m * 16, col = colb + bj * 128; const f32x4 v0 = acc[ai][bj][m][0], v1 = acc[ai][bj][m][1];
                            const float l0 = lv[mm][bj][0], l1 = lv[mm][bj][1], l2 = lv[mm][bj][2];
                            const float mx = fmaxf(l0, fmaxf(l1, l2)); float e0 = __expf(l0 - mx), e1 = __expf(l1 - mx), e2 = __expf(l2 - mx);
                            const float inv = 1.0f / (e0 + e1 + e2); e0 *= inv; e1 *= inv; e2 *= inv;
                            float o0[8], o1[8], o2[8]; unpack8(ov[mm][bj][0], o0); unpack8(ov[mm][bj][1], o1); unpack8(ov[mm][bj][2], o2);
                            const float a[8] = {v0[0], v0[1], v0[2], v0[3], v1[0], v1[1], v1[2], v1[3]};
                            float y[8];
#pragma unroll
                            for (int i = 0; i < 8; ++i) y[i] = (e0 * o0[i] + e1 * o1[i] + e2 * o2[i]) * a[i] * fast_sigmoid(a[i]);
                            u32x4 w; w.x = pk2(y[0], y[1]); w.y = pk2(y[2], y[3]); w.z = pk2(y[4], y[5]); w.w = pk2(y[6], y[7]);
                            *(u32x4*)(Ya + (size_t)row * 512 + col) = w; }
                }
        }
    }
};

constexpr int KP = 136;
struct AttnSrc { const bf16_t* Kg; const bf16_t* Vg; const bf16_t* Qrow; long tok0; int dil, kbase, L; };
template <int NKK, int NKV> struct StageRegs { bf16x8 k[(NKK * 16 + 511) / 512]; bf16x8 v[((NKV / 16) * 4 + 7) / 8]; bf16x8 q[4]; };
template <int NKK, int NKV, bool WITHQ>
__device__ __forceinline__ void stage_load(StageRegs<NKK, NKV>& R, const AttnSrc& A, int tid) {
    constexpr int KI = (NKK * 16 + 511) / 512, VI = ((NKV / 16) * 4 + 7) / 8;
    const int wave = tid >> 6, lane = tid & 63;
#pragma unroll
    for (int i = 0; i < KI; ++i) { const int task = tid + i * 512; const int row = task >> 4, c = task & 15; const int ki = A.kbase + row;
        bf16x8 v = (bf16x8){0, 0, 0, 0, 0, 0, 0, 0};
        if (task < NKK * 16 && ki >= 0 && ki < A.L) v = *(const bf16x8*)(A.Kg + (size_t)(A.tok0 + (long)ki * A.dil) * PC + c * 8);
        R.k[i] = v; }
#pragma unroll
    for (int i = 0; i < VI; ++i) { const int it = wave + 8 * i; const int row = (it >> 2) * 16 + (lane & 15), c = (it & 3) * 4 + (lane >> 4); const int ki = A.kbase + row;
        bf16x8 v = (bf16x8){0, 0, 0, 0, 0, 0, 0, 0};
        if (it < (NKV / 16) * 4 && ki >= 0 && ki < A.L) v = *(const bf16x8*)(A.Vg + (size_t)(A.tok0 + (long)ki * A.dil) * PC + c * 8);
        R.v[i] = v; }
    if (WITHQ) {
#pragma unroll
        for (int ks = 0; ks < 4; ++ks) R.q[ks] = *(const bf16x8*)(A.Qrow + ks * 32 + (lane >> 4) * 8); }
}
template <int NKK, int NKV, int VP>
__device__ __forceinline__ void stage_store(const StageRegs<NKK, NKV>& R, LAS bf16_t* Ks, LAS bf16_t* Vt, int tid) {
    constexpr int KI = (NKK * 16 + 511) / 512, VI = ((NKV / 16) * 4 + 7) / 8;
    const int wave = tid >> 6, lane = tid & 63;
#pragma unroll
    for (int i = 0; i < KI; ++i) { const int task = tid + i * 512; const int row = task >> 4, c = task & 15;
        if (task < NKK * 16) *(LAS bf16x8*)(Ks + row * KP + c * 8) = R.k[i]; }
#pragma unroll
    for (int i = 0; i < VI; ++i) { const int it = wave + 8 * i; const int row = (it >> 2) * 16 + (lane & 15), c = (it & 3) * 4 + (lane >> 4);
        if (it < (NKV / 16) * 4) {
            const u32x4 wv = __builtin_bit_cast(u32x4, R.v[i]); const bool odd = lane & 1;
            const unsigned rx = __shfl_xor(odd ? wv.x : wv.z, 1), ry = __shfl_xor(odd ? wv.y : wv.w, 1);
            const unsigned a0 = odd ? rx : wv.x, b0 = odd ? wv.z : rx, a1 = odd ? ry : wv.y, b1 = odd ? wv.w : ry;
            LAS unsigned* vp = (LAS unsigned*)(Vt + (c * 8 + (odd ? 4 : 0)) * VP + (row & ~1));
            vp[0] = (a0 & 0xffffu) | (b0 << 16); vp[VP / 2] = (a0 >> 16) | (b0 & 0xffff0000u);
            vp[VP] = (a1 & 0xffffu) | (b1 << 16); vp[VP + VP / 2] = (a1 >> 16) | (b1 & 0xffff0000u); } }
}
template <int NT, int VP>
__device__ __forceinline__ void attn_wave(const LAS bf16_t* Ks, const LAS bf16_t* Vt, int kt0, const bf16x8 (&qf)[4], int qi, int kbase, int L, int hw,
                                          bool has_sink, float sink, f32x4 (&o)[8], float& lse_out, int lane) {
    const int lr = lane & 15, lq = lane >> 4;
    f32x4 s[NT];
#pragma unroll
    for (int kt = 0; kt < NT - 1; ++kt) { f32x4 a = (f32x4){0.f, 0.f, 0.f, 0.f}; const LAS bf16_t* kp = Ks + (kt0 + 16 * kt + lr) * KP + lq * 8;
#pragma unroll
        for (int ks = 0; ks < 4; ++ks) a = mfma16(*(const LAS bf16x8*)(kp + ks * 32), qf[ks], a);
        s[kt] = a; }
    s[NT - 1] = (f32x4){-INFINITY, -INFINITY, -INFINITY, -INFINITY};
    const bool edge = (kbase + kt0 < 0) || (kbase + kt0 + 16 * NT > L);
#pragma unroll
    for (int kt = 0; kt < NT - 1; ++kt) {
        if (kt == 0 || kt == NT - 2 || edge) {
#pragma unroll
            for (int j = 0; j < 4; ++j) { const int ki = kbase + kt0 + 16 * kt + lq * 4 + j; const int rel = ki - qi;
                const bool ok = (ki >= 0) && (ki < L) && (rel <= hw) && (rel >= -hw);
                s[kt][j] = ok ? s[kt][j] : -INFINITY; } }
    }
    float m = -INFINITY;
#pragma unroll
    for (int kt = 0; kt < NT - 1; ++kt) m = fmaxf(fmaxf(m, fmaxf(s[kt][0], s[kt][1])), fmaxf(s[kt][2], s[kt][3]));
    m = fmaxf(m, __shfl_xor(m, 16)); m = fmaxf(m, __shfl_xor(m, 32));
    const float sc = 0.08838834764831845f * 1.4426950408889634f;
    float m2 = m * sc;
    if (has_sink) m2 = fmaxf(m2, sink * 1.4426950408889634f);
    float den = 0.f;
#pragma unroll
    for (int kt = 0; kt < NT - 1; ++kt)
#pragma unroll
        for (int j = 0; j < 4; ++j) { const float p = __builtin_amdgcn_exp2f(s[kt][j] * sc - m2); s[kt][j] = p; den += p; }
    s[NT - 1] = (f32x4){0.f, 0.f, 0.f, 0.f};
    den += __shfl_xor(den, 16); den += __shfl_xor(den, 32);
    if (has_sink) den += __builtin_amdgcn_exp2f(sink * 1.4426950408889634f - m2);
#pragma unroll
    for (int dt = 0; dt < 8; ++dt) o[dt] = (f32x4){0.f, 0.f, 0.f, 0.f};
#pragma unroll
    for (int t = 0; t < NT / 2; ++t) {
        u32x4 pw; pw.x = pk2(s[2 * t][0], s[2 * t][1]); pw.y = pk2(s[2 * t][2], s[2 * t][3]); pw.z = pk2(s[2 * t + 1][0], s[2 * t + 1][1]); pw.w = pk2(s[2 * t + 1][2], s[2 * t + 1][3]);
        const bf16x8 p = __builtin_bit_cast(bf16x8, pw);
#pragma unroll
        for (int dt = 0; dt < 8; ++dt) { const LAS bf16_t* vp = Vt + (dt * 16 + lr) * VP + kt0 + 32 * t + lq * 4;
            const u32x2 a0 = *(const LAS u32x2*)vp, a1 = *(const LAS u32x2*)(vp + 16);
            u32x4 aw; aw.x = a0.x; aw.y = a0.y; aw.z = a1.x; aw.w = a1.y;
            o[dt] = mfma16(__builtin_bit_cast(bf16x8, aw), p, o[dt]); }
    }
    const float inv = 1.0f / den;
#pragma unroll
    for (int dt = 0; dt < 8; ++dt) o[dt] = o[dt] * inv;
    lse_out = (m2 + __builtin_amdgcn_logf(den)) * 0.6931471805599453f;
}
constexpr int A_NK = 272, A_VP = 280, B_NKK = 288, B_NKV = 304, B_VP = 312;
struct AUnit { int g, slot, dil, phase, jb, L; long tok0; };
__device__ __forceinline__ AUnit decodeA(int u) { AUnit a; const int b = u / 1536, r = u % 1536; a.g = r >> 9; const int r2 = r & 511; a.slot = r2 >> 7; const int blk = r2 & 127;
    const int sh = 2 * a.g; a.dil = 1 << sh; const int nbp = 128 >> sh; a.phase = blk / nbp; a.jb = blk % nbp; a.L = S >> sh; a.tok0 = (long)b * S + a.phase; return a; }
__device__ __forceinline__ AttnSrc srcA(const AUnit& a, const bf16_t* P, int tid) { const int head = a.g * 4 + a.slot; const int w = tid >> 6, lr = tid & 15;
    const int qi = a.jb * 128 + 16 * w + lr;
    AttnSrc s; s.Kg = P + PA_K + head * 128; s.Vg = P + PA_V + head * 128; s.Qrow = P + (size_t)(a.tok0 + (long)qi * a.dil) * PC + PA_Q + head * 128; s.tok0 = a.tok0; s.dil = a.dil; s.kbase = a.jb * 128 - 64; s.L = a.L; return s; }
__device__ __forceinline__ void attnA_phase(bf16_t* P, float* lse, LAS unsigned char* lds, int tid, int bx, int G) {
    LAS bf16_t* Ks = (LAS bf16_t*)lds; LAS bf16_t* Vt = (LAS bf16_t*)(lds + A_NK * KP * 2);
    StageRegs<A_NK, A_NK> R;
    int u = bx;
    if (u < 3072) { const AUnit a = decodeA(u); stage_load<A_NK, A_NK, true>(R, srcA(a, P, tid), tid); }
    for (; u < 3072; u += G) {
        const AUnit a = decodeA(u);
        stage_store<A_NK, A_NK, A_VP>(R, Ks, Vt, tid);
        bf16x8 qf[4];
#pragma unroll
        for (int ks = 0; ks < 4; ++ks) qf[ks] = R.q[ks];
        __syncthreads();
        if (u + G < 3072) { const AUnit an = decodeA(u + G); stage_load<A_NK, A_NK, true>(R, srcA(an, P, tid), tid); }
        const int w = tid >> 6, lane = tid & 63, lr = lane & 15, lq = lane >> 4;
        const int qi = a.jb * 128 + 16 * w + lr; const long token = a.tok0 + (long)qi * a.dil; const int head = a.g * 4 + a.slot;
        f32x4 o[8]; float lv;
        attn_wave<10, A_VP>(Ks, Vt, 16 * w, qf, qi, a.jb * 128 - 64, a.L, 64, false, 0.f, o, lv, lane);
        bf16_t* qrow = P + (size_t)token * PC + PA_Q + head * 128;
#pragma unroll
        for (int dt = 0; dt < 8; ++dt) { u32x2 wv; wv.x = pk2(o[dt][0], o[dt][1]); wv.y = pk2(o[dt][2], o[dt][3]); *(u32x2*)(qrow + dt * 16 + lq * 4) = wv; }
        if (lq == 0) lse[((size_t)a.g * T + token) * 4 + a.slot] = lv;
        __syncthreads();
    }
}
__device__ __forceinline__ AttnSrc srcB(int u, const bf16_t* P, int tid) { const int b = u >> 10, r = u & 1023, kvh = r >> 9, blk = r & 511; const int w = tid >> 6, lr = tid & 15;
    const int head = kvh * 4 + (w >> 1), qi = blk * 32 + 16 * (w & 1) + lr;
    AttnSrc s; s.Kg = P + PB_K + kvh * 128; s.Vg = P + PB_V + kvh * 128; s.tok0 = (long)b * S; s.Qrow = P + (size_t)(s.tok0 + qi) * PC + PB_Q + head * 128; s.dil = 1; s.kbase = blk * 32 - 128; s.L = S; return s; }
__device__ __forceinline__ void attnB_phase(const bf16_t* P, bf16_t* Yb, const float* sinks, LAS unsigned char* lds, int tid, int bx, int G) {
    LAS bf16_t* Ks = (LAS bf16_t*)lds; LAS bf16_t* Vt = (LAS bf16_t*)(lds + B_NKK * KP * 2);
    StageRegs<B_NKK, B_NKV> R;
    int u = bx;
    if (u < 2048) stage_load<B_NKK, B_NKV, false>(R, srcB(u, P, tid), tid);
    for (; u < 2048; u += G) {
        bf16x8 qf[4];
        { const AttnSrc sq = srcB(u, P, tid);
#pragma unroll
          for (int ks = 0; ks < 4; ++ks) qf[ks] = *(const bf16x8*)(sq.Qrow + ks * 32 + ((tid & 63) >> 4) * 8); }
        stage_store<B_NKK, B_NKV, B_VP>(R, Ks, Vt, tid);
        __syncthreads();
        if (u + G < 2048) stage_load<B_NKK, B_NKV, false>(R, srcB(u + G, P, tid), tid);
        const int b = u >> 10, r = u & 1023, kvh = r >> 9, blk = r & 511;
        const int w = tid >> 6, lane = tid & 63, lr = lane & 15, lq = lane >> 4;
        const int head = kvh * 4 + (w >> 1), rg = w & 1;
        const int qi = blk * 32 + 16 * rg + lr; const long token = (long)b * S + qi;
        f32x4 o[8]; float lv;
        attn_wave<18, B_VP>(Ks, Vt, 16 * rg, qf, qi, blk * 32 - 128, S, 128, true, sinks[head], o, lv, lane);
        bf16_t* orow = Yb + (size_t)token * 1024 + head * 128;
#pragma unroll
        for (int dt = 0; dt < 8; ++dt) { u32x2 wv; wv.x = pk2(o[dt][0], o[dt][1]); wv.y = pk2(o[dt][2], o[dt][3]); *(u32x2*)(orow + dt * 16 + lq * 4) = wv; }
        __syncthreads();
    }
}

constexpr int H_QT = 0, H_KT = 17408, H_QH = 34816, H_KHT = 52224, H_VT = 70656, H_ST = 89088, H_SC = 123904, H_QS = 133120, H_DEC = 135168;
__device__ __forceinline__ void hgrn_unit(int b, int h, int seg, int dir, int mode, bf16_t* P, const float* lb, float* SUM, float* LSUM, LAS unsigned char* lds, int tid) {
    const int w = tid >> 6, lane = tid & 63, lr = lane & 15, lq = lane >> 4;
    const int k = tid & 127, tq = tid >> 7;
    LAS bf16_t* Qt = (LAS bf16_t*)(lds + H_QT); LAS bf16_t* Kt = (LAS bf16_t*)(lds + H_KT);
    LAS bf16_t* KhT = (LAS bf16_t*)(lds + H_KHT); LAS bf16_t* VT = (LAS bf16_t*)(lds + H_VT); LAS bf16_t* ST = (LAS bf16_t*)(lds + H_ST);
    LAS bf16_t* Sc = (LAS bf16_t*)(lds + H_SC); LAS float* QS = (LAS float*)(lds + H_QS); LAS float* DEC = (LAS float*)(lds + H_DEC);
    const float lbv = lb[h * 128 + k], oml = 1.0f - lbv;
    f32x4 Sacc[8];
#pragma unroll
    for (int vt = 0; vt < 8; ++vt) Sacc[vt] = (f32x4){0.f, 0.f, 0.f, 0.f};
    float lsum = 0.f;
    const int chain = ((b * 8 + h) * 2 + dir) * 16;
    if (mode == 1) {
        const int nprev = dir ? 15 - seg : seg;
        f32x4 nx[8], nl;
        if (nprev > 0) { const int su = chain + (dir ? 15 : 0); const float* sp = SUM + (size_t)su * 16384; nl = *(const f32x4*)(LSUM + su * 128 + 16 * w + lq * 4);
#pragma unroll
            for (int vt = 0; vt < 8; ++vt) nx[vt] = *(const f32x4*)(sp + ((w * 8 + vt) * 64 + lane) * 4); }
        for (int jj = 0; jj < nprev; ++jj) {
            f32x4 cx[8]; const f32x4 lv = nl;
#pragma unroll
            for (int vt = 0; vt < 8; ++vt) cx[vt] = nx[vt];
            if (jj + 1 < nprev) { const int su = chain + (dir ? 14 - jj : jj + 1); const float* sp = SUM + (size_t)su * 16384; nl = *(const f32x4*)(LSUM + su * 128 + 16 * w + lq * 4);
#pragma unroll
                for (int vt = 0; vt < 8; ++vt) nx[vt] = *(const f32x4*)(sp + ((w * 8 + vt) * 64 + lane) * 4); }
            f32x4 dv; dv.x = __expf(lv.x); dv.y = __expf(lv.y); dv.z = __expf(lv.z); dv.w = __expf(lv.w);
#pragma unroll
            for (int vt = 0; vt < 8; ++vt) Sacc[vt] = Sacc[vt] * dv + cx[vt]; }
    }
    typedef __attribute__((address_space(1))) const bf16_t gbf16_t;
    gbf16_t* Pg = (gbf16_t*)P;
    const unsigned colF = (dir ? PC_FB : PC_FF) + h * 128 + k, colV = PC_I + h * 128 + k, colQ = PC_Q + h * 128 + k;
    unsigned short nfz[16], nv[16], nq[16];
#define HG_ROW0(cc_) ((unsigned)((b * S + (seg * 16 + (dir ? 15 - (cc_) : (cc_))) * 64 + (dir ? 63 - tq * 16 : tq * 16)) * PC))
#define HG_LOAD_F(cc_) do { unsigned vo_ = HG_ROW0(cc_) + colF; asm volatile("" : "+v"(vo_)); \
        _Pragma("unroll") for (int ii = 0; ii < 16; ++ii) nfz[ii] = Pg[dir ? vo_ - (unsigned)(ii * PC) : vo_ + (unsigned)(ii * PC)]; } while (0)
#define HG_LOAD_QV(cc_) do { unsigned vo_ = HG_ROW0(cc_); asm volatile("" : "+v"(vo_)); \
        _Pragma("unroll") for (int ii = 0; ii < 16; ++ii) { const unsigned ro_ = dir ? vo_ - (unsigned)(ii * PC) : vo_ + (unsigned)(ii * PC); \
            nv[ii] = Pg[ro_ + colV]; if (mode == 1) nq[ii] = Pg[ro_ + colQ]; } } while (0)
    float lf[16], kk[16];
#define HG_STAGE1(qb_) do { \
        _Pragma("unroll") for (int ii = 0; ii < 16; ++ii) { const float fz = bf2f(nfz[ii]); const float e = __expf(-fz), sg = __builtin_amdgcn_rcpf(1.0f + e); \
            lf[ii] = __logf(lbv + oml * sg); kk[ii] = oml * e * sg; } \
        _Pragma("unroll") for (int ii = 1; ii < 16; ++ii) lf[ii] += lf[ii - 1]; \
        QS[(qb_) * 640 + tq * 128 + k] = lf[15]; } while (0)
    HG_LOAD_F(0); HG_LOAD_QV(0);
    HG_STAGE1(0);
    HG_LOAD_F(1);
    __syncthreads();
    for (int cc = 0; cc < 16; ++cc) {
        const int c = seg * 16 + (dir ? 15 - cc : cc); const long btok = (long)b * S + c * 64;
        LAS float* QSc = QS + (cc & 1) * 640;
        const float q0 = QSc[k], q1 = QSc[128 + k], q2 = QSc[256 + k], q3 = QSc[384 + k];
        const float off = (tq > 0 ? q0 : 0.f) + (tq > 1 ? q1 : 0.f) + (tq > 2 ? q2 : 0.f);
        const float rref = q0 + q1, bl = (q0 + q1) + (q2 + q3);
        if (tq == 0) { DEC[k] = __expf(bl); lsum += bl; }
        u32x4 kh0, kh1, vv0, vv1;
        {
            float khat[16];
            const float ebr = __expf(bl - rref);
#pragma unroll
            for (int ii = 0; ii < 16; ++ii) { const int i = tq * 16 + ii; const float bt = off + lf[ii];
                if (mode == 1) { const float qh = bf2f(nq[ii]);
                    const float eq = __expf(fminf(fmaxf(bt - rref, -80.f), 80.f)), ek = __builtin_amdgcn_rcpf(eq);
                    const float kt = kk[ii] * ek; khat[ii] = kt * ebr;
                    Qt[i * KP + k] = (bf16_t)(pk2(qh * eq, 0.f) & 0xffffu); Kt[i * KP + k] = (bf16_t)(pk2(kt, 0.f) & 0xffffu); }
                else khat[ii] = kk[ii] * __expf(bl - bt); }
            kh0.x = pk2(khat[0], khat[1]); kh0.y = pk2(khat[2], khat[3]); kh0.z = pk2(khat[4], khat[5]); kh0.w = pk2(khat[6], khat[7]);
            kh1.x = pk2(khat[8], khat[9]); kh1.y = pk2(khat[10], khat[11]); kh1.z = pk2(khat[12], khat[13]); kh1.w = pk2(khat[14], khat[15]);
            vv0.x = nv[0] | ((unsigned)nv[1] << 16); vv0.y = nv[2] | ((unsigned)nv[3] << 16); vv0.z = nv[4] | ((unsigned)nv[5] << 16); vv0.w = nv[6] | ((unsigned)nv[7] << 16);
            vv1.x = nv[8] | ((unsigned)nv[9] << 16); vv1.y = nv[10] | ((unsigned)nv[11] << 16); vv1.z = nv[12] | ((unsigned)nv[13] << 16); vv1.w = nv[14] | ((unsigned)nv[15] << 16);
        }
        *(LAS u32x4*)(KhT + k * 72 + tq * 16) = kh0; *(LAS u32x4*)(KhT + k * 72 + tq * 16 + 8) = kh1;
        *(LAS u32x4*)(VT + k * 72 + tq * 16) = vv0; *(LAS u32x4*)(VT + k * 72 + tq * 16 + 8) = vv1;
        if (mode == 1) {
            const f32x4 ra = *(const LAS f32x4*)(QSc + 16 * w + lq * 4), rb = *(const LAS f32x4*)(QSc + 128 + 16 * w + lq * 4);
            f32x4 er; er.x = __expf(ra.x + rb.x); er.y = __expf(ra.y + rb.y); er.z = __expf(ra.z + rb.z); er.w = __expf(ra.w + rb.w);
#pragma unroll
            for (int vt = 0; vt < 8; ++vt) { const f32x4 sx = Sacc[vt] * er; u32x2 sv; sv.x = pk2(sx[0], sx[1]); sv.y = pk2(sx[2], sx[3]); *(LAS u32x2*)(ST + (16 * vt + lr) * KP + 16 * w + lq * 4) = sv; }
        }
        __syncthreads();
        if (cc < 15) { HG_STAGE1((cc + 1) & 1); HG_LOAD_QV(cc + 1); if (cc < 14) HG_LOAD_F(cc + 2); }
        if (mode == 1) {
#pragma unroll
            for (int e = 0; e < 2; ++e) { const int ti = 2 * w + e, st = ti >> 2, tt = ti & 3;
                f32x4 a = (f32x4){0.f, 0.f, 0.f, 0.f};
                if (st <= tt) {
#pragma unroll
                    for (int ks = 0; ks < 4; ++ks) a = mfma16(*(const LAS bf16x8*)(Kt + (16 * st + lr) * KP + ks * 32 + lq * 8), *(const LAS bf16x8*)(Qt + (16 * tt + lr) * KP + ks * 32 + lq * 8), a);
                }
                const int t = 16 * tt + lr, s0 = 16 * st + lq * 4;
                float x0 = (t >= s0 && st <= tt) ? a[0] : 0.f, x1 = (t >= s0 + 1 && st <= tt) ? a[1] : 0.f, x2 = (t >= s0 + 2 && st <= tt) ? a[2] : 0.f, x3 = (t >= s0 + 3 && st <= tt) ? a[3] : 0.f;
                u32x2 sv; sv.x = pk2(x0, x1); sv.y = pk2(x2, x3); *(LAS u32x2*)(Sc + t * 72 + s0) = sv; }
            __syncthreads();
            const int tt = w & 3, vh = w >> 2;
            bf16x8 scf[2], qhf[4];
#pragma unroll
            for (int ks = 0; ks < 2; ++ks) scf[ks] = *(const LAS bf16x8*)(Sc + (16 * tt + lr) * 72 + ks * 32 + lq * 8);
#pragma unroll
            for (int ks = 0; ks < 4; ++ks) qhf[ks] = *(const LAS bf16x8*)(Qt + (16 * tt + lr) * KP + ks * 32 + lq * 8);
            const int il = 16 * tt + lr; const long tok = btok + (dir ? 63 - il : il);
#pragma unroll
            for (int vi = 0; vi < 4; ++vi) { const int vt = vh * 4 + vi; f32x4 a = (f32x4){0.f, 0.f, 0.f, 0.f};
#pragma unroll
                for (int ks = 0; ks < 2; ++ks) a = mfma16(*(const LAS bf16x8*)(VT + (16 * vt + lr) * 72 + ks * 32 + lq * 8), scf[ks], a);
#pragma unroll
                for (int ks = 0; ks < 4; ++ks) a = mfma16(*(const LAS bf16x8*)(ST + (16 * vt + lr) * KP + ks * 32 + lq * 8), qhf[ks], a);
                bf16_t* of = P + (size_t)tok * PC + PC_FF + h * 128 + 16 * vt + lq * 4;
                if (dir == 0) { u32x2 sv; sv.x = pk2(a[0], a[1]); sv.y = pk2(a[2], a[3]); *(u32x2*)of = sv; }
                else { const u32x2 pv = *(const u32x2*)of;
                    a[0] += __builtin_bit_cast(float, pv.x << 16); a[1] += __builtin_bit_cast(float, pv.x & 0xffff0000u); a[2] += __builtin_bit_cast(float, pv.y << 16); a[3] += __builtin_bit_cast(float, pv.y & 0xffff0000u);
                    u32x2 sv; sv.x = pk2(a[0], a[1]); sv.y = pk2(a[2], a[3]); *(u32x2*)(P + (size_t)tok * PC + PC_FB + h * 128 + 16 * vt + lq * 4) = sv; } }
        }
        { const f32x4 dv = *(const LAS f32x4*)(DEC + 16 * w + lq * 4);
          bf16x8 af[2];
#pragma unroll
          for (int ks = 0; ks < 2; ++ks) af[ks] = *(const LAS bf16x8*)(KhT + (16 * w + lr) * 72 + ks * 32 + lq * 8);
#pragma unroll
          for (int vt = 0; vt < 8; ++vt) { f32x4 a = Sacc[vt] * dv;
#pragma unroll
              for (int ks = 0; ks < 2; ++ks) a = mfma16(af[ks], *(const LAS bf16x8*)(VT + (16 * vt + lr) * 72 + ks * 32 + lq * 8), a);
              Sacc[vt] = a; } }
        __syncthreads();
    }
#undef HG_STAGE1
#undef HG_LOAD_F
#undef HG_LOAD_QV
#undef HG_ROW0
    if (mode == 0) { const int su = chain + seg; float* sp = SUM + (size_t)su * 16384;
#pragma unroll
        for (int vt = 0; vt < 8; ++vt) *(f32x4*)(sp + ((w * 8 + vt) * 64 + lane) * 4) = Sacc[vt];
        if (tq == 0) LSUM[su * 128 + k] = lsum; }
}
__device__ __forceinline__ void hgrn_full_unit(int u, bf16_t* P, const float* lb, const float* hnorm, float* SUM, float* LSUM, bf16_t* Yc, LAS unsigned char* lds, int tid) {
    const int b = u >> 7, h = (u >> 4) & 7, seg = u & 15;
    hgrn_unit(b, h, seg, 0, 1, P, lb, SUM, LSUM, lds, tid);
    __threadfence(); __syncthreads();
#if defined(PROBE_HG) && PROBE_HG == 1
    return;
#endif
    hgrn_unit(b, h, seg, 1, 1, P, lb, SUM, LSUM, lds, tid);
    __threadfence(); __syncthreads();
#if defined(PROBE_HG) && PROBE_HG == 2
    return;
#endif
    const int w = tid >> 6, lane = tid & 63;
    const float g0 = hnorm[h * 128 + 2 * lane], g1 = hnorm[h * 128 + 2 * lane + 1];
    for (int r0 = w * 128; r0 < w * 128 + 128; r0 += 16) {
        unsigned pv[16];
#pragma unroll
        for (int i = 0; i < 16; ++i) pv[i] = *(const unsigned*)(P + (size_t)((long)b * S + seg * 1024 + r0 + i) * PC + PC_FB + h * 128 + 2 * lane);
#pragma unroll
        for (int i = 0; i < 16; ++i) { const long tok = (long)b * S + seg * 1024 + r0 + i;
            const float x0 = __builtin_bit_cast(float, pv[i] << 16), x1 = __builtin_bit_cast(float, pv[i] & 0xffff0000u);
            const float ss = wave_sum(x0 * x0 + x1 * x1); const float rs = 1.0f / sqrtf(ss * (1.0f / 128.f) + NORM_EPS);
            *(unsigned*)(Yc + (size_t)tok * 1024 + h * 128 + 2 * lane) = pk2(x0 * rs * g0, x1 * rs * g1); }
    }
    __syncthreads();
}

#define XB_TMO      128
#define XB_XCNT(j)  (256  + 64 * (j))
#define XB_XSUB(j)  (1280 + 64 * (j))
#define XB_XGEN(j)  (2304 + 64 * (j))
#define XB_TOP      3328
#define XB_TOPGEN   3392
#define XCD_BAR_WORDS 3456
#define XB_SPIN_CAP (1u << 18)

__device__ __forceinline__ unsigned xb_ld(unsigned* p)              { return __hip_atomic_load(p, __ATOMIC_RELAXED, __HIP_MEMORY_SCOPE_AGENT); }
__device__ __forceinline__ unsigned xb_add(unsigned* p, unsigned v) { return __hip_atomic_fetch_add(p, v, __ATOMIC_RELAXED, __HIP_MEMORY_SCOPE_AGENT); }
__device__ __forceinline__ unsigned xb_xcc_id() { return (unsigned)__builtin_amdgcn_s_getreg((3 << 11) | 20) & 0xFu; }
#define XB_SPIN(cond, bar) do { unsigned _sp = 0; while (cond) { __builtin_amdgcn_s_sleep(1); \
    if ((++_sp & 255u) == 0u) { if (xb_ld(&(bar)[XB_TMO])) break; if (_sp > XB_SPIN_CAP) { atomicAdd(&(bar)[XB_TMO], 1u); break; } } } } while (0)

struct XcdBarrier {
    unsigned* bar; unsigned x;
    volatile LAS unsigned* st;
};

__device__ __forceinline__ XcdBarrier xcd_barrier_post(unsigned* bar, volatile LAS unsigned* st) {
    XcdBarrier b; b.bar = bar; b.x = xb_xcc_id(); b.st = st;
    if (threadIdx.x == 0) (void)xb_add(&bar[XB_XCNT(b.x)], 1u);
    return b;
}
__device__ __forceinline__ void xcd_barrier_complete(unsigned* bar, unsigned x, unsigned& nloc, unsigned& nx) {
    const unsigned G = gridDim.x * gridDim.y * gridDim.z;
    unsigned sum, cnt, mine, sp = 0u;
    for (;;) {
        sum = 0u; cnt = 0u; mine = 0u;
#pragma unroll
        for (unsigned j = 0; j < 16; ++j) { const unsigned c = xb_ld(&bar[XB_XCNT(j)]); sum += c; cnt += (c > 0u) ? 1u : 0u; mine = (j == x) ? c : mine; }
        if (sum == G) break;
        __builtin_amdgcn_s_sleep(1);
        if ((++sp & 255u) == 0u) { if (xb_ld(&bar[XB_TMO])) break; if (sp > XB_SPIN_CAP) { atomicAdd(&bar[XB_TMO], 1u); break; } }
    }
    nloc = mine > 0u ? mine : 1u; nx = cnt > 0u ? cnt : 1u;
}

__device__ __forceinline__ void xcd_barrier(const XcdBarrier& b) {
    asm volatile("s_waitcnt vmcnt(0)" ::: "memory");
    __syncthreads();
    if (threadIdx.x == 0) {
        unsigned* bar = b.bar;
        __builtin_amdgcn_s_waitcnt(0);
        unsigned nloc = b.st[0], nx = b.st[1];
        if (nloc == 0u) { xcd_barrier_complete(bar, b.x, nloc, nx); b.st[0] = nloc; b.st[1] = nx; }
        const unsigned old = xb_add(&bar[XB_XSUB(b.x)], 1u);
        const unsigned gen = old / nloc;
        if (old + 1u == (gen + 1u) * nloc) {
            __builtin_amdgcn_fence(__ATOMIC_RELEASE, "agent");
            asm volatile("s_waitcnt vmcnt(0)" ::: "memory");
            const unsigned og = xb_add(&bar[XB_TOP], 1u);
            const unsigned tg = og / nx;
            if (og + 1u == (tg + 1u) * nx) xb_add(&bar[XB_TOPGEN], 1u);
            else XB_SPIN(xb_ld(&bar[XB_TOPGEN]) == tg, bar);
            __builtin_amdgcn_fence(__ATOMIC_ACQUIRE, "agent");
            xb_add(&bar[XB_XGEN(b.x)], 1u);
            asm volatile("s_waitcnt vmcnt(0)" ::: "memory");
        } else {
            XB_SPIN(xb_ld(&bar[XB_XGEN(b.x)]) == gen, bar);
            __builtin_amdgcn_fence(__ATOMIC_ACQUIRE, "agent");
            asm volatile("s_waitcnt vmcnt(0)" ::: "memory");
        }
    }
    __syncthreads();
}


struct Args { const float* in[11]; float* out; unsigned char* ws; int ph_lo, ph_hi; };
#define DERIVE_PTRS \
    int tid = threadIdx.x; asm volatile("" : "+v"(tid)); const int lane = tid & 63, wave = __builtin_amdgcn_readfirstlane(tid >> 6); \
    int G = gridDim.x, bx = blockIdx.x; asm volatile("" : "+s"(G), "+s"(bx)); \
    const int gw = bx * 8 + wave, NGW = G * 8; \
    unsigned char* ws = args.ws; asm volatile("" : "+s"(ws)); \
    const float* x0 = args.in[0]; const float* pre_norm = args.in[1]; const float* post_norm = args.in[2]; const float* sink_logits = args.in[4]; \
    const float* hlb = args.in[5]; const float* hnorm = args.in[6]; float* outp = args.out; \
    asm volatile("" : "+s"(x0), "+s"(pre_norm), "+s"(post_norm), "+s"(sink_logits), "+s"(hlb), "+s"(hnorm), "+s"(outp)); \
    float2* rope = (float2*)(ws + WS_ROPE); float* lse = (float*)(ws + WS_LSE); float* LB = (float*)(ws + WS_LB); float* LSUM = (float*)(ws + WS_LSUM); \
    bf16_t* WinT = (bf16_t*)(ws + WS_WIN); bf16_t* WaT = (bf16_t*)(ws + WS_WA); bf16_t* WbT = (bf16_t*)(ws + WS_WB); bf16_t* WcT = (bf16_t*)(ws + WS_WC); bf16_t* WoT = (bf16_t*)(ws + WS_WO); \
    bf16_t* XN = (bf16_t*)(ws + WS_XN); bf16_t* Ya = (bf16_t*)(ws + WS_YA); bf16_t* Yb = (bf16_t*)(ws + WS_YB); bf16_t* Yc = (bf16_t*)(ws + WS_YC); \
    float* SUM = (float*)(ws + WS_SUM); bf16_t* P = (bf16_t*)(ws + WS_P); bf16_t* Gm = (bf16_t*)(ws + WS_G); bf16_t* YM = (bf16_t*)(ws + WS_YM); float* OUT = (float*)(ws + WS_OUT); \
    (void)tid; (void)lane; (void)gw; (void)NGW; (void)x0; (void)pre_norm; (void)post_norm; (void)sink_logits; (void)hlb; (void)hnorm; (void)outp; (void)rope; (void)lse; (void)LB; (void)LSUM; \
    (void)WinT; (void)WaT; (void)WbT; (void)WcT; (void)WoT; (void)XN; (void)Ya; (void)Yb; (void)Yc; (void)SUM; (void)P; (void)Gm; (void)YM; (void)OUT;
#ifndef REPEAT_MASK
#define REPEAT_MASK 0
#endif
#define NREP(j) (1 + ((REPEAT_MASK >> (j)) & 1))
#define IN(k) (args.ph_lo <= (k) && (k) < args.ph_hi)
#define XB_ST_OFF (LDS_BYTES - 64)
#ifdef PROBE_TS
#define STAMP(k) do { if (blockIdx.x == 0 && threadIdx.x == 0) ((unsigned long long*)(args.ws + 65536))[k] = __builtin_amdgcn_s_memrealtime(); } while (0)
#else
#define STAMP(k) do { } while (0)
#endif
#define GRID_SYNC(k) do { if (IN(k) && IN((k) + 1)) { if ((k) == 0) cg::this_grid().sync(); else { XcdBarrier xb_; xb_.bar = (unsigned*)args.ws; xb_.x = xb_xcc_id(); xb_.st = (volatile LAS unsigned*)(lds + XB_ST_OFF); xcd_barrier(xb_); } } STAMP((k) + 1); } while (0)
template <int layer> __device__ __forceinline__ void run_layer(const Args& args, LAS unsigned char* lds) {
#ifndef SKIP_P1
        for (int rep = 0; rep < NREP(0); ++rep) if (IN(1 + 8 * layer + 0)) { DERIVE_PTRS pg8::Gemm g{XN, WinT, T, PC, D}; pg8::StaticOrder So; So.init(T, PC, G, bx); EpiStoreRope E{P, PC};
          pg8::gemm_phase<EpiStoreRope, pg8::StaticOrder, true, true>(lds, g, So, E); }
#endif
        GRID_SYNC(1 + 8 * layer + 0);
#ifndef SKIP_P2
        if (IN(1 + 8 * layer + 1)) { DERIVE_PTRS const float* lbL = LB + layer * 1024;
          for (int rep = 0; rep < NREP(8); ++rep) for (int u = bx; u < 512; u += G) { const int dir = u & 1, seg = (u >> 1) & 15, h = (u >> 5) & 7, b = u >> 8; hgrn_unit(b, h, seg, dir, 0, P, lbL, SUM, LSUM, lds, tid); }
          __syncthreads();
          const int vb = (G % 8 == 0) ? (bx % 8) * (G / 8) + bx / 8 : bx;
          attnA_phase(P, lse, lds, tid, vb, G);
          for (int rep = 0; rep < NREP(9); ++rep) attnB_phase(P, Yb, sink_logits + layer * 8, lds, tid, vb, G); }
#endif
        GRID_SYNC(1 + 8 * layer + 1);
#ifndef SKIP_P3
        if (IN(1 + 8 * layer + 2)) { DERIVE_PTRS const int vb3 = (G % 8 == 0) ? (bx % 8) * (G / 8) + bx / 8 : bx;
            for (int u = vb3; u < 256; u += G) hgrn_full_unit(u, P, LB + layer * 1024, hnorm + layer * 1024, SUM, LSUM, Yc, lds, tid); }
#endif
        GRID_SYNC(1 + 8 * layer + 2);
#ifndef SKIP_P4
        if (IN(1 + 8 * layer + 3)) { DERIVE_PTRS pg8::Gemm g{XN, WinT + (size_t)PC * D, T, NGATE, D}; pg8::StaticOrder So; So.init(T, NGATE, G, bx); EpiGate E{Ya, Yb, Yc, P, lse};
          pg8::gemm_phase<EpiGate, pg8::StaticOrder, true, true>(lds, g, So, E); }
#endif
#if defined(MULTI_LAUNCH) || defined(PROBE_PHASES)
        GRID_SYNC(1 + 8 * layer + 3);
#endif
#ifndef SKIP_P5
        for (int rep = 0; rep < NREP(4); ++rep) if (IN(1 + 8 * layer + 4)) { DERIVE_PTRS pg8::Gemm g{(const bf16_t*)(ws + WS_XN8), (const bf16_t*)(ws + WS_WM8), T, NMERGE, D}; pg8::StaticOrder So; So.init(T, NMERGE, G, bx); EpiSigmoidI8 E{(unsigned char*)Gm, G_PITCH, 1.0f / (Q_SX * Q_SW)};
          pg8::gemm_phase<EpiSigmoidI8, pg8::StaticOrder, true, true, 1>(lds, g, So, E); }
#endif
        GRID_SYNC(1 + 8 * layer + 4);
#ifndef SKIP_P6
        for (int rep = 0; rep < NREP(5); ++rep) if (IN(1 + 8 * layer + 5)) { DERIVE_PTRS pg8::StaticOrder So; So.init(T, D, G, bx);
          { pg8::Gemm g{Ya, WaT, T, D, 512}; EpiBranch<true> E{YM, (const unsigned char*)Gm, 0}; pg8::gemm_phase<EpiBranch<true>, pg8::StaticOrder, true, true>(lds, g, So, E); }
          { pg8::Gemm g{Yb, WbT, T, D, 1024}; EpiBranch<false> E{YM, (const unsigned char*)Gm, 1}; pg8::gemm_phase<EpiBranch<false>, pg8::StaticOrder, true, true>(lds, g, So, E); }
          { pg8::Gemm g{Yc, WcT, T, D, 1024}; EpiBranch<false> E{YM, (const unsigned char*)Gm, 2}; pg8::gemm_phase<EpiBranch<false>, pg8::StaticOrder, true, true>(lds, g, So, E); } }
#endif
        GRID_SYNC(1 + 8 * layer + 5);
#ifndef SKIP_P7
        for (int rep = 0; rep < NREP(6); ++rep) if (IN(1 + 8 * layer + 6)) { DERIVE_PTRS pg8::Gemm g{YM, WoT, T, D, D}; pg8::StaticOrder So; So.init(T, D, G, bx); EpiStoreBf16 E{(bf16_t*)OUT, D};
          pg8::gemm_phase<EpiStoreBf16, pg8::StaticOrder, true, true>(lds, g, So, E); }
#endif
        GRID_SYNC(1 + 8 * layer + 6);
        for (int rep8 = 0; rep8 < (layer == 0 ? NREP(11) : 1); ++rep8) if (IN(1 + 8 * layer + 7)) { DERIVE_PTRS const float* xold = layer == 0 ? x0 : outp;
          for (int m = gw; m < T; m += 2 * NGW) { const int m2 = (m + NGW < T) ? m + NGW : m;
              const bf16_t* const orow[2] = {(const bf16_t*)OUT + (size_t)m * D, (const bf16_t*)OUT + (size_t)m2 * D};
              const float* const xo[2] = {xold + (size_t)m * D, xold + (size_t)m2 * D}; float* const xn[2] = {outp + (size_t)m * D, outp + (size_t)m2 * D};
              bf16_t* const xq[2] = {XN + (size_t)m * D, XN + (size_t)m2 * D}; unsigned* const xq8[2] = {(unsigned*)(ws + WS_XN8) + (size_t)m * (D / 4), (unsigned*)(ws + WS_XN8) + (size_t)m2 * (D / 4)};
              final_rows<2>(orow, post_norm + layer * D, xo, xn, layer == 0 ? pre_norm + D : nullptr, xq, xq8, lane); }
          if (layer == 0) { Weights Wt{args.in[3] + (size_t)D * NIN, args.in[7] + (size_t)512 * D, args.in[8] + (size_t)1024 * D, args.in[9] + (size_t)1024 * D, args.in[10] + (size_t)D * D};
              __syncthreads(); transpose_weights(Wt, ws, lds, gw, NGW, wave, lane); GRID_SYNC(1 + 8 * layer + 7); } }
}
__global__ void __launch_bounds__(NTHREADS, 2) fwd_megakernel(Args args) {
    extern __shared__ __attribute__((aligned(16))) unsigned char lds_raw[];
    LAS unsigned char* lds = (LAS unsigned char*)lds_raw;
    if (threadIdx.x < 16) ((LAS unsigned*)(lds + XB_ST_OFF))[threadIdx.x] = 0u;
    __syncthreads();
    if (args.ph_hi - args.ph_lo > 1 && blockIdx.x == 0) { for (int i = threadIdx.x; i < XCD_BAR_WORDS; i += NTHREADS) ((unsigned*)args.ws)[i] = 0u; }
    STAMP(0);
    for (int rep0 = 0; rep0 < NREP(10); ++rep0) if (IN(0)) { DERIVE_PTRS
    for (int i = bx * NTHREADS + tid; i < 1024; i += G * NTHREADS) { const float h0 = hlb[i], h1 = hlb[1024 + i]; const float mx = fmaxf(h0, h1);
        const float e0 = expf(h0 - mx), e1 = expf(h1 - mx); LB[i] = 0.f; LB[1024 + i] = e1 / (e0 + e1); }
    { Weights Wt{args.in[3], args.in[7], args.in[8], args.in[9], args.in[10]}; transpose_weights(Wt, ws, lds, gw, NGW, wave, lane); }
    for (int m = gw; m < T; m += NGW) prenorm_row(x0 + (size_t)m * D, pre_norm, XN + (size_t)m * D, (unsigned*)(ws + WS_XN8) + (size_t)m * (D / 4), lane);
    }
    GRID_SYNC(0);
    if (args.ph_hi - args.ph_lo > 1) (void)xcd_barrier_post((unsigned*)args.ws, (volatile LAS unsigned*)(lds + XB_ST_OFF));

    run_layer<0>(args, lds);
#if NLAYER > 1
    run_layer<1>(args, lds);
#endif
#ifdef PROBE_TS
    STAMP(17);
    if (blockIdx.x == 0 && threadIdx.x == 0) { const unsigned long long* ts = (const unsigned long long*)(args.ws + 65536); const float dus_ = 0.01f * (float)(ts[PROBE_TS + 1] - ts[PROBE_TS]); args.out[0] = 1000.0f * floorf(dus_ / (float)PROBE_BUCKET) + 1000.0f; }
#endif
}

__global__ void dump_bf16(const bf16_t* src, size_t pitch, float* out) {
    const size_t i = (size_t)blockIdx.x * blockDim.x + threadIdx.x; const size_t r = i / 2048, c = i % 2048;
    out[i] = bf2f(src[r * pitch + c]);
}
__global__ void dump_f32(const float* src, float* out) { const size_t i = (size_t)blockIdx.x * blockDim.x + threadIdx.x; out[i] = src[i]; }
__global__ void dump_mix(const unsigned char* ws, float* out) {
    const size_t i = (size_t)blockIdx.x * blockDim.x + threadIdx.x; const size_t r = i / 2048, c = i % 2048;
    const bf16_t* P = (const bf16_t*)(ws + WS_P); const bf16_t* Yb = (const bf16_t*)(ws + WS_YB); const bf16_t* Yc = (const bf16_t*)(ws + WS_YC); const float* SUM = (const float*)(ws + WS_SUM); const float* lse = (const float*)(ws + WS_LSE);
    float v = 0.f;
#if PROBE_SEL & 1
    v += bf2f(P[r * PC + c]);
#endif
#if PROBE_SEL & 2
    v += bf2f(Yb[r * 1024 + (c & 1023)]);
#endif
#if PROBE_SEL & 4
    v += SUM[i % ((size_t)512 * 16384)];
#endif
#if PROBE_SEL & 8
    v += lse[i % ((size_t)3 * T * 4)];
#endif
#if PROBE_SEL & 16
    v += bf2f(Yc[r * 1024 + (c & 1023)]);
#endif
#if PROBE_SEL & 32
    v += bf2f(P[r * PC + PC_FF + (c & 1023)]);
#endif
#if PROBE_SEL & 64
    v += bf2f(P[r * PC + PC_FB + (c & 1023)]);
#endif
    if (!(v == v) || fabsf(v) > 1e30f) v = 12345.f;
    out[i] = v;
}
extern "C" void kernel_launch(void* const* d_in, const int* in_sizes, int n_in, void* d_out, int out_size, void* d_ws, size_t ws_size, hipStream_t stream) {
    static int grid = 0;
    if (grid == 0) {
        if (n_in != 11 || ws_size < WS_END8) { fprintf(stderr, "kernel_launch: unexpected inputs (n_in %d, ws %zu)\n", n_in, ws_size); grid = -1; return; }
        int dev = 0, cus = 0, per_cu = 0;
        hipGetDevice(&dev); hipDeviceGetAttribute(&cus, hipDeviceAttributeMultiprocessorCount, dev);
        hipFuncSetAttribute((const void*)fwd_megakernel, hipFuncAttributeMaxDynamicSharedMemorySize, LDS_BYTES);
        hipOccupancyMaxActiveBlocksPerMultiprocessor(&per_cu, (const void*)fwd_megakernel, NTHREADS, LDS_BYTES);
        if (per_cu < 1) per_cu = 1;
        grid = cus * per_cu;
    }
    if (grid < 0) return;
    Args a{};
    for (int i = 0; i < 11; ++i) a.in[i] = (const float*)d_in[i];
    a.out = (float*)d_out; a.ws = (unsigned char*)d_ws;
#ifdef PROBE_PHASES
    for (int ph = 0; ph < PROBE_PHASES; ++ph) { a.ph_lo = ph; a.ph_hi = ph + 1; hipLaunchKernelGGL(fwd_megakernel, dim3(grid), dim3(NTHREADS), LDS_BYTES, stream, a); }
    PROBE_DUMP
#elif defined(MULTI_LAUNCH)
    for (int ph = 0; ph < 17; ++ph) { a.ph_lo = ph; a.ph_hi = ph + 1; hipLaunchKernelGGL(fwd_megakernel, dim3(grid), dim3(NTHREADS), LDS_BYTES, stream, a); }
#else
    static bool per_phase = false;
    if (!per_phase) {
        a.ph_lo = 0; a.ph_hi = 17;
        void* kargs[] = {&a};
        hipError_t e = hipLaunchCooperativeKernel((const void*)fwd_megakernel, dim3(grid), dim3(NTHREADS), kargs, LDS_BYTES, stream);
        if (e != hipSuccess) { fprintf(stderr, "cooperative launch failed: %s (grid %d); falling back to one launch per phase\n", hipGetErrorString(e), grid); (void)hipGetLastError(); per_phase = true; }
    }
    if (per_phase) for (int ph = 0; ph < 17; ++ph) { a.ph_lo = ph; a.ph_hi = ph + 1; hipLaunchKernelGGL(fwd_megakernel, dim3(grid), dim3(NTHREADS), LDS_BYTES, stream, a); }
#endif
}
```

```cpp
#include <hip/hip_runtime.h>
#include <hip/hip_cooperative_groups.h>
#include <cstdio>
#include <cstdint>
namespace cg = cooperative_groups;
namespace pg8 {
#define PG8_LAS __attribute__((address_space(3)))
typedef unsigned short bf16_t;
typedef short bf16x8 __attribute__((ext_vector_type(8)));
typedef float f32x4 __attribute__((ext_vector_type(4)));
typedef unsigned u32x4 __attribute__((ext_vector_type(4)));
constexpr int BM = 256, BK = 64, HALF = 128, HTB = HALF * BK * 2  , STAGE_BYTES = 8 * HTB, NXCD = 8, WGM = 8;

__host__ __device__ __forceinline__ int lds_byte(int r, int c) { const int st = (r >> 4) * 2 + (c >> 5), rr = r & 15, cc = c & 31, ob = rr * 64 + cc * 2; return st * 1024 + (ob ^ (((ob >> 9) & 1) << 5)); }
__host__ __device__ __forceinline__ void stage_rc(int b, int& R, int& C) { const int st = b / 1024, sb = b % 1024, swz = sb ^ (((sb >> 9) & 1) << 5); R = (st >> 1) * 16 + swz / 64; C = (st & 1) * 32 + (swz % 64) / 2; }
__host__ __device__ __forceinline__ int perm32(int rho) { const int n = rho >> 4, i = rho & 15; return 8 * (i >> 2) + 4 * n + (i & 3); }

struct Unit { int pm, pn; };
struct Gemm { const bf16_t* A; const bf16_t* Bt; int M, N, K; };

struct StaticOrder {
    int nM, nN, nwg, G, c;
    __host__ __device__ void init(int M, int N, int G_, int c_) { nM = M / BM; nN = N / BM; nwg = nM * nN; G = G_; c = c_; }
    __host__ __device__ bool next(int i, Unit& u) const {
        const long L = (long)i * G + c; if (L >= nwg) return false;
        int wgid = (int)L; { const int q = nwg / NXCD, r = nwg % NXCD, xcd = wgid % NXCD, off = wgid / NXCD; wgid = (xcd < r ? xcd * (q + 1) : r * (q + 1) + (xcd - r) * q) + off; }
        const int nig = WGM * nN, gid = wgid / nig, fm = gid * WGM, gsz = (nM - fm) < WGM ? (nM - fm) : WGM;
        u.pm = fm + ((wgid % nig) % gsz); u.pn = (wgid % nig) / gsz; return true;
    }
    __device__ __forceinline__ void a_ready(const Unit&) const {}
    __device__ __forceinline__ void done(const Unit&) const {}
};

__device__ __forceinline__ unsigned cvt_pk_bf16(float lo, float hi) { unsigned r; asm volatile("v_cvt_pk_bf16_f32 %0, %1, %2" : "=v"(r) : "v"(lo), "v"(hi)); return r; }
typedef int i32x4 __attribute__((ext_vector_type(4)));
template <int ES> __device__ __forceinline__ f32x4 pg8_mma(bf16x8 a, bf16x8 b, f32x4 c) {
    if constexpr (ES == 2) return __builtin_amdgcn_mfma_f32_16x16x32_bf16(a, b, c, 0, 0, 0);
    else return __builtin_bit_cast(f32x4, __builtin_amdgcn_mfma_i32_16x16x64_i8(__builtin_bit_cast(i32x4, a), __builtin_bit_cast(i32x4, b), __builtin_bit_cast(i32x4, c), 0, 0, 0));
}
template <class Epi, class Sched, bool ALIGN_EPI = false, bool SP2 = false, int ES = 2>
__device__ __forceinline__ void gemm_phase(PG8_LAS unsigned char* lds, const Gemm g, const Sched& S, const Epi& E) {
    int tid = threadIdx.x; asm volatile("" : "+v"(tid));
    const int wid = __builtin_amdgcn_readfirstlane(tid >> 6), lane = tid & 63, wr = wid >> 2, wc = wid & 3, fr = lane & 15, fq = lane >> 4;
    const int K = g.K, nt = (K * ES) / (BK * 2);
    unsigned voffA[2], voffB[2];
#pragma unroll
    for (int i = 0; i < 2; ++i) { int R, C; stage_rc(tid * 16 + i * 8192, R, C); const int Rb = Epi::PERM ? ((R & ~31) + perm32(R & 31)) : R;
        voffA[i] = (unsigned)(R * K * ES + C * 2); voffB[i] = (unsigned)(Rb * K * ES + C * 2); }
    const size_t kstep = (size_t)(BK * 2);
    const size_t hstep = (size_t)HALF * K * ES;
    const size_t tstep = 2 * hstep;
    const unsigned ldsw = (unsigned)wid * 1024u;
    const int aoff = lds_byte(wr * 64 + fr, fq * 8), boff = lds_byte(wc * 32 + fr, fq * 8);
#define PG8_SA(b, h) (((b) * 2 + (h)) * HTB)
#define PG8_SB(b, h) ((4 + (b) * 2 + (h)) * HTB)
#define PG8_STAGE(bufoff, gbase, voff) do { _Pragma("unroll") for (int _i = 0; _i < 2; ++_i) \
        __builtin_amdgcn_global_load_lds((const unsigned*)((const char*)(gbase) + (voff)[_i]), (PG8_LAS unsigned*)(lds + (bufoff) + ldsw + _i * 8192), 16, 0, 0); } while (0)
#define PG8_LDA(dst, b, h) do { _Pragma("unroll") for (int m = 0; m < 4; ++m) _Pragma("unroll") for (int k = 0; k < 2; ++k) dst[m][k] = *(const PG8_LAS bf16x8*)(lds + PG8_SA(b, h) + aoff + m * 2048 + k * 1024); } while (0)
#define PG8_LDB(dst, b, h) do { _Pragma("unroll") for (int n = 0; n < 2; ++n) _Pragma("unroll") for (int k = 0; k < 2; ++k) dst[n][k] = *(const PG8_LAS bf16x8*)(lds + PG8_SB(b, h) + boff + n * 2048 + k * 1024); } while (0)
#define PG8_MMA(ai, bj, At, Bt) do { __builtin_amdgcn_s_setprio(1); _Pragma("unroll") for (int m = 0; m < 4; ++m) _Pragma("unroll") for (int n = 0; n < 2; ++n) _Pragma("unroll") for (int k = 0; k < 2; ++k) \
        acc[ai][bj][m][n] = pg8_mma<ES>(Bt[n][k], At[m][k], acc[ai][bj][m][n]); __builtin_amdgcn_s_setprio(0); } while (0)
#define PG8_WAIT_V(n) asm volatile("s_waitcnt vmcnt(" #n ")" ::: "memory")
#define PG8_WAIT_L(n) asm volatile("s_waitcnt lgkmcnt(" #n ")" ::: "memory")
#define PG8_BAR __builtin_amdgcn_s_barrier()
#define PG8_SCHED __builtin_amdgcn_sched_barrier(0)
    Unit cur, nxt; int ui = 0;
    if (!S.next(0, cur)) return;
    f32x4 acc[2][2][4][2];
#pragma unroll
    for (int a = 0; a < 2; ++a)
#pragma unroll
        for (int b = 0; b < 2; ++b)
#pragma unroll
            for (int m = 0; m < 4; ++m)
#pragma unroll
                for (int n = 0; n < 2; ++n) acc[a][b][m][n] = (f32x4){0.f, 0.f, 0.f, 0.f};
    bf16x8 At[4][2], B0[2][2], B1[2][2];
    const char* cA = (const char*)g.A + (size_t)cur.pm * tstep; const char* cB = (const char*)g.Bt + (size_t)cur.pn * tstep;
    S.a_ready(cur);
    if constexpr (SP2) {
        PG8_STAGE(PG8_SB(0, 0), cB, voffB); PG8_STAGE(PG8_SB(0, 1), cB + hstep, voffB); PG8_STAGE(PG8_SA(0, 0), cA, voffA); PG8_STAGE(PG8_SA(0, 1), cA + hstep, voffA);
        if (wr == 1) PG8_BAR;
        PG8_WAIT_V(2); PG8_BAR;
        PG8_STAGE(PG8_SB(1, 0), cB + kstep, voffB); PG8_STAGE(PG8_SA(1, 0), cA + kstep, voffA); PG8_STAGE(PG8_SB(1, 1), cB + hstep + kstep, voffB);
        PG8_WAIT_V(6); PG8_BAR;
    } else {
        PG8_STAGE(PG8_SB(0, 0), cB, voffB); PG8_STAGE(PG8_SA(0, 0), cA, voffA); PG8_STAGE(PG8_SB(0, 1), cB + hstep, voffB); PG8_STAGE(PG8_SA(0, 1), cA + hstep, voffA);
        if (wr == 1) PG8_BAR;
        PG8_WAIT_V(4); PG8_BAR;
        PG8_STAGE(PG8_SB(1, 0), cB + kstep, voffB); PG8_STAGE(PG8_SA(1, 0), cA + kstep, voffA); PG8_STAGE(PG8_SB(1, 1), cB + hstep + kstep, voffB);
        PG8_WAIT_V(6); PG8_BAR;
    }
    for (;;) {
        const bool has_next = S.next(ui + 1, nxt);
        const char* nA = has_next ? (const char*)g.A + (size_t)nxt.pm * tstep : cA; const char* nB = has_next ? (const char*)g.Bt + (size_t)nxt.pn * tstep : cB;
        for (int t = 0; t < nt; t += 2) {
            const bool last = (t == nt - 2);
            const char* a1 = cA + (size_t)(t + 1) * kstep;
            const char* a2 = last ? nA : cA + (size_t)(t + 2) * kstep; const char* b2 = last ? nB : cB + (size_t)(t + 2) * kstep;
            const char* a3 = a2 + kstep; const char* b3 = b2 + kstep;
            if (last && has_next) S.a_ready(nxt);
            if constexpr (SP2) {
            PG8_LDB(B0, 0, 0); PG8_LDB(B1, 0, 1); PG8_SCHED; PG8_LDA(At, 0, 0); PG8_STAGE(PG8_SA(1, 1), a1 + hstep, voffA);
            PG8_WAIT_V(8); PG8_WAIT_L(0); PG8_BAR; PG8_MMA(0, 0, At, B0); PG8_MMA(0, 1, At, B1); PG8_BAR; PG8_SCHED;
            PG8_LDA(At, 0, 1); PG8_STAGE(PG8_SB(0, 0), b2, voffB); PG8_STAGE(PG8_SB(0, 1), b2 + hstep, voffB); PG8_STAGE(PG8_SA(0, 0), a2, voffA);
            PG8_WAIT_V(8); PG8_WAIT_L(0); PG8_BAR; PG8_MMA(1, 0, At, B0); PG8_MMA(1, 1, At, B1); PG8_BAR; PG8_SCHED;
            PG8_LDB(B0, 1, 0); PG8_LDB(B1, 1, 1); PG8_SCHED; PG8_LDA(At, 1, 0); PG8_STAGE(PG8_SA(0, 1), a2 + hstep, voffA);
            PG8_WAIT_V(8); PG8_WAIT_L(0); PG8_BAR; PG8_MMA(0, 0, At, B0); PG8_MMA(0, 1, At, B1); PG8_BAR; PG8_SCHED;
            PG8_LDA(At, 1, 1); PG8_STAGE(PG8_SB(1, 0), b3, voffB); PG8_STAGE(PG8_SB(1, 1), b3 + hstep, voffB); PG8_STAGE(PG8_SA(1, 0), a3, voffA);
            PG8_WAIT_V(8); PG8_WAIT_L(0); PG8_BAR; PG8_MMA(1, 0, At, B0); PG8_MMA(1, 1, At, B1); PG8_BAR; PG8_SCHED;
            } else {
            PG8_LDB(B0, 0, 0); PG8_SCHED; PG8_LDA(At, 0, 0); PG8_STAGE(PG8_SA(1, 1), a1 + hstep, voffA);
            PG8_WAIT_L(8); PG8_BAR; PG8_WAIT_L(0); PG8_MMA(0, 0, At, B0); PG8_BAR; PG8_SCHED;
            PG8_LDB(B1, 0, 1); PG8_STAGE(PG8_SB(0, 0), b2, voffB);
            PG8_BAR; PG8_WAIT_L(0); PG8_MMA(0, 1, At, B1); PG8_BAR;
            PG8_LDA(At, 0, 1); PG8_STAGE(PG8_SA(0, 0), a2, voffA);
            PG8_BAR; PG8_WAIT_L(0); PG8_MMA(1, 0, At, B0); PG8_BAR; PG8_SCHED;
            PG8_STAGE(PG8_SB(0, 1), b2 + hstep, voffB);
            PG8_WAIT_V(6); PG8_BAR; PG8_MMA(1, 1, At, B1); PG8_BAR;
            PG8_LDB(B0, 1, 0); PG8_SCHED; PG8_LDA(At, 1, 0); PG8_STAGE(PG8_SA(0, 1), a2 + hstep, voffA);
            PG8_WAIT_L(8); PG8_BAR; PG8_WAIT_L(0); PG8_MMA(0, 0, At, B0); PG8_BAR; PG8_SCHED;
            PG8_LDB(B1, 1, 1); PG8_STAGE(PG8_SB(1, 0), b3, voffB);
            PG8_BAR; PG8_WAIT_L(0); PG8_MMA(0, 1, At, B1); PG8_BAR;
            PG8_LDA(At, 1, 1); PG8_STAGE(PG8_SA(1, 0), a3, voffA);
            PG8_BAR; PG8_WAIT_L(0); PG8_MMA(1, 0, At, B0); PG8_BAR; PG8_SCHED;
            PG8_STAGE(PG8_SB(1, 1), b3 + hstep, voffB);
            PG8_WAIT_V(6); PG8_BAR; PG8_MMA(1, 1, At, B1); PG8_BAR;
            }
        }
        if constexpr (ALIGN_EPI) { if (wr == 0) PG8_BAR; }
        if constexpr (!Epi::AFTER_DRAIN) { E(acc, cur, wr, wc, fr, fq); S.done(cur); }
        if (!has_next) break;
#pragma unroll
        for (int a = 0; a < 2; ++a)
#pragma unroll
            for (int b = 0; b < 2; ++b)
#pragma unroll
                for (int m = 0; m < 4; ++m)
#pragma unroll
                    for (int n = 0; n < 2; ++n) acc[a][b][m][n] = (f32x4){0.f, 0.f, 0.f, 0.f};
        cur = nxt; cA = nA; cB = nB; ++ui;
        if constexpr (ALIGN_EPI) { if (wr == 1) PG8_BAR; }
    }
    PG8_WAIT_V(0);
    if constexpr (!ALIGN_EPI) { if (wr == 0) PG8_BAR; }
    PG8_BAR;
    if constexpr (Epi::AFTER_DRAIN) { E.fused(acc, cur, wr, wc, fr, fq, lds, wid, lane); S.done(cur); }
#undef PG8_SA
#undef PG8_SB
#undef PG8_STAGE
#undef PG8_LDA
#undef PG8_LDB
#undef PG8_MMA
#undef PG8_WAIT_V
#undef PG8_WAIT_L
#undef PG8_BAR
#undef PG8_SCHED
}
}

#define LAS __attribute__((address_space(3)))
typedef unsigned short bf16_t;
typedef short bf16x8 __attribute__((ext_vector_type(8)));
typedef short bf16x4 __attribute__((ext_vector_type(4)));
typedef float f32x4 __attribute__((ext_vector_type(4)));
typedef unsigned u32x4 __attribute__((ext_vector_type(4)));
typedef unsigned u32x2 __attribute__((ext_vector_type(2)));

constexpr int T = 32768, S = 16384, D = 2048;
constexpr int PC = 10240;
constexpr int NGATE = 2560, NMERGE = 6144, NIN = 18944;
constexpr int PA_Q = 0, PA_K = 1536, PA_V = 3072, PB_Q = 4608, PB_K = 5632, PB_V = 5888, PC_Q = 6144, PC_FF = 7168, PC_FB = 8192, PC_I = 9216;
constexpr float NORM_EPS = 1e-6f;
constexpr size_t MiB = 1u << 20;
constexpr size_t WS_ROPE = 1 * MiB, WS_LSE = 3 * MiB, WS_LB = 5 * MiB, WS_LSUM = 5 * MiB + 65536;
constexpr size_t WS_WIN = 6 * MiB, WS_WA = 80 * MiB, WS_WB = 82 * MiB, WS_WC = 86 * MiB, WS_WO = 90 * MiB;
constexpr size_t WS_XN = 98 * MiB, WS_YA = 226 * MiB, WS_YB = 258 * MiB, WS_YC = 322 * MiB, WS_SUM = 386 * MiB, WS_P = 418 * MiB, WS_END = 1058 * MiB;
constexpr size_t WS_G = WS_P + 3072, WS_YM = WS_XN, WS_OUT = WS_P;
constexpr int G_PITCH = PC * 2;
constexpr size_t WS_XN8 = 1058 * MiB, WS_WM8 = 1122 * MiB, WS_END8 = 1134 * MiB;
constexpr float Q_SX = 21.0f, Q_SW = 960.0f;
constexpr int LDS_BYTES = 163840;
constexpr int NTHREADS = 512;
#ifndef NLAYER
#define NLAYER 2
#endif

__device__ __forceinline__ float bf2f(unsigned short b) { return __builtin_bit_cast(float, (unsigned)b << 16); }
__device__ __forceinline__ float bf2f_s(short b) { return __builtin_bit_cast(float, ((unsigned)(unsigned short)b) << 16); }
typedef float f32x2_t __attribute__((ext_vector_type(2))); typedef __bf16 bf16x2_t __attribute__((ext_vector_type(2)));
__device__ __forceinline__ unsigned pk2(float lo, float hi) { f32x2_t v = {lo, hi}; bf16x2_t b = __builtin_convertvector(v, bf16x2_t); return __builtin_bit_cast(unsigned, b); }
__device__ __forceinline__ float wave_sum(float v) {
#pragma unroll
    for (int o = 1; o < 64; o <<= 1) v += __shfl_xor(v, o);
    return v;
}
__device__ __forceinline__ f32x4 mfma16(bf16x8 a, bf16x8 b, f32x4 c) { return __builtin_amdgcn_mfma_f32_16x16x32_bf16(a, b, c, 0, 0, 0); }
__device__ __forceinline__ float fast_sigmoid(float x) { return __builtin_amdgcn_rcpf(1.0f + __expf(-x)); }

__device__ __forceinline__ unsigned q8x4(float a, float b, float c, float d, float sc) {
    const int ia = __builtin_amdgcn_fmed3f(rintf(a * sc), -127.f, 127.f), ib = __builtin_amdgcn_fmed3f(rintf(b * sc), -127.f, 127.f);
    const int ic = __builtin_amdgcn_fmed3f(rintf(c * sc), -127.f, 127.f), id = __builtin_amdgcn_fmed3f(rintf(d * sc), -127.f, 127.f);
    return (unsigned)(ia & 0xff) | ((unsigned)(ib & 0xff) << 8) | ((unsigned)(ic & 0xff) << 16) | ((unsigned)(id & 0xff) << 24);
}
__device__ __forceinline__ void transpose_item(const float* W, int K, int N, bf16_t* WT, int drow, LAS float* scr, int k0, int n0, int lane, signed char* WT8 = nullptr) {
#pragma unroll
    for (int i = 0; i < 32; ++i) { const int kk = 2 * i + (lane >> 5); scr[kk * 33 + (lane & 31)] = W[(size_t)(k0 + kk) * N + n0 + (lane & 31)]; }
    asm volatile("s_waitcnt lgkmcnt(0)" ::: "memory");
    const int c = lane & 7;
#pragma unroll
    for (int j = 0; j < 4; ++j) { const int n = (lane >> 3) + 8 * j; const LAS float* s = scr + (8 * c) * 33 + n;
        u32x4 o; o.x = pk2(s[0 * 33], s[1 * 33]); o.y = pk2(s[2 * 33], s[3 * 33]); o.z = pk2(s[4 * 33], s[5 * 33]); o.w = pk2(s[6 * 33], s[7 * 33]);
        *(u32x4*)(WT + (size_t)(drow + n) * K + k0 + 8 * c) = o;
        if (WT8) { u32x2 q; q.x = q8x4(s[0 * 33], s[1 * 33], s[2 * 33], s[3 * 33], Q_SW); q.y = q8x4(s[4 * 33], s[5 * 33], s[6 * 33], s[7 * 33], Q_SW); *(u32x2*)(WT8 + (size_t)(drow - 12800 + n) * K + k0 + 8 * c) = q; } }
    asm volatile("s_waitcnt lgkmcnt(0)" ::: "memory");
}
__device__ __forceinline__ int win_dst(int n) {
    if (n < 4608) return n;
    if (n < 5120) return 10240 + (n - 4608);
    if (n < 6656) return 4608 + (n - 5120);
    if (n < 7680) return 10240 + 512 + (n - 6656);
    if (n < 11776) return 6144 + (n - 7680);
    if (n < 12800) return 10240 + 1536 + (n - 11776);
    return n;
}
struct Weights { const float *win, *wa, *wb, *wc, *wo; };
__device__ __forceinline__ void transpose_weights(const Weights& Wt, unsigned char* ws, LAS unsigned char* lds, int gw, int NGW, int wave, int lane) {
    LAS float* scr = (LAS float*)(lds + wave * 8448);
    constexpr int I_IN = 32 * (NIN / 32), I_A = 8 * 64, I_B = 16 * 64, I_C = 16 * 64, I_O = 32 * 64;
    constexpr int NITEMS = I_IN + I_A + I_B + I_C + I_O;
    for (int it = gw; it < NITEMS; it += NGW) {
        int r = it;
        if (r < I_IN) { const int nb = r % (NIN / 32), kb = r / (NIN / 32); transpose_item(Wt.win, D, NIN, (bf16_t*)(ws + WS_WIN), win_dst(nb * 32), scr, kb * 64, nb * 32, lane, nb * 32 >= 12800 ? (signed char*)(ws + WS_WM8) : nullptr); continue; } r -= I_IN;
        if (r < I_A) { const int nb = r % 64, kb = r / 64; transpose_item(Wt.wa, 512, D, (bf16_t*)(ws + WS_WA), nb * 32, scr, kb * 64, nb * 32, lane); continue; } r -= I_A;
        if (r < I_B) { const int nb = r % 64, kb = r / 64; transpose_item(Wt.wb, 1024, D, (bf16_t*)(ws + WS_WB), nb * 32, scr, kb * 64, nb * 32, lane); continue; } r -= I_B;
        if (r < I_C) { const int nb = r % 64, kb = r / 64; transpose_item(Wt.wc, 1024, D, (bf16_t*)(ws + WS_WC), nb * 32, scr, kb * 64, nb * 32, lane); continue; } r -= I_C;
        { const int nb = r % 64, kb = r / 64; transpose_item(Wt.wo, D, D, (bf16_t*)(ws + WS_WO), nb * 32, scr, kb * 64, nb * 32, lane); }
    }
}
__device__ __forceinline__ void prenorm_row(const float* xrow, const float* gain, bf16_t* orow, unsigned* orow8, int lane) {
    f32x4 v[8]; float s = 0.f;
#pragma unroll
    for (int j = 0; j < 8; ++j) { v[j] = ((const f32x4*)xrow)[lane + 64 * j]; s += (v[j].x * v[j].x + v[j].y * v[j].y) + (v[j].z * v[j].z + v[j].w * v[j].w); }
    const float r = 1.0f / sqrtf(wave_sum(s) * (1.0f / D) + NORM_EPS);
#pragma unroll
    for (int j = 0; j < 8; ++j) { const f32x4 g = ((const f32x4*)gain)[lane + 64 * j]; const float a = v[j].x * r * g.x, b = v[j].y * r * g.y, c = v[j].z * r * g.z, d = v[j].w * r * g.w;
        u32x2 o; o.x = pk2(a, b); o.y = pk2(c, d); ((u32x2*)orow)[lane + 64 * j] = o; orow8[lane + 64 * j] = q8x4(a, b, c, d, Q_SX); }
}
template <int NR>
__device__ __forceinline__ void final_rows(const bf16_t* const (&orow)[NR], const float* post, const float* const (&xold)[NR], float* const (&xnew)[NR], const float* pre_next, bf16_t* const (&xn_next)[NR], unsigned* const (&xn8_next)[NR], int lane) {
    f32x4 v[NR][8], xo[NR][8]; float s[NR];
#pragma unroll
    for (int q = 0; q < NR; ++q) { s[q] = 0.f;
#pragma unroll
        for (int j = 0; j < 8; ++j) { const u32x2 r = ((const u32x2*)orow[q])[lane + 64 * j];
            v[q][j].x = __builtin_bit_cast(float, r.x << 16); v[q][j].y = __builtin_bit_cast(float, r.x & 0xffff0000u); v[q][j].z = __builtin_bit_cast(float, r.y << 16); v[q][j].w = __builtin_bit_cast(float, r.y & 0xffff0000u);
            s[q] += (v[q][j].x * v[q][j].x + v[q][j].y * v[q][j].y) + (v[q][j].z * v[q][j].z + v[q][j].w * v[q][j].w); }
#pragma unroll
        for (int j = 0; j < 8; ++j) xo[q][j] = ((const f32x4*)xold[q])[lane + 64 * j]; }
#pragma unroll
    for (int q = 0; q < NR; ++q) {
        const float r = 1.0f / sqrtf(wave_sum(s[q]) * (1.0f / D) + NORM_EPS);
        float s2 = 0.f;
#pragma unroll
        for (int j = 0; j < 8; ++j) { const f32x4 g = ((const f32x4*)post)[lane + 64 * j];
            f32x4 y; y.x = xo[q][j].x + v[q][j].x * r * g.x; y.y = xo[q][j].y + v[q][j].y * r * g.y; y.z = xo[q][j].z + v[q][j].z * r * g.z; y.w = xo[q][j].w + v[q][j].w * r * g.w;
            v[q][j] = y; s2 += (y.x * y.x + y.y * y.y) + (y.z * y.z + y.w * y.w); ((f32x4*)xnew[q])[lane + 64 * j] = y; }
        if (pre_next) {
            const float r2 = 1.0f / sqrtf(wave_sum(s2) * (1.0f / D) + NORM_EPS);
#pragma unroll
            for (int j = 0; j < 8; ++j) { const f32x4 g = ((const f32x4*)pre_next)[lane + 64 * j]; const float a = v[q][j].x * r2 * g.x, b = v[q][j].y * r2 * g.y, c = v[q][j].z * r2 * g.z, d = v[q][j].w * r2 * g.w;
                u32x2 o; o.x = pk2(a, b); o.y = pk2(c, d); ((u32x2*)xn_next[q])[lane + 64 * j] = o; xn8_next[q][lane + 64 * j] = q8x4(a, b, c, d, Q_SX); }
        }
    }
}

#define EPI_LOOP_BEGIN \
    const int row0 = u.pm * 256 + wr * 64 + fr; const int colb = u.pn * 256 + wc * 32 + 8 * fq; \
    _Pragma("unroll") for (int ai = 0; ai < 2; ++ai) _Pragma("unroll") for (int m = 0; m < 4; ++m) { const int row = row0 + ai * 128 + m * 16; \
    _Pragma("unroll") for (int bj = 0; bj < 2; ++bj) { const int col = colb + bj * 128; const f32x4 v0 = acc[ai][bj][m][0], v1 = acc[ai][bj][m][1];
#define EPI_LOOP_END } }

struct EpiStoreBf16 {
    static constexpr bool PERM = true, AFTER_DRAIN = false;
    bf16_t* O; int ldc;
    __device__ __forceinline__ void operator()(const f32x4 (&acc)[2][2][4][2], const pg8::Unit& u, int wr, int wc, int fr, int fq) const {
        EPI_LOOP_BEGIN
            u32x4 w; w.x = pk2(v0[0], v0[1]); w.y = pk2(v0[2], v0[3]); w.z = pk2(v1[0], v1[1]); w.w = pk2(v1[2], v1[3]);
            *(u32x4*)(O + (size_t)row * ldc + col) = w;
        EPI_LOOP_END
    }
};
struct EpiStoreRope {
    static constexpr bool PERM = true, AFTER_DRAIN = false;
    bf16_t* O; int ldc;
    __device__ __forceinline__ void operator()(const f32x4 (&acc)[2][2][4][2], const pg8::Unit& u, int wr, int wc, int fr, int fq) const {
        const bool rt = (wc == 0) && ((u.pn < 12) || (u.pn >= 18 && u.pn < 23));
        const float sgn = (fq < 2) ? -1.f : 1.f;
        const int row0 = u.pm * 256 + wr * 64 + fr; const int colb = u.pn * 256 + wc * 32 + 8 * fq;
        float irev[8];
        if (rt) {
#pragma unroll
            for (int i = 0; i < 8; ++i) irev[i] = __builtin_amdgcn_exp2f(-(float)((fq & 1) * 8 + i) * (18.931568569324174f / 16.0f) - 2.651496129472319f);
        }
#pragma unroll
        for (int ai = 0; ai < 2; ++ai)
#pragma unroll
            for (int m = 0; m < 4; ++m) { const int row = row0 + ai * 128 + m * 16;
                float cs[8], sn[8];
                if (rt) { const float pos = (float)(row & (S - 1));
#pragma unroll
                    for (int i = 0; i < 8; ++i) { const float fr_ = __builtin_amdgcn_fractf(pos * irev[i]); cs[i] = __builtin_amdgcn_cosf(fr_); sn[i] = sgn * __builtin_amdgcn_sinf(fr_); } }
#pragma unroll
                for (int bj = 0; bj < 2; ++bj) { const int col = colb + bj * 128; const f32x4 v0 = acc[ai][bj][m][0], v1 = acc[ai][bj][m][1];
                    float y[8] = {v0[0], v0[1], v0[2], v0[3], v1[0], v1[1], v1[2], v1[3]};
                    if (rt) {
#pragma unroll
                        for (int i = 0; i < 8; ++i) { const float pt = __shfl_xor(y[i], 32); y[i] = y[i] * cs[i] + pt * sn[i]; } }
                    if (u.pn >= 24 && u.pn < 28) {
#pragma unroll
                        for (int i = 0; i < 8; ++i) y[i] = y[i] * fast_sigmoid(y[i]); }
                    u32x4 w; w.x = pk2(y[0], y[1]); w.y = pk2(y[2], y[3]); w.z = pk2(y[4], y[5]); w.w = pk2(y[6], y[7]);
                    *(u32x4*)(O + (size_t)row * ldc + col) = w; } }
    }
};
struct EpiSigmoidBf16 {
    static constexpr bool PERM = true, AFTER_DRAIN = false;
    bf16_t* O; int ldc;
    __device__ __forceinline__ void operator()(const f32x4 (&acc)[2][2][4][2], const pg8::Unit& u, int wr, int wc, int fr, int fq) const {
        EPI_LOOP_BEGIN
            u32x4 w; w.x = pk2(fast_sigmoid(v0[0]), fast_sigmoid(v0[1])); w.y = pk2(fast_sigmoid(v0[2]), fast_sigmoid(v0[3]));
            w.z = pk2(fast_sigmoid(v1[0]), fast_sigmoid(v1[1])); w.w = pk2(fast_sigmoid(v1[2]), fast_sigmoid(v1[3]));
            *(u32x4*)(O + (size_t)row * ldc + col) = w;
        EPI_LOOP_END
    }
};
struct EpiSigmoidI8 {
    static constexpr bool PERM = true, AFTER_DRAIN = false;
    unsigned char* O; int ldc; float dq;
    __device__ __forceinline__ void operator()(const f32x4 (&acc)[2][2][4][2], const pg8::Unit& u, int wr, int wc, int fr, int fq) const {
        EPI_LOOP_BEGIN
            const pg8::i32x4 i0 = __builtin_bit_cast(pg8::i32x4, v0), i1 = __builtin_bit_cast(pg8::i32x4, v1);
            unsigned b[8];
#pragma unroll
            for (int i = 0; i < 4; ++i) { b[i] = (unsigned)(255.0f * fast_sigmoid((float)i0[i] * dq) + 0.5f); b[4 + i] = (unsigned)(255.0f * fast_sigmoid((float)i1[i] * dq) + 0.5f); }
            u32x2 w; w.x = b[0] | (b[1] << 8) | (b[2] << 16) | (b[3] << 24); w.y = b[4] | (b[5] << 8) | (b[6] << 16) | (b[7] << 24);
            *(u32x2*)(O + (size_t)row * ldc + col) = w;
        EPI_LOOP_END
    }
};
struct EpiStoreF32 {
    static constexpr bool PERM = true, AFTER_DRAIN = false;
    float* O; int ldc;
    __device__ __forceinline__ void operator()(const f32x4 (&acc)[2][2][4][2], const pg8::Unit& u, int wr, int wc, int fr, int fq) const {
        EPI_LOOP_BEGIN
            float* p = O + (size_t)row * ldc + col; *(f32x4*)p = v0; *(f32x4*)(p + 4) = v1;
        EPI_LOOP_END
    }
};
__device__ __forceinline__ void unpack8(const u32x4 g, float (&f)[8]) {
    f[0] = __builtin_bit_cast(float, g.x << 16); f[1] = __builtin_bit_cast(float, g.x & 0xffff0000u); f[2] = __builtin_bit_cast(float, g.y << 16); f[3] = __builtin_bit_cast(float, g.y & 0xffff0000u);
    f[4] = __builtin_bit_cast(float, g.z << 16); f[5] = __builtin_bit_cast(float, g.z & 0xffff0000u); f[6] = __builtin_bit_cast(float, g.w << 16); f[7] = __builtin_bit_cast(float, g.w & 0xffff0000u);
}
template <bool FIRST> struct EpiBranch {
    static constexpr bool PERM = true, AFTER_DRAIN = false;
    bf16_t* YM; const unsigned char* G; int br;
    __device__ __forceinline__ void operator()(const f32x4 (&acc)[2][2][4][2], const pg8::Unit& u, int wr, int wc, int fr, int fq) const {
        const int row0 = u.pm * 256 + wr * 64 + fr; const int colb = u.pn * 256 + wc * 32 + 8 * fq;
#pragma unroll
        for (int ai = 0; ai < 2; ++ai) {
            u32x2 gv[4][2]; u32x4 yv[4][2];
#pragma unroll
            for (int m = 0; m < 4; ++m)
#pragma unroll
                for (int bj = 0; bj < 2; ++bj) { const int row = row0 + ai * 128 + m * 16, col = colb + bj * 128;
                    gv[m][bj] = *(const u32x2*)(G + (size_t)row * G_PITCH + br * 2048 + col);
                    if (!FIRST) yv[m][bj] = *(const u32x4*)(YM + (size_t)row * D + col); }
#pragma unroll
            for (int m = 0; m < 4; ++m)
#pragma unroll
                for (int bj = 0; bj < 2; ++bj) { const int row = row0 + ai * 128 + m * 16, col = colb + bj * 128; const f32x4 v0 = acc[ai][bj][m][0], v1 = acc[ai][bj][m][1];
                    float g[8], y[8];
#pragma unroll
                    for (int i = 0; i < 4; ++i) { g[i] = (float)((gv[m][bj].x >> (8 * i)) & 0xffu) * (1.0f / 255.0f); g[4 + i] = (float)((gv[m][bj].y >> (8 * i)) & 0xffu) * (1.0f / 255.0f); }
                    y[0] = v0[0] * g[0]; y[1] = v0[1] * g[1]; y[2] = v0[2] * g[2]; y[3] = v0[3] * g[3]; y[4] = v1[0] * g[4]; y[5] = v1[1] * g[5]; y[6] = v1[2] * g[6]; y[7] = v1[3] * g[7];
                    if (!FIRST) { float o[8]; unpack8(yv[m][bj], o);
#pragma unroll
                        for (int i = 0; i < 8; ++i) y[i] += o[i]; }
                    u32x4 w; w.x = pk2(y[0], y[1]); w.y = pk2(y[2], y[3]); w.z = pk2(y[4], y[5]); w.w = pk2(y[6], y[7]);
                    *(u32x4*)(YM + (size_t)row * D + col) = w; }
        }
    }
};
struct EpiGate {
    static constexpr bool PERM = true, AFTER_DRAIN = false;
    bf16_t *Ya, *Yb, *Yc; const bf16_t* P; const float* lse;
    __device__ __forceinline__ void operator()(const f32x4 (&acc)[2][2][4][2], const pg8::Unit& u, int wr, int wc, int fr, int fq) const {
        const int row0 = u.pm * 256 + wr * 64 + fr; const int colb = u.pn * 256 + wc * 32 + 8 * fq;
        if (u.pn >= 2) {
            bf16_t* Y = (u.pn < 6) ? Yb : Yc; const int cofs = (u.pn < 6) ? 512 : 1536;
#pragma unroll
            for (int ai = 0; ai < 2; ++ai) {
                u32x4 rv[4][2];
#pragma unroll
                for (int m = 0; m < 4; ++m)
#pragma unroll
                    for (int bj = 0; bj < 2; ++bj) rv[m][bj] = *(const u32x4*)(Y + (size_t)(row0 + ai * 128 + m * 16) * 1024 + (colb + bj * 128 - cofs));
#pragma unroll
                for (int m = 0; m < 4; ++m)
#pragma unroll
                    for (int bj = 0; bj < 2; ++bj) { const f32x4 v0 = acc[ai][bj][m][0], v1 = acc[ai][bj][m][1];
                        float raw[8]; unpack8(rv[m][bj], raw);
                        const float a[8] = {v0[0], v0[1], v0[2], v0[3], v1[0], v1[1], v1[2], v1[3]};
                        float y[8];
#pragma unroll
                        for (int i = 0; i < 8; ++i) y[i] = raw[i] * a[i] * fast_sigmoid(a[i]);
                        u32x4 w; w.x = pk2(y[0], y[1]); w.y = pk2(y[2], y[3]); w.z = pk2(y[4], y[5]); w.w = pk2(y[6], y[7]);
                        *(u32x4*)(Y + (size_t)(row0 + ai * 128 + m * 16) * 1024 + (colb + bj * 128 - cofs)) = w; }
            }
        } else {
#pragma unroll
            for (int ai = 0; ai < 2; ++ai)
#pragma unroll
                for (int mp = 0; mp < 4; ++mp) {
                    u32x4 ov[1][2][3]; float lv[1][2][3];
#pragma unroll
                    for (int mm = 0; mm < 1; ++mm)
#pragma unroll
                        for (int bj = 0; bj < 2; ++bj) { const int row = row0 + ai * 128 + (mp + mm) * 16, col = colb + bj * 128, slot = col >> 7;
#pragma unroll
                            for (int g = 0; g < 3; ++g) { ov[mm][bj][g] = *(const u32x4*)(P + (size_t)row * PC + g * 512 + col); lv[mm][bj][g] = lse[((size_t)g * T + row) * 4 + slot]; } }
#pragma unroll
                    for (int mm = 0; mm < 1; ++mm)
#pragma unroll
                        for (int bj = 0; bj < 2; ++bj) { const int m = mp + mm; const int row = row0 + ai * 128 + m * 16, col = colb + bj * 128; const f32x4 v0 = acc[ai][bj][m][0], v1 = acc[ai][bj][m][1];
                            const float l0 = lv[mm][bj][0], l1 = lv[mm][bj][1], l2 = lv[mm][bj][2];
                            const float mx = fmaxf(l0, fmaxf(l1, l2)); float e0 = __expf(l0 - mx), e1 = __expf(l1 - mx), e2 = __expf(l2 - mx);
                            const float inv = 1.0f / (e0 + e1 + e2); e0 *= inv; e1 *= inv; e2 *= inv;
                            float o0[8], o1[8], o2[8]; unpack8(ov[mm][bj][0], o0); unpack8(ov[mm][bj][1], o1); unpack8(ov[mm][bj][2], o2);
                            const float a[8] = {v0[0], v0[1], v0[2], v0[3], v1[0], v1[1], v1[2], v1[3]};
                            float y[8];
#pragma unroll
                            for (int i = 0; i < 8; ++i) y[i] = (e0 * o0[i] + e1 * o1[i] + e2 * o2[i]) * a[i] * fast_sigmoid(a[i]);
                            u32x4 w; w.x = pk2(y[0], y[1]); w.y = pk2(y[2], y[3]); w.z = pk2(y[4], y[5]); w.w = pk2(y[6], y[7]);
                            *(u32x4*)(Ya + (size_t)row * 512 + col) = w; }
                }
        }
    }
};

constexpr int KP = 136;
struct AttnSrc { const bf16_t* Kg; const bf16_t* Vg; const bf16_t* Qrow; long tok0; int dil, kbase, L; };
template <int NKK, int NKV> struct StageRegs { bf16x8 k[(NKK * 16 + 511) / 512]; bf16x8 v[((NKV / 16) * 4 + 7) / 8]; bf16x8 q[4]; };
template <int NKK, int NKV, bool WITHQ>
__device__ __forceinline__ void stage_load(StageRegs<NKK, NKV>& R, const AttnSrc& A, int tid) {
    constexpr int KI = (NKK * 16 + 511) / 512, VI = ((NKV / 16) * 4 + 7) / 8;
    const int wave = tid >> 6, lane = tid & 63;
#pragma unroll
    for (int i = 0; i < KI; ++i) { const int task = tid + i * 512; const int row = task >> 4, c = task & 15; const int ki = A.kbase + row;
        bf16x8 v = (bf16x8){0, 0, 0, 0, 0, 0, 0, 0};
        if (task < NKK * 16 && ki >= 0 && ki < A.L) v = *(const bf16x8*)(A.Kg + (size_t)(A.tok0 + (long)ki * A.dil) * PC + c * 8);
        R.k[i] = v; }
#pragma unroll
    for (int i = 0; i < VI; ++i) { const int it = wave + 8 * i; const int row = (it >> 2) * 16 + (lane & 15), c = (it & 3) * 4 + (lane >> 4); const int ki = A.kbase + row;
        bf16x8 v = (bf16x8){0, 0, 0, 0, 0, 0, 0, 0};
        if (it < (NKV / 16) * 4 && ki >= 0 && ki < A.L) v = *(const bf16x8*)(A.Vg + (size_t)(A.tok0 + (long)ki * A.dil) * PC + c * 8);
        R.v[i] = v; }
    if (WITHQ) {
#pragma unroll
        for (int ks = 0; ks < 4; ++ks) R.q[ks] = *(const bf16x8*)(A.Qrow + ks * 32 + (lane >> 4) * 8); }
}
template <int NKK, int NKV, int VP>
__device__ __forceinline__ void stage_store(const StageRegs<NKK, NKV>& R, LAS bf16_t* Ks, LAS bf16_t* Vt, int tid) {
    constexpr int KI = (NKK * 16 + 511) / 512, VI = ((NKV / 16) * 4 + 7) / 8;
    const int wave = tid >> 6, lane = tid & 63;
#pragma unroll
    for (int i = 0; i < KI; ++i) { const int task = tid + i * 512; const int row = task >> 4, c = task & 15;
        if (task < NKK * 16) *(LAS bf16x8*)(Ks + row * KP + c * 8) = R.k[i]; }
#pragma unroll
    for (int i = 0; i < VI; ++i) { const int it = wave + 8 * i; const int row = (it >> 2) * 16 + (lane & 15), c = (it & 3) * 4 + (lane >> 4);
        if (it < (NKV / 16) * 4) {
            const u32x4 wv = __builtin_bit_cast(u32x4, R.v[i]); const bool odd = lane & 1;
            const unsigned rx = __shfl_xor(odd ? wv.x : wv.z, 1), ry = __shfl_xor(odd ? wv.y : wv.w, 1);
            const unsigned a0 = odd ? rx : wv.x, b0 = odd ? wv.z : rx, a1 = odd ? ry : wv.y, b1 = odd ? wv.w : ry;
            LAS unsigned* vp = (LAS unsigned*)(Vt + (c * 8 + (odd ? 4 : 0)) * VP + (row & ~1));
            vp[0] = (a0 & 0xffffu) | (b0 << 16); vp[VP / 2] = (a0 >> 16) | (b0 & 0xffff0000u);
            vp[VP] = (a1 & 0xffffu) | (b1 << 16); vp[VP + VP / 2] = (a1 >> 16) | (b1 & 0xffff0000u); } }
}
template <int NT, int VP>
__device__ __forceinline__ void attn_wave(const LAS bf16_t* Ks, const LAS bf16_t* Vt, int kt0, const bf16x8 (&qf)[4], int qi, int kbase, int L, int hw,
                                          bool has_sink, float sink, f32x4 (&o)[8], float& lse_out, int lane) {
    const int lr = lane & 15, lq = lane >> 4;
    f32x4 s[NT];
#pragma unroll
    for (int kt = 0; kt < NT - 1; ++kt) { f32x4 a = (f32x4){0.f, 0.f, 0.f, 0.f}; const LAS bf16_t* kp = Ks + (kt0 + 16 * kt + lr) * KP + lq * 8;
#pragma unroll
        for (int ks = 0; ks < 4; ++ks) a = mfma16(*(const LAS bf16x8*)(kp + ks * 32), qf[ks], a);
        s[kt] = a; }
    s[NT - 1] = (f32x4){-INFINITY, -INFINITY, -INFINITY, -INFINITY};
    const bool edge = (kbase + kt0 < 0) || (kbase + kt0 + 16 * NT > L);
#pragma unroll
    for (int kt = 0; kt < NT - 1; ++kt) {
        if (kt == 0 || kt == NT - 2 || edge) {
#pragma unroll
            for (int j = 0; j < 4; ++j) { const int ki = kbase + kt0 + 16 * kt + lq * 4 + j; const int rel = ki - qi;
                const bool ok = (ki >= 0) && (ki < L) && (rel <= hw) && (rel >= -hw);
                s[kt][j] = ok ? s[kt][j] : -INFINITY; } }
    }
    float m = -INFINITY;
#pragma unroll
    for (int kt = 0; kt < NT - 1; ++kt) m = fmaxf(fmaxf(m, fmaxf(s[kt][0], s[kt][1])), fmaxf(s[kt][2], s[kt][3]));
    m = fmaxf(m, __shfl_xor(m, 16)); m = fmaxf(m, __shfl_xor(m, 32));
    const float sc = 0.08838834764831845f * 1.4426950408889634f;
    float m2 = m * sc;
    if (has_sink) m2 = fmaxf(m2, sink * 1.4426950408889634f);
    float den = 0.f;
#pragma unroll
    for (int kt = 0; kt < NT - 1; ++kt)
#pragma unroll
        for (int j = 0; j < 4; ++j) { const float p = __builtin_amdgcn_exp2f(s[kt][j] * sc - m2); s[kt][j] = p; den += p; }
    s[NT - 1] = (f32x4){0.f, 0.f, 0.f, 0.f};
    den += __shfl_xor(den, 16); den += __shfl_xor(den, 32);
    if (has_sink) den += __builtin_amdgcn_exp2f(sink * 1.4426950408889634f - m2);
#pragma unroll
    for (int dt = 0; dt < 8; ++dt) o[dt] = (f32x4){0.f, 0.f, 0.f, 0.f};
#pragma unroll
    for (int t = 0; t < NT / 2; ++t) {
        u32x4 pw; pw.x = pk2(s[2 * t][0], s[2 * t][1]); pw.y = pk2(s[2 * t][2], s[2 * t][3]); pw.z = pk2(s[2 * t + 1][0], s[2 * t + 1][1]); pw.w = pk2(s[2 * t + 1][2], s[2 * t + 1][3]);
        const bf16x8 p = __builtin_bit_cast(bf16x8, pw);
#pragma unroll
        for (int dt = 0; dt < 8; ++dt) { const LAS bf16_t* vp = Vt + (dt * 16 + lr) * VP + kt0 + 32 * t + lq * 4;
            const u32x2 a0 = *(const LAS u32x2*)vp, a1 = *(const LAS u32x2*)(vp + 16);
            u32x4 aw; aw.x = a0.x; aw.y = a0.y; aw.z = a1.x; aw.w = a1.y;
            o[dt] = mfma16(__builtin_bit_cast(bf16x8, aw), p, o[dt]); }
    }
    const float inv = 1.0f / den;
#pragma unroll
    for (int dt = 0; dt < 8; ++dt) o[dt] = o[dt] * inv;
    lse_out = (m2 + __builtin_amdgcn_logf(den)) * 0.6931471805599453f;
}
constexpr int A_NK = 272, A_VP = 280, B_NKK = 288, B_NKV = 304, B_VP = 312;
struct AUnit { int g, slot, dil, phase, jb, L; long tok0; };
__device__ __forceinline__ AUnit decodeA(int u) { AUnit a; const int b = u / 1536, r = u % 1536; a.g = r >> 9; const int r2 = r & 511; a.slot = r2 >> 7; const int blk = r2 & 127;
    const int sh = 2 * a.g; a.dil = 1 << sh; const int nbp = 128 >> sh; a.phase = blk / nbp; a.jb = blk % nbp; a.L = S >> sh; a.tok0 = (long)b * S + a.phase; return a; }
__device__ __forceinline__ AttnSrc srcA(const AUnit& a, const bf16_t* P, int tid) { const int head = a.g * 4 + a.slot; const int w = tid >> 6, lr = tid & 15;
    const int qi = a.jb * 128 + 16 * w + lr;
    AttnSrc s; s.Kg = P + PA_K + head * 128; s.Vg = P + PA_V + head * 128; s.Qrow = P + (size_t)(a.tok0 + (long)qi * a.dil) * PC + PA_Q + head * 128; s.tok0 = a.tok0; s.dil = a.dil; s.kbase = a.jb * 128 - 64; s.L = a.L; return s; }
__device__ __forceinline__ void attnA_phase(bf16_t* P, float* lse, LAS unsigned char* lds, int tid, int bx, int G) {
    LAS bf16_t* Ks = (LAS bf16_t*)lds; LAS bf16_t* Vt = (LAS bf16_t*)(lds + A_NK * KP * 2);
    StageRegs<A_NK, A_NK> R;
    int u = bx;
    if (u < 3072) { const AUnit a = decodeA(u); stage_load<A_NK, A_NK, true>(R, srcA(a, P, tid), tid); }
    for (; u < 3072; u += G) {
        const AUnit a = decodeA(u);
        stage_store<A_NK, A_NK, A_VP>(R, Ks, Vt, tid);
        bf16x8 qf[4];
#pragma unroll
        for (int ks = 0; ks < 4; ++ks) qf[ks] = R.q[ks];
        __syncthreads();
        if (u + G < 3072) { const AUnit an = decodeA(u + G); stage_load<A_NK, A_NK, true>(R, srcA(an, P, tid), tid); }
        const int w = tid >> 6, lane = tid & 63, lr = lane & 15, lq = lane >> 4;
        const int qi = a.jb * 128 + 16 * w + lr; const long token = a.tok0 + (long)qi * a.dil; const int head = a.g * 4 + a.slot;
        f32x4 o[8]; float lv;
        attn_wave<10, A_VP>(Ks, Vt, 16 * w, qf, qi, a.jb * 128 - 64, a.L, 64, false, 0.f, o, lv, lane);
        bf16_t* qrow = P + (size_t)token * PC + PA_Q + head * 128;
#pragma unroll
        for (int dt = 0; dt < 8; ++dt) { u32x2 wv; wv.x = pk2(o[dt][0], o[dt][1]); wv.y = pk2(o[dt][2], o[dt][3]); *(u32x2*)(qrow + dt * 16 + lq * 4) = wv; }
        if (lq == 0) lse[((size_t)a.g * T + token) * 4 + a.slot] = lv;
        __syncthreads();
    }
}
__device__ __forceinline__ AttnSrc srcB(int u, const bf16_t* P, int tid) { const int b = u >> 10, r = u & 1023, kvh = r >> 9, blk = r & 511; const int w = tid >> 6, lr = tid & 15;
    const int head = kvh * 4 + (w >> 1), qi = blk * 32 + 16 * (w & 1) + lr;
    AttnSrc s; s.Kg = P + PB_K + kvh * 128; s.Vg = P + PB_V + kvh * 128; s.tok0 = (long)b * S; s.Qrow = P + (size_t)(s.tok0 + qi) * PC + PB_Q + head * 128; s.dil = 1; s.kbase = blk * 32 - 128; s.L = S; return s; }
__device__ __forceinline__ void attnB_phase(const bf16_t* P, bf16_t* Yb, const float* sinks, LAS unsigned char* lds, int tid, int bx, int G) {
    LAS bf16_t* Ks = (LAS bf16_t*)lds; LAS bf16_t* Vt = (LAS bf16_t*)(lds + B_NKK * KP * 2);
    StageRegs<B_NKK, B_NKV> R;
    int u = bx;
    if (u < 2048) stage_load<B_NKK, B_NKV, false>(R, srcB(u, P, tid), tid);
    for (; u < 2048; u += G) {
        bf16x8 qf[4];
        { const AttnSrc sq = srcB(u, P, tid);
#pragma unroll
          for (int ks = 0; ks < 4; ++ks) qf[ks] = *(const bf16x8*)(sq.Qrow + ks * 32 + ((tid & 63) >> 4) * 8); }
        stage_store<B_NKK, B_NKV, B_VP>(R, Ks, Vt, tid);
        __syncthreads();
        if (u + G < 2048) stage_load<B_NKK, B_NKV, false>(R, srcB(u + G, P, tid), tid);
        const int b = u >> 10, r = u & 1023, kvh = r >> 9, blk = r & 511;
        const int w = tid >> 6, lane = tid & 63, lr = lane & 15, lq = lane >> 4;
        const int head = kvh * 4 + (w >> 1), rg = w & 1;
        const int qi = blk * 32 + 16 * rg + lr; const long token = (long)b * S + qi;
        f32x4 o[8]; float lv;
        attn_wave<18, B_VP>(Ks, Vt, 16 * rg, qf, qi, blk * 32 - 128, S, 128, true, sinks[head], o, lv, lane);
        bf16_t* orow = Yb + (size_t)token * 1024 + head * 128;
#pragma unroll
        for (int dt = 0; dt < 8; ++dt) { u32x2 wv; wv.x = pk2(o[dt][0], o[dt][1]); wv.y = pk2(o[dt][2], o[dt][3]); *(u32x2*)(orow + dt * 16 + lq * 4) = wv; }
        __syncthreads();
    }
}

constexpr int H_QT = 0, H_KT = 17408, H_QH = 34816, H_KHT = 52224, H_VT = 70656, H_ST = 89088, H_SC = 123904, H_QS = 133120, H_DEC = 135168;
__device__ __forceinline__ void hgrn_unit(int b, int h, int seg, int dir, int mode, bf16_t* P, const float* lb, float* SUM, float* LSUM, LAS unsigned char* lds, int tid) {
    const int w = tid >> 6, lane = tid & 63, lr = lane & 15, lq = lane >> 4;
    const int k = tid & 127, tq = tid >> 7;
    LAS bf16_t* Qt = (LAS bf16_t*)(lds + H_QT); LAS bf16_t* Kt = (LAS bf16_t*)(lds + H_KT);
    LAS bf16_t* KhT = (LAS bf16_t*)(lds + H_KHT); LAS bf16_t* VT = (LAS bf16_t*)(lds + H_VT); LAS bf16_t* ST = (LAS bf16_t*)(lds + H_ST);
    LAS bf16_t* Sc = (LAS bf16_t*)(lds + H_SC); LAS float* QS = (LAS float*)(lds + H_QS); LAS float* DEC = (LAS float*)(lds + H_DEC);
    const float lbv = lb[h * 128 + k], oml = 1.0f - lbv;
    f32x4 Sacc[8];
#pragma unroll
    for (int vt = 0; vt < 8; ++vt) Sacc[vt] = (f32x4){0.f, 0.f, 0.f, 0.f};
    float lsum = 0.f;
    const int chain = ((b * 8 + h) * 2 + dir) * 16;
    if (mode == 1) {
        const int nprev = dir ? 15 - seg : seg;
        f32x4 nx[8], nl;
        if (nprev > 0) { const int su = chain + (dir ? 15 : 0); const float* sp = SUM + (size_t)su * 16384; nl = *(const f32x4*)(LSUM + su * 128 + 16 * w + lq * 4);
#pragma unroll
            for (int vt = 0; vt < 8; ++vt) nx[vt] = *(const f32x4*)(sp + ((w * 8 + vt) * 64 + lane) * 4); }
        for (int jj = 0; jj < nprev; ++jj) {
            f32x4 cx[8]; const f32x4 lv = nl;
#pragma unroll
            for (int vt = 0; vt < 8; ++vt) cx[vt] = nx[vt];
            if (jj + 1 < nprev) { const int su = chain + (dir ? 14 - jj : jj + 1); const float* sp = SUM + (size_t)su * 16384; nl = *(const f32x4*)(LSUM + su * 128 + 16 * w + lq * 4);
#pragma unroll
                for (int vt = 0; vt < 8; ++vt) nx[vt] = *(const f32x4*)(sp + ((w * 8 + vt) * 64 + lane) * 4); }
            f32x4 dv; dv.x = __expf(lv.x); dv.y = __expf(lv.y); dv.z = __expf(lv.z); dv.w = __expf(lv.w);
#pragma unroll
            for (int vt = 0; vt < 8; ++vt) Sacc[vt] = Sacc[vt] * dv + cx[vt]; }
    }
    typedef __attribute__((address_space(1))) const bf16_t gbf16_t;
    gbf16_t* Pg = (gbf16_t*)P;
    const unsigned colF = (dir ? PC_FB : PC_FF) + h * 128 + k, colV = PC_I + h * 128 + k, colQ = PC_Q + h * 128 + k;
    unsigned short nfz[16], nv[16], nq[16];
#define HG_ROW0(cc_) ((unsigned)((b * S + (seg * 16 + (dir ? 15 - (cc_) : (cc_))) * 64 + (dir ? 63 - tq * 16 : tq * 16)) * PC))
#define HG_LOAD_F(cc_) do { unsigned vo_ = HG_ROW0(cc_) + colF; asm volatile("" : "+v"(vo_)); \
        _Pragma("unroll") for (int ii = 0; ii < 16; ++ii) nfz[ii] = Pg[dir ? vo_ - (unsigned)(ii * PC) : vo_ + (unsigned)(ii * PC)]; } while (0)
#define HG_LOAD_QV(cc_) do { unsigned vo_ = HG_ROW0(cc_); asm volatile("" : "+v"(vo_)); \
        _Pragma("unroll") for (int ii = 0; ii < 16; ++ii) { const unsigned ro_ = dir ? vo_ - (unsigned)(ii * PC) : vo_ + (unsigned)(ii * PC); \
            nv[ii] = Pg[ro_ + colV]; if (mode == 1) nq[ii] = Pg[ro_ + colQ]; } } while (0)
    float lf[16], kk[16];
#define HG_STAGE1(qb_) do { \
        _Pragma("unroll") for (int ii = 0; ii < 16; ++ii) { const float fz = bf2f(nfz[ii]); const float e = __expf(-fz), sg = __builtin_amdgcn_rcpf(1.0f + e); \
            lf[ii] = __logf(lbv + oml * sg); kk[ii] = oml * e * sg; } \
        _Pragma("unroll") for (int ii = 1; ii < 16; ++ii) lf[ii] += lf[ii - 1]; \
        QS[(qb_) * 640 + tq * 128 + k] = lf[15]; } while (0)
    HG_LOAD_F(0); HG_LOAD_QV(0);
    HG_STAGE1(0);
    HG_LOAD_F(1);
    __syncthreads();
    for (int cc = 0; cc < 16; ++cc) {
        const int c = seg * 16 + (dir ? 15 - cc : cc); const long btok = (long)b * S + c * 64;
        LAS float* QSc = QS + (cc & 1) * 640;
        const float q0 = QSc[k], q1 = QSc[128 + k], q2 = QSc[256 + k], q3 = QSc[384 + k];
        const float off = (tq > 0 ? q0 : 0.f) + (tq > 1 ? q1 : 0.f) + (tq > 2 ? q2 : 0.f);
        const float rref = q0 + q1, bl = (q0 + q1) + (q2 + q3);
        if (tq == 0) { DEC[k] = __expf(bl); lsum += bl; }
        u32x4 kh0, kh1, vv0, vv1;
        {
            float khat[16];
            const float ebr = __expf(bl - rref);
#pragma unroll
            for (int ii = 0; ii < 16; ++ii) { const int i = tq * 16 + ii; const float bt = off + lf[ii];
                if (mode == 1) { const float qh = bf2f(nq[ii]);
                    const float eq = __expf(fminf(fmaxf(bt - rref, -80.f), 80.f)), ek = __builtin_amdgcn_rcpf(eq);
                    const float kt = kk[ii] * ek; khat[ii] = kt * ebr;
                    Qt[i * KP + k] = (bf16_t)(pk2(qh * eq, 0.f) & 0xffffu); Kt[i * KP + k] = (bf16_t)(pk2(kt, 0.f) & 0xffffu); }
                else khat[ii] = kk[ii] * __expf(bl - bt); }
            kh0.x = pk2(khat[0], khat[1]); kh0.y = pk2(khat[2], khat[3]); kh0.z = pk2(khat[4], khat[5]); kh0.w = pk2(khat[6], khat[7]);
            kh1.x = pk2(khat[8], khat[9]); kh1.y = pk2(khat[10], khat[11]); kh1.z = pk2(khat[12], khat[13]); kh1.w = pk2(khat[14], khat[15]);
            vv0.x = nv[0] | ((unsigned)nv[1] << 16); vv0.y = nv[2] | ((unsigned)nv[3] << 16); vv0.z = nv[4] | ((unsigned)nv[5] << 16); vv0.w = nv[6] | ((unsigned)nv[7] << 16);
            vv1.x = nv[8] | ((unsigned)nv[9] << 16); vv1.y = nv[10] | ((unsigned)nv[11] << 16); vv1.z = nv[12] | ((unsigned)nv[13] << 16); vv1.w = nv[14] | ((unsigned)nv[15] << 16);
        }
        *(LAS u32x4*)(KhT + k * 72 + tq * 16) = kh0; *(LAS u32x4*)(KhT + k * 72 + tq * 16 + 8) = kh1;
        *(LAS u32x4*)(VT + k * 72 + tq * 16) = vv0; *(LAS u32x4*)(VT + k * 72 + tq * 16 + 8) = vv1;
        if (mode == 1) {
            const f32x4 ra = *(const LAS f32x4*)(QSc + 16 * w + lq * 4), rb = *(const LAS f32x4*)(QSc + 128 + 16 * w + lq * 4);
            f32x4 er; er.x = __expf(ra.x + rb.x); er.y = __expf(ra.y + rb.y); er.z = __expf(ra.z + rb.z); er.w = __expf(ra.w + rb.w);
#pragma unroll
            for (int vt = 0; vt < 8; ++vt) { const f32x4 sx = Sacc[vt] * er; u32x2 sv; sv.x = pk2(sx[0], sx[1]); sv.y = pk2(sx[2], sx[3]); *(LAS u32x2*)(ST + (16 * vt + lr) * KP + 16 * w + lq * 4) = sv; }
        }
        __syncthreads();
        if (cc < 15) { HG_STAGE1((cc + 1) & 1); HG_LOAD_QV(cc + 1); if (cc < 14) HG_LOAD_F(cc + 2); }
        if (mode == 1) {
#pragma unroll
            for (int e = 0; e < 2; ++e) { const int ti = 2 * w + e, st = ti >> 2, tt = ti & 3;
                f32x4 a = (f32x4){0.f, 0.f, 0.f, 0.f};
                if (st <= tt) {
#pragma unroll
                    for (int ks = 0; ks < 4; ++ks) a = mfma16(*(const LAS bf16x8*)(Kt + (16 * st + lr) * KP + ks * 32 + lq * 8), *(const LAS bf16x8*)(Qt + (16 * tt + lr) * KP + ks * 32 + lq * 8), a);
                }
                const int t = 16 * tt + lr, s0 = 16 * st + lq * 4;
                float x0 = (t >= s0 && st <= tt) ? a[0] : 0.f, x1 = (t >= s0 + 1 && st <= tt) ? a[1] : 0.f, x2 = (t >= s0 + 2 && st <= tt) ? a[2] : 0.f, x3 = (t >= s0 + 3 && st <= tt) ? a[3] : 0.f;
                u32x2 sv; sv.x = pk2(x0, x1); sv.y = pk2(x2, x3); *(LAS u32x2*)(Sc + t * 72 + s0) = sv; }
            __syncthreads();
            const int tt = w & 3, vh = w >> 2;
            bf16x8 scf[2], qhf[4];
#pragma unroll
            for (int ks = 0; ks < 2; ++ks) scf[ks] = *(const LAS bf16x8*)(Sc + (16 * tt + lr) * 72 + ks * 32 + lq * 8);
#pragma unroll
            for (int ks = 0; ks < 4; ++ks) qhf[ks] = *(const LAS bf16x8*)(Qt + (16 * tt + lr) * KP + ks * 32 + lq * 8);
            const int il = 16 * tt + lr; const long tok = btok + (dir ? 63 - il : il);
#pragma unroll
            for (int vi = 0; vi < 4; ++vi) { const int vt = vh * 4 + vi; f32x4 a = (f32x4){0.f, 0.f, 0.f, 0.f};
#pragma unroll
                for (int ks = 0; ks < 2; ++ks) a = mfma16(*(const LAS bf16x8*)(VT + (16 * vt + lr) * 72 + ks * 32 + lq * 8), scf[ks], a);
#pragma unroll
                for (int ks = 0; ks < 4; ++ks) a = mfma16(*(const LAS bf16x8*)(ST + (16 * vt + lr) * KP + ks * 32 + lq * 8), qhf[ks], a);
                bf16_t* of = P + (size_t)tok * PC + PC_FF + h * 128 + 16 * vt + lq * 4;
                if (dir == 0) { u32x2 sv; sv.x = pk2(a[0], a[1]); sv.y = pk2(a[2], a[3]); *(u32x2*)of = sv; }
                else { const u32x2 pv = *(const u32x2*)of;
                    a[0] += __builtin_bit_cast(float, pv.x << 16); a[1] += __builtin_bit_cast(float, pv.x & 0xffff0000u); a[2] += __builtin_bit_cast(float, pv.y << 16); a[3] += __builtin_bit_cast(float, pv.y & 0xffff0000u);
                    u32x2 sv; sv.x = pk2(a[0], a[1]); sv.y = pk2(a[2], a[3]); *(u32x2*)(P + (size_t)tok * PC + PC_FB + h * 128 + 16 * vt + lq * 4) = sv; } }
        }
        { const f32x4 dv = *(const LAS f32x4*)(DEC + 16 * w + lq * 4);
          bf16x8 af[2];
#pragma unroll
          for (int ks = 0; ks < 2; ++ks) af[ks] = *(const LAS bf16x8*)(KhT + (16 * w + lr) * 72 + ks * 32 + lq * 8);
#pragma unroll
          for (int vt = 0; vt < 8; ++vt) { f32x4 a = Sacc[vt] * dv;
#pragma unroll
              for (int ks = 0; ks < 2; ++ks) a = mfma16(af[ks], *(const LAS bf16x8*)(VT + (16 * vt + lr) * 72 + ks * 32 + lq * 8), a);
              Sacc[vt] = a; } }
        __syncthreads();
    }
#undef HG_STAGE1
#undef HG_LOAD_F
#undef HG_LOAD_QV
#undef HG_ROW0
    if (mode == 0) { const int su = chain + seg; float* sp = SUM + (size_t)su * 16384;
#pragma unroll
        for (int vt = 0; vt < 8; ++vt) *(f32x4*)(sp + ((w * 8 + vt) * 64 + lane) * 4) = Sacc[vt];
        if (tq == 0) LSUM[su * 128 + k] = lsum; }
}
__device__ __forceinline__ void hgrn_full_unit(int u, bf16_t* P, const float* lb, const float* hnorm, float* SUM, float* LSUM, bf16_t* Yc, LAS unsigned char* lds, int tid) {
    const int b = u >> 7, h = (u >> 4) & 7, seg = u & 15;
    hgrn_unit(b, h, seg, 0, 1, P, lb, SUM, LSUM, lds, tid);
    __syncthreads();
#if defined(PROBE_HG) && PROBE_HG == 1
    return;
#endif
    hgrn_unit(b, h, seg, 1, 1, P, lb, SUM, LSUM, lds, tid);
    __syncthreads();
#if defined(PROBE_HG) && PROBE_HG == 2
    return;
#endif
    const int w = tid >> 6, lane = tid & 63;
    const float g0 = hnorm[h * 128 + 2 * lane], g1 = hnorm[h * 128 + 2 * lane + 1];
    for (int r0 = w * 128; r0 < w * 128 + 128; r0 += 16) {
        unsigned pv[16];
#pragma unroll
        for (int i = 0; i < 16; ++i) pv[i] = *(const unsigned*)(P + (size_t)((long)b * S + seg * 1024 + r0 + i) * PC + PC_FB + h * 128 + 2 * lane);
#pragma unroll
        for (int i = 0; i < 16; ++i) { const long tok = (long)b * S + seg * 1024 + r0 + i;
            const float x0 = __builtin_bit_cast(float, pv[i] << 16), x1 = __builtin_bit_cast(float, pv[i] & 0xffff0000u);
            const float ss = wave_sum(x0 * x0 + x1 * x1); const float rs = 1.0f / sqrtf(ss * (1.0f / 128.f) + NORM_EPS);
            *(unsigned*)(Yc + (size_t)tok * 1024 + h * 128 + 2 * lane) = pk2(x0 * rs * g0, x1 * rs * g1); }
    }
    __syncthreads();
}

#define XB_TMO      128
#define XB_XCNT(j)  (256  + 64 * (j))
#define XB_XSUB(j)  (1280 + 64 * (j))
#define XB_XGEN(j)  (2304 + 64 * (j))
#define XB_TOP      3328
#define XB_TOPGEN   3392
#define XCD_BAR_WORDS 3456
#define XB_SPIN_CAP (1u << 18)

__device__ __forceinline__ unsigned xb_ld(unsigned* p)              { return __hip_atomic_load(p, __ATOMIC_RELAXED, __HIP_MEMORY_SCOPE_AGENT); }
__device__ __forceinline__ unsigned xb_add(unsigned* p, unsigned v) { return __hip_atomic_fetch_add(p, v, __ATOMIC_RELAXED, __HIP_MEMORY_SCOPE_AGENT); }
__device__ __forceinline__ unsigned xb_xcc_id() { return (unsigned)__builtin_amdgcn_s_getreg((3 << 11) | 20) & 0xFu; }
#define XB_SPIN(cond, bar) do { unsigned _sp = 0; while (cond) { __builtin_amdgcn_s_sleep(1); \
    if ((++_sp & 255u) == 0u) { if (xb_ld(&(bar)[XB_TMO])) break; if (_sp > XB_SPIN_CAP) { atomicAdd(&(bar)[XB_TMO], 1u); break; } } } } while (0)

struct XcdBarrier {
    unsigned* bar; unsigned x;
    volatile LAS unsigned* st;
};

__device__ __forceinline__ XcdBarrier xcd_barrier_post(unsigned* bar, volatile LAS unsigned* st) {
    XcdBarrier b; b.bar = bar; b.x = xb_xcc_id(); b.st = st;
    if (threadIdx.x == 0) (void)xb_add(&bar[XB_XCNT(b.x)], 1u);
    return b;
}
__device__ __forceinline__ void xcd_barrier_complete(unsigned* bar, unsigned x, unsigned& nloc, unsigned& nx) {
    const unsigned G = gridDim.x * gridDim.y * gridDim.z;
    unsigned sum, cnt, mine, sp = 0u;
    for (;;) {
        sum = 0u; cnt = 0u; mine = 0u;
#pragma unroll
        for (unsigned j = 0; j < 16; ++j) { const unsigned c = xb_ld(&bar[XB_XCNT(j)]); sum += c; cnt += (c > 0u) ? 1u : 0u; mine = (j == x) ? c : mine; }
        if (sum == G) break;
        __builtin_amdgcn_s_sleep(1);
        if ((++sp & 255u) == 0u) { if (xb_ld(&bar[XB_TMO])) break; if (sp > XB_SPIN_CAP) { atomicAdd(&bar[XB_TMO], 1u); break; } }
    }
    nloc = mine > 0u ? mine : 1u; nx = cnt > 0u ? cnt : 1u;
}

__device__ __forceinline__ void xcd_barrier(const XcdBarrier& b) {
    asm volatile("s_waitcnt vmcnt(0)" ::: "memory");
    __syncthreads();
    if (threadIdx.x == 0) {
        unsigned* bar = b.bar;
        __builtin_amdgcn_s_waitcnt(0);
        unsigned nloc = b.st[0], nx = b.st[1];
        if (nloc == 0u) { xcd_barrier_complete(bar, b.x, nloc, nx); b.st[0] = nloc; b.st[1] = nx; }
        const unsigned old = xb_add(&bar[XB_XSUB(b.x)], 1u);
        const unsigned gen = old / nloc;
        if (old + 1u == (gen + 1u) * nloc) {
            __builtin_amdgcn_fence(__ATOMIC_RELEASE, "agent");
            asm volatile("s_waitcnt vmcnt(0)" ::: "memory");
            const unsigned og = xb_add(&bar[XB_TOP], 1u);
            const unsigned tg = og / nx;
            if (og + 1u == (tg + 1u) * nx) xb_add(&bar[XB_TOPGEN], 1u);
            else XB_SPIN(xb_ld(&bar[XB_TOPGEN]) == tg, bar);
            __builtin_amdgcn_fence(__ATOMIC_ACQUIRE, "agent");
            xb_add(&bar[XB_XGEN(b.x)], 1u);
            asm volatile("s_waitcnt vmcnt(0)" ::: "memory");
        } else {
            XB_SPIN(xb_ld(&bar[XB_XGEN(b.x)]) == gen, bar);
            __builtin_amdgcn_fence(__ATOMIC_ACQUIRE, "agent");
            asm volatile("s_waitcnt vmcnt(0)" ::: "memory");
        }
    }
    __syncthreads();
}


struct Args { const float* in[11]; float* out; unsigned char* ws; int ph_lo, ph_hi; };
#define DERIVE_PTRS \
    int tid = threadIdx.x; asm volatile("" : "+v"(tid)); const int lane = tid & 63, wave = __builtin_amdgcn_readfirstlane(tid >> 6); \
    int G = gridDim.x, bx = blockIdx.x; asm volatile("" : "+s"(G), "+s"(bx)); \
    const int gw = bx * 8 + wave, NGW = G * 8; \
    unsigned char* ws = args.ws; asm volatile("" : "+s"(ws)); \
    const float* x0 = args.in[0]; const float* pre_norm = args.in[1]; const float* post_norm = args.in[2]; const float* sink_logits = args.in[4]; \
    const float* hlb = args.in[5]; const float* hnorm = args.in[6]; float* outp = args.out; \
    asm volatile("" : "+s"(x0), "+s"(pre_norm), "+s"(post_norm), "+s"(sink_logits), "+s"(hlb), "+s"(hnorm), "+s"(outp)); \
    float2* rope = (float2*)(ws + WS_ROPE); float* lse = (float*)(ws + WS_LSE); float* LB = (float*)(ws + WS_LB); float* LSUM = (float*)(ws + WS_LSUM); \
    bf16_t* WinT = (bf16_t*)(ws + WS_WIN); bf16_t* WaT = (bf16_t*)(ws + WS_WA); bf16_t* WbT = (bf16_t*)(ws + WS_WB); bf16_t* WcT = (bf16_t*)(ws + WS_WC); bf16_t* WoT = (bf16_t*)(ws + WS_WO); \
    bf16_t* XN = (bf16_t*)(ws + WS_XN); bf16_t* Ya = (bf16_t*)(ws + WS_YA); bf16_t* Yb = (bf16_t*)(ws + WS_YB); bf16_t* Yc = (bf16_t*)(ws + WS_YC); \
    float* SUM = (float*)(ws + WS_SUM); bf16_t* P = (bf16_t*)(ws + WS_P); bf16_t* Gm = (bf16_t*)(ws + WS_G); bf16_t* YM = (bf16_t*)(ws + WS_YM); float* OUT = (float*)(ws + WS_OUT); \
    (void)tid; (void)lane; (void)gw; (void)NGW; (void)x0; (void)pre_norm; (void)post_norm; (void)sink_logits; (void)hlb; (void)hnorm; (void)outp; (void)rope; (void)lse; (void)LB; (void)LSUM; \
    (void)WinT; (void)WaT; (void)WbT; (void)WcT; (void)WoT; (void)XN; (void)Ya; (void)Yb; (void)Yc; (void)SUM; (void)P; (void)Gm; (void)YM; (void)OUT;
#ifndef REPEAT_MASK
#define REPEAT_MASK 0
#endif
#define NREP(j) (1 + ((REPEAT_MASK >> (j)) & 1))
#define IN(k) (args.ph_lo <= (k) && (k) < args.ph_hi)
#define XB_ST_OFF (LDS_BYTES - 64)
#ifdef PROBE_TS
#define STAMP(k) do { if (blockIdx.x == 0 && threadIdx.x == 0) ((unsigned long long*)(args.ws + 65536))[k] = __builtin_amdgcn_s_memrealtime(); } while (0)
#else
#define STAMP(k) do { } while (0)
#endif
#define GRID_SYNC(k) do { if (IN(k) && IN((k) + 1)) { if ((k) == 0) cg::this_grid().sync(); else { XcdBarrier xb_; xb_.bar = (unsigned*)args.ws; xb_.x = xb_xcc_id(); xb_.st = (volatile LAS unsigned*)(lds + XB_ST_OFF); xcd_barrier(xb_); } } STAMP((k) + 1); } while (0)
template <int layer> __device__ __forceinline__ void run_layer(const Args& args, LAS unsigned char* lds) {
#ifndef SKIP_P1
        for (int rep = 0; rep < NREP(0); ++rep) if (IN(1 + 8 * layer + 0)) { DERIVE_PTRS pg8::Gemm g{XN, WinT, T, PC, D}; pg8::StaticOrder So; So.init(T, PC, G, bx); EpiStoreRope E{P, PC};
          pg8::gemm_phase<EpiStoreRope, pg8::StaticOrder, true, true>(lds, g, So, E); }
#endif
        GRID_SYNC(1 + 8 * layer + 0);
#ifndef SKIP_P2
        if (IN(1 + 8 * layer + 1)) { DERIVE_PTRS const float* lbL = LB + layer * 1024;
          for (int rep = 0; rep < NREP(8); ++rep) for (int u = bx; u < 512; u += G) { const int dir = u & 1, seg = (u >> 1) & 15, h = (u >> 5) & 7, b = u >> 8; hgrn_unit(b, h, seg, dir, 0, P, lbL, SUM, LSUM, lds, tid); }
          __syncthreads();
          const int vb = (G % 8 == 0) ? (bx % 8) * (G / 8) + bx / 8 : bx;
          attnA_phase(P, lse, lds, tid, vb, G);
          for (int rep = 0; rep < NREP(9); ++rep) attnB_phase(P, Yb, sink_logits + layer * 8, lds, tid, vb, G); }
#endif
        GRID_SYNC(1 + 8 * layer + 1);
#ifndef SKIP_P3
        if (IN(1 + 8 * layer + 2)) { DERIVE_PTRS const int vb3 = (G % 8 == 0) ? (bx % 8) * (G / 8) + bx / 8 : bx;
            for (int u = vb3; u < 256; u += G) hgrn_full_unit(u, P, LB + layer * 1024, hnorm + layer * 1024, SUM, LSUM, Yc, lds, tid); }
#endif
        GRID_SYNC(1 + 8 * layer + 2);
#ifndef SKIP_P4
        if (IN(1 + 8 * layer + 3)) { DERIVE_PTRS pg8::Gemm g{XN, WinT + (size_t)PC * D, T, NGATE, D}; pg8::StaticOrder So; So.init(T, NGATE, G, bx); EpiGate E{Ya, Yb, Yc, P, lse};
          pg8::gemm_phase<EpiGate, pg8::StaticOrder, true, true>(lds, g, So, E); }
#endif
#if defined(MULTI_LAUNCH) || defined(PROBE_PHASES)
        GRID_SYNC(1 + 8 * layer + 3);
#endif
#ifndef SKIP_P5
        for (int rep = 0; rep < NREP(4); ++rep) if (IN(1 + 8 * layer + 4)) { DERIVE_PTRS pg8::Gemm g{(const bf16_t*)(ws + WS_XN8), (const bf16_t*)(ws + WS_WM8), T, NMERGE, D}; pg8::StaticOrder So; So.init(T, NMERGE, G, bx); EpiSigmoidI8 E{(unsigned char*)Gm, G_PITCH, 1.0f / (Q_SX * Q_SW)};
          pg8::gemm_phase<EpiSigmoidI8, pg8::StaticOrder, true, true, 1>(lds, g, So, E); }
#endif
        GRID_SYNC(1 + 8 * layer + 4);
#ifndef SKIP_P6
        for (int rep = 0; rep < NREP(5); ++rep) if (IN(1 + 8 * layer + 5)) { DERIVE_PTRS pg8::StaticOrder So; So.init(T, D, G, bx);
          { pg8::Gemm g{Ya, WaT, T, D, 512}; EpiBranch<true> E{YM, (const unsigned char*)Gm, 0}; pg8::gemm_phase<EpiBranch<true>, pg8::StaticOrder, true, true>(lds, g, So, E); }
          { pg8::Gemm g{Yb, WbT, T, D, 1024}; EpiBranch<false> E{YM, (const unsigned char*)Gm, 1}; pg8::gemm_phase<EpiBranch<false>, pg8::StaticOrder, true, true>(lds, g, So, E); }
          { pg8::Gemm g{Yc, WcT, T, D, 1024}; EpiBranch<false> E{YM, (const unsigned char*)Gm, 2}; pg8::gemm_phase<EpiBranch<false>, pg8::StaticOrder, true, true>(lds, g, So, E); } }
#endif
        GRID_SYNC(1 + 8 * layer + 5);
#ifndef SKIP_P7
        for (int rep = 0; rep < NREP(6); ++rep) if (IN(1 + 8 * layer + 6)) { DERIVE_PTRS pg8::Gemm g{YM, WoT, T, D, D}; pg8::StaticOrder So; So.init(T, D, G, bx); EpiStoreBf16 E{(bf16_t*)OUT, D};
          pg8::gemm_phase<EpiStoreBf16, pg8::StaticOrder, true, true>(lds, g, So, E); }
#endif
        GRID_SYNC(1 + 8 * layer + 6);
        for (int rep8 = 0; rep8 < (layer == 0 ? NREP(11) : 1); ++rep8) if (IN(1 + 8 * layer + 7)) { DERIVE_PTRS const float* xold = layer == 0 ? x0 : outp;
          for (int m = gw; m < T; m += 2 * NGW) { const int m2 = (m + NGW < T) ? m + NGW : m;
              const bf16_t* const orow[2] = {(const bf16_t*)OUT + (size_t)m * D, (const bf16_t*)OUT + (size_t)m2 * D};
              const float* const xo[2] = {xold + (size_t)m * D, xold + (size_t)m2 * D}; float* const xn[2] = {outp + (size_t)m * D, outp + (size_t)m2 * D};
              bf16_t* const xq[2] = {XN + (size_t)m * D, XN + (size_t)m2 * D}; unsigned* const xq8[2] = {(unsigned*)(ws + WS_XN8) + (size_t)m * (D / 4), (unsigned*)(ws + WS_XN8) + (size_t)m2 * (D / 4)};
              final_rows<2>(orow, post_norm + layer * D, xo, xn, layer == 0 ? pre_norm + D : nullptr, xq, xq8, lane); }
          if (layer == 0) { Weights Wt{args.in[3] + (size_t)D * NIN, args.in[7] + (size_t)512 * D, args.in[8] + (size_t)1024 * D, args.in[9] + (size_t)1024 * D, args.in[10] + (size_t)D * D};
              __syncthreads(); transpose_weights(Wt, ws, lds, gw, NGW, wave, lane); GRID_SYNC(1 + 8 * layer + 7); } }
}
__global__ void __launch_bounds__(NTHREADS, 2) fwd_megakernel(Args args) {
    extern __shared__ __attribute__((aligned(16))) unsigned char lds_raw[];
    LAS unsigned char* lds = (LAS unsigned char*)lds_raw;
    if (threadIdx.x < 16) ((LAS unsigned*)(lds + XB_ST_OFF))[threadIdx.x] = 0u;
    __syncthreads();
    if (args.ph_hi - args.ph_lo > 1 && blockIdx.x == 0) { for (int i = threadIdx.x; i < XCD_BAR_WORDS; i += NTHREADS) ((unsigned*)args.ws)[i] = 0u; }
    STAMP(0);
    for (int rep0 = 0; rep0 < NREP(10); ++rep0) if (IN(0)) { DERIVE_PTRS
    for (int i = bx * NTHREADS + tid; i < 1024; i += G * NTHREADS) { const float h0 = hlb[i], h1 = hlb[1024 + i]; const float mx = fmaxf(h0, h1);
        const float e0 = expf(h0 - mx), e1 = expf(h1 - mx); LB[i] = 0.f; LB[1024 + i] = e1 / (e0 + e1); }
    { Weights Wt{args.in[3], args.in[7], args.in[8], args.in[9], args.in[10]}; transpose_weights(Wt, ws, lds, gw, NGW, wave, lane); }
    for (int m = gw; m < T; m += NGW) prenorm_row(x0 + (size_t)m * D, pre_norm, XN + (size_t)m * D, (unsigned*)(ws + WS_XN8) + (size_t)m * (D / 4), lane);
    }
    GRID_SYNC(0);
    if (args.ph_hi - args.ph_lo > 1) (void)xcd_barrier_post((unsigned*)args.ws, (volatile LAS unsigned*)(lds + XB_ST_OFF));

    run_layer<0>(args, lds);
#if NLAYER > 1
    run_layer<1>(args, lds);
#endif
#ifdef PROBE_TS
    STAMP(17);
    if (blockIdx.x == 0 && threadIdx.x == 0) { const unsigned long long* ts = (const unsigned long long*)(args.ws + 65536); const float dus_ = 0.01f * (float)(ts[PROBE_TS + 1] - ts[PROBE_TS]); args.out[0] = 1000.0f * floorf(dus_ / (float)PROBE_BUCKET) + 1000.0f; }
#endif
}

__global__ void dump_bf16(const bf16_t* src, size_t pitch, float* out) {
    const size_t i = (size_t)blockIdx.x * blockDim.x + threadIdx.x; const size_t r = i / 2048, c = i % 2048;
    out[i] = bf2f(src[r * pitch + c]);
}
__global__ void dump_f32(const float* src, float* out) { const size_t i = (size_t)blockIdx.x * blockDim.x + threadIdx.x; out[i] = src[i]; }
__global__ void dump_mix(const unsigned char* ws, float* out) {
    const size_t i = (size_t)blockIdx.x * blockDim.x + threadIdx.x; const size_t r = i / 2048, c = i % 2048;
    const bf16_t* P = (const bf16_t*)(ws + WS_P); const bf16_t* Yb = (const bf16_t*)(ws + WS_YB); const bf16_t* Yc = (const bf16_t*)(ws + WS_YC); const float* SUM = (const float*)(ws + WS_SUM); const float* lse = (const float*)(ws + WS_LSE);
    float v = 0.f;
#if PROBE_SEL & 1
    v += bf2f(P[r * PC + c]);
#endif
#if PROBE_SEL & 2
    v += bf2f(Yb[r * 1024 + (c & 1023)]);
#endif
#if PROBE_SEL & 4
    v += SUM[i % ((size_t)512 * 16384)];
#endif
#if PROBE_SEL & 8
    v += lse[i % ((size_t)3 * T * 4)];
#endif
#if PROBE_SEL & 16
    v += bf2f(Yc[r * 1024 + (c & 1023)]);
#endif
#if PROBE_SEL & 32
    v += bf2f(P[r * PC + PC_FF + (c & 1023)]);
#endif
#if PROBE_SEL & 64
    v += bf2f(P[r * PC + PC_FB + (c & 1023)]);
#endif
    if (!(v == v) || fabsf(v) > 1e30f) v = 12345.f;
    out[i] = v;
}
extern "C" void kernel_launch(void* const* d_in, const int* in_sizes, int n_in, void* d_out, int out_size, void* d_ws, size_t ws_size, hipStream_t stream) {
    static int grid = 0;
    if (grid == 0) {
        if (n_in != 11 || ws_size < WS_END8) { fprintf(stderr, "kernel_launch: unexpected inputs (n_in %d, ws %zu)\n", n_in, ws_size); grid = -1; return; }
        int dev = 0, cus = 0, per_cu = 0;
        hipGetDevice(&dev); hipDeviceGetAttribute(&cus, hipDeviceAttributeMultiprocessorCount, dev);
        hipFuncSetAttribute((const void*)fwd_megakernel, hipFuncAttributeMaxDynamicSharedMemorySize, LDS_BYTES);
        hipOccupancyMaxActiveBlocksPerMultiprocessor(&per_cu, (const void*)fwd_megakernel, NTHREADS, LDS_BYTES);
        if (per_cu < 1) per_cu = 1;
        grid = cus * per_cu;
    }
    if (grid < 0) return;
    Args a{};
    for (int i = 0; i < 11; ++i) a.in[i] = (const float*)d_in[i];
    a.out = (float*)d_out; a.ws = (unsigned char*)d_ws;
#ifdef PROBE_PHASES
    for (int ph = 0; ph < PROBE_PHASES; ++ph) { a.ph_lo = ph; a.ph_hi = ph + 1; hipLaunchKernelGGL(fwd_megakernel, dim3(grid), dim3(NTHREADS), LDS_BYTES, stream, a); }
    PROBE_DUMP
#elif defined(MULTI_LAUNCH)
    for (int ph = 0; ph < 17; ++ph) { a.ph_lo = ph; a.ph_hi = ph + 1; hipLaunchKernelGGL(fwd_megakernel, dim3(grid), dim3(NTHREADS), LDS_BYTES, stream, a); }
#else
    static bool per_phase = false;
    if (!per_phase) {
        a.ph_lo = 0; a.ph_hi = 17;
        void* kargs[] = {&a};
        hipError_t e = hipLaunchCooperativeKernel((const void*)fwd_megakernel, dim3(grid), dim3(NTHREADS), kargs, LDS_BYTES, stream);
        if (e != hipSuccess) { fprintf(stderr, "cooperative launch failed: %s (grid %d); falling back to one launch per phase\n", hipGetErrorString(e), grid); (void)hipGetLastError(); per_phase = true; }
    }
    if (per_phase) for (int ph = 0; ph < 17; ++ph) { a.ph_lo = ph; a.ph_hi = ph + 1; hipLaunchKernelGGL(fwd_megakernel, dim3(grid), dim3(NTHREADS), LDS_BYTES, stream, a); }
#endif
}
```

```cpp
#include <hip/hip_runtime.h>
#include <hip/hip_cooperative_groups.h>
#include <cstdio>
#include <cstdint>
namespace cg = cooperative_groups;
namespace pg8 {
#define PG8_LAS __attribute__((address_space(3)))
typedef unsigned short bf16_t;
typedef short bf16x8 __attribute__((ext_vector_type(8)));
typedef float f32x4 __attribute__((ext_vector_type(4)));
typedef unsigned u32x4 __attribute__((ext_vector_type(4)));
constexpr int BM = 256, BK = 64, HALF = 128, HTB = HALF * BK * 2  , STAGE_BYTES = 8 * HTB, NXCD = 8, WGM = 8;

__host__ __device__ __forceinline__ int lds_byte(int r, int c) { const int st = (r >> 4) * 2 + (c >> 5), rr = r & 15, cc = c & 31, ob = rr * 64 + cc * 2; return st * 1024 + (ob ^ (((ob >> 9) & 1) << 5)); }
__host__ __device__ __forceinline__ void stage_rc(int b, int& R, int& C) { const int st = b / 1024, sb = b % 1024, swz = sb ^ (((sb >> 9) & 1) << 5); R = (st >> 1) * 16 + swz / 64; C = (st & 1) * 32 + (swz % 64) / 2; }
__host__ __device__ __forceinline__ int perm32(int rho) { const int n = rho >> 4, i = rho & 15; return 8 * (i >> 2) + 4 * n + (i & 3); }

struct Unit { int pm, pn; };
struct Gemm { const bf16_t* A; const bf16_t* Bt; int M, N, K; };

struct StaticOrder {
    int nM, nN, nwg, G, c;
    __host__ __device__ void init(int M, int N, int G_, int c_) { nM = M / BM; nN = N / BM; nwg = nM * nN; G = G_; c = c_; }
    __host__ __device__ bool next(int i, Unit& u) const {
        const long L = (long)i * G + c; if (L >= nwg) return false;
        int wgid = (int)L; { const int q = nwg / NXCD, r = nwg % NXCD, xcd = wgid % NXCD, off = wgid / NXCD; wgid = (xcd < r ? xcd * (q + 1) : r * (q + 1) + (xcd - r) * q) + off; }
        const int nig = WGM * nN, gid = wgid / nig, fm = gid * WGM, gsz = (nM - fm) < WGM ? (nM - fm) : WGM;
        u.pm = fm + ((wgid % nig) % gsz); u.pn = (wgid % nig) / gsz; return true;
    }
    __device__ __forceinline__ void a_ready(const Unit&) const {}
    __device__ __forceinline__ void done(const Unit&) const {}
};

__device__ __forceinline__ unsigned cvt_pk_bf16(float lo, float hi) { unsigned r; asm volatile("v_cvt_pk_bf16_f32 %0, %1, %2" : "=v"(r) : "v"(lo), "v"(hi)); return r; }
typedef int i32x4 __attribute__((ext_vector_type(4)));
template <int ES> __device__ __forceinline__ f32x4 pg8_mma(bf16x8 a, bf16x8 b, f32x4 c) {
    if constexpr (ES == 2) return __builtin_amdgcn_mfma_f32_16x16x32_bf16(a, b, c, 0, 0, 0);
    else return __builtin_bit_cast(f32x4, __builtin_amdgcn_mfma_i32_16x16x64_i8(__builtin_bit_cast(i32x4, a), __builtin_bit_cast(i32x4, b), __builtin_bit_cast(i32x4, c), 0, 0, 0));
}
template <class Epi, class Sched, bool ALIGN_EPI = false, bool SP2 = false, int ES = 2>
__device__ __forceinline__ void gemm_phase(PG8_LAS unsigned char* lds, const Gemm g, const Sched& S, const Epi& E) {
    int tid = threadIdx.x; asm volatile("" : "+v"(tid));
    const int wid = __builtin_amdgcn_readfirstlane(tid >> 6), lane = tid & 63, wr = wid >> 2, wc = wid & 3, fr = lane & 15, fq = lane >> 4;
    const int K = g.K, nt = (K * ES) / (BK * 2);
    unsigned voffA[2], voffB[2];
#pragma unroll
    for (int i = 0; i < 2; ++i) { int R, C; stage_rc(tid * 16 + i * 8192, R, C); const int Rb = Epi::PERM ? ((R & ~31) + perm32(R & 31)) : R;
        voffA[i] = (unsigned)(R * K * ES + C * 2); voffB[i] = (unsigned)(Rb * K * ES + C * 2); }
    const size_t kstep = (size_t)(BK * 2);
    const size_t hstep = (size_t)HALF * K * ES;
    const size_t tstep = 2 * hstep;
    const unsigned ldsw = (unsigned)wid * 1024u;
    const int aoff = lds_byte(wr * 64 + fr, fq * 8), boff = lds_byte(wc * 32 + fr, fq * 8);
#define PG8_SA(b, h) (((b) * 2 + (h)) * HTB)
#define PG8_SB(b, h) ((4 + (b) * 2 + (h)) * HTB)
#define PG8_STAGE(bufoff, gbase, voff) do { _Pragma("unroll") for (int _i = 0; _i < 2; ++_i) \
        __builtin_amdgcn_global_load_lds((const unsigned*)((const char*)(gbase) + (voff)[_i]), (PG8_LAS unsigned*)(lds + (bufoff) + ldsw + _i * 8192), 16, 0, 0); } while (0)
#define PG8_LDA(dst, b, h) do { _Pragma("unroll") for (int m = 0; m < 4; ++m) _Pragma("unroll") for (int k = 0; k < 2; ++k) dst[m][k] = *(const PG8_LAS bf16x8*)(lds + PG8_SA(b, h) + aoff + m * 2048 + k * 1024); } while (0)
#define PG8_LDB(dst, b, h) do { _Pragma("unroll") for (int n = 0; n < 2; ++n) _Pragma("unroll") for (int k = 0; k < 2; ++k) dst[n][k] = *(const PG8_LAS bf16x8*)(lds + PG8_SB(b, h) + boff + n * 2048 + k * 1024); } while (0)
#define PG8_MMA(ai, bj, At, Bt) do { __builtin_amdgcn_s_setprio(1); _Pragma("unroll") for (int m = 0; m < 4; ++m) _Pragma("unroll") for (int n = 0; n < 2; ++n) _Pragma("unroll") for (int k = 0; k < 2; ++k) \
        acc[ai][bj][m][n] = pg8_mma<ES>(Bt[n][k], At[m][k], acc[ai][bj][m][n]); __builtin_amdgcn_s_setprio(0); } while (0)
#define PG8_WAIT_V(n) asm volatile("s_waitcnt vmcnt(" #n ")" ::: "memory")
#define PG8_WAIT_L(n) asm volatile("s_waitcnt lgkmcnt(" #n ")" ::: "memory")
#define PG8_BAR __builtin_amdgcn_s_barrier()
#define PG8_SCHED __builtin_amdgcn_sched_barrier(0)
    Unit cur, nxt; int ui = 0;
    if (!S.next(0, cur)) return;
    f32x4 acc[2][2][4][2];
#pragma unroll
    for (int a = 0; a < 2; ++a)
#pragma unroll
        for (int b = 0; b < 2; ++b)
#pragma unroll
            for (int m = 0; m < 4; ++m)
#pragma unroll
                for (int n = 0; n < 2; ++n) acc[a][b][m][n] = (f32x4){0.f, 0.f, 0.f, 0.f};
    bf16x8 At[4][2], B0[2][2], B1[2][2];
    const char* cA = (const char*)g.A + (size_t)cur.pm * tstep; const char* cB = (const char*)g.Bt + (size_t)cur.pn * tstep;
    S.a_ready(cur);
    if constexpr (SP2) {
        PG8_STAGE(PG8_SB(0, 0), cB, voffB); PG8_STAGE(PG8_SB(0, 1), cB + hstep, voffB); PG8_STAGE(PG8_SA(0, 0), cA, voffA); PG8_STAGE(PG8_SA(0, 1), cA + hstep, voffA);
        if (wr == 1) PG8_BAR;
        PG8_WAIT_V(2); PG8_BAR;
        PG8_STAGE(PG8_SB(1, 0), cB + kstep, voffB); PG8_STAGE(PG8_SA(1, 0), cA + kstep, voffA); PG8_STAGE(PG8_SB(1, 1), cB + hstep + kstep, voffB);
        PG8_WAIT_V(6); PG8_BAR;
    } else {
        PG8_STAGE(PG8_SB(0, 0), cB, voffB); PG8_STAGE(PG8_SA(0, 0), cA, voffA); PG8_STAGE(PG8_SB(0, 1), cB + hstep, voffB); PG8_STAGE(PG8_SA(0, 1), cA + hstep, voffA);
        if (wr == 1) PG8_BAR;
        PG8_WAIT_V(4); PG8_BAR;
        PG8_STAGE(PG8_SB(1, 0), cB + kstep, voffB); PG8_STAGE(PG8_SA(1, 0), cA + kstep, voffA); PG8_STAGE(PG8_SB(1, 1), cB + hstep + kstep, voffB);
        PG8_WAIT_V(6); PG8_BAR;
    }
    for (;;) {
        const bool has_next = S.next(ui + 1, nxt);
        const char* nA = has_next ? (const char*)g.A + (size_t)nxt.pm * tstep : cA; const char* nB = has_next ? (const char*)g.Bt + (size_t)nxt.pn * tstep : cB;
        for (int t = 0; t < nt; t += 2) {
            const bool last = (t == nt - 2);
            const char* a1 = cA + (size_t)(t + 1) * kstep;
            const char* a2 = last ? nA : cA + (size_t)(t + 2) * kstep; const char* b2 = last ? nB : cB + (size_t)(t + 2) * kstep;
            const char* a3 = a2 + kstep; const char* b3 = b2 + kstep;
            if (last && has_next) S.a_ready(nxt);
            if constexpr (SP2) {
            PG8_LDB(B0, 0, 0); PG8_LDB(B1, 0, 1); PG8_SCHED; PG8_LDA(At, 0, 0); PG8_STAGE(PG8_SA(1, 1), a1 + hstep, voffA);
            PG8_WAIT_V(8); PG8_WAIT_L(0); PG8_BAR; PG8_MMA(0, 0, At, B0); PG8_MMA(0, 1, At, B1); PG8_BAR; PG8_SCHED;
            PG8_LDA(At, 0, 1); PG8_STAGE(PG8_SB(0, 0), b2, voffB); PG8_STAGE(PG8_SB(0, 1), b2 + hstep, voffB); PG8_STAGE(PG8_SA(0, 0), a2, voffA);
            PG8_WAIT_V(8); PG8_WAIT_L(0); PG8_BAR; PG8_MMA(1, 0, At, B0); PG8_MMA(1, 1, At, B1); PG8_BAR; PG8_SCHED;
            PG8_LDB(B0, 1, 0); PG8_LDB(B1, 1, 1); PG8_SCHED; PG8_LDA(At, 1, 0); PG8_STAGE(PG8_SA(0, 1), a2 + hstep, voffA);
            PG8_WAIT_V(8); PG8_WAIT_L(0); PG8_BAR; PG8_MMA(0, 0, At, B0); PG8_MMA(0, 1, At, B1); PG8_BAR; PG8_SCHED;
            PG8_LDA(At, 1, 1); PG8_STAGE(PG8_SB(1, 0), b3, voffB); PG8_STAGE(PG8_SB(1, 1), b3 + hstep, voffB); PG8_STAGE(PG8_SA(1, 0), a3, voffA);
            PG8_WAIT_V(8); PG8_WAIT_L(0); PG8_BAR; PG8_MMA(1, 0, At, B0); PG8_MMA(1, 1, At, B1); PG8_BAR; PG8_SCHED;
            } else {
            PG8_LDB(B0, 0, 0); PG8_SCHED; PG8_LDA(At, 0, 0); PG8_STAGE(PG8_SA(1, 1), a1 + hstep, voffA);
            PG8_WAIT_L(8); PG8_BAR; PG8_WAIT_L(0); PG8_MMA(0, 0, At, B0); PG8_BAR; PG8_SCHED;
            PG8_LDB(B1, 0, 1); PG8_STAGE(PG8_SB(0, 0), b2, voffB);
            PG8_BAR; PG8_WAIT_L(0); PG8_MMA(0, 1, At, B1); PG8_BAR;
            PG8_LDA(At, 0, 1); PG8_STAGE(PG8_SA(0, 0), a2, voffA);
            PG8_BAR; PG8_WAIT_L(0); PG8_MMA(1, 0, At, B0); PG8_BAR; PG8_SCHED;
            PG8_STAGE(PG8_SB(0, 1), b2 + hstep, voffB);
            PG8_WAIT_V(6); PG8_BAR; PG8_MMA(1, 1, At, B1); PG8_BAR;
            PG8_LDB(B0, 1, 0); PG8_SCHED; PG8_LDA(At, 1, 0); PG8_STAGE(PG8_SA(0, 1), a2 + hstep, voffA);
            PG8_WAIT_L(8); PG8_BAR; PG8_WAIT_L(0); PG8_MMA(0, 0, At, B0); PG8_BAR; PG8_SCHED;
            PG8_LDB(B1, 1, 1); PG8_STAGE(PG8_SB(1, 0), b3, voffB);
            PG8_BAR; PG8_WAIT_L(0); PG8_MMA(0, 1, At, B1); PG8_BAR;
            PG8_LDA(At, 1, 1); PG8_STAGE(PG8_SA(1, 0), a3, voffA);
            PG8_BAR; PG8_WAIT_L(0); PG8_MMA(1, 0, At, B0); PG8_BAR; PG8_SCHED;
            PG8_STAGE(PG8_SB(1, 1), b3 + hstep, voffB);
            PG8_WAIT_V(6); PG8_BAR; PG8_MMA(1, 1, At, B1); PG8_BAR;
            }
        }
        if constexpr (ALIGN_EPI) { if (wr == 0) PG8_BAR; }
        if constexpr (!Epi::AFTER_DRAIN) { E(acc, cur, wr, wc, fr, fq); S.done(cur); }
        if (!has_next) break;
#pragma unroll
        for (int a = 0; a < 2; ++a)
#pragma unroll
            for (int b = 0; b < 2; ++b)
#pragma unroll
                for (int m = 0; m < 4; ++m)
#pragma unroll
                    for (int n = 0; n < 2; ++n) acc[a][b][m][n] = (f32x4){0.f, 0.f, 0.f, 0.f};
        cur = nxt; cA = nA; cB = nB; ++ui;
        if constexpr (ALIGN_EPI) { if (wr == 1) PG8_BAR; }
    }
    PG8_WAIT_V(0);
    if constexpr (!ALIGN_EPI) { if (wr == 0) PG8_BAR; }
    PG8_BAR;
    if constexpr (Epi::AFTER_DRAIN) { E.fused(acc, cur, wr, wc, fr, fq, lds, wid, lane); S.done(cur); }
#undef PG8_SA
#undef PG8_SB
#undef PG8_STAGE
#undef PG8_LDA
#undef PG8_LDB
#undef PG8_MMA
#undef PG8_WAIT_V
#undef PG8_WAIT_L
#undef PG8_BAR
#undef PG8_SCHED
}
}

#define LAS __attribute__((address_space(3)))
typedef unsigned short bf16_t;
typedef short bf16x8 __attribute__((ext_vector_type(8)));
typedef short bf16x4 __attribute__((ext_vector_type(4)));
typedef float f32x4 __attribute__((ext_vector_type(4)));
typedef unsigned u32x4 __attribute__((ext_vector_type(4)));
typedef unsigned u32x2 __attribute__((ext_vector_type(2)));

constexpr int T = 32768, S = 16384, D = 2048;
constexpr int PC = 10240;
constexpr int NGATE = 2560, NMERGE = 6144, NIN = 18944;
constexpr int PA_Q = 0, PA_K = 1536, PA_V = 3072, PB_Q = 4608, PB_K = 5632, PB_V = 5888, PC_Q = 6144, PC_FF = 7168, PC_FB = 8192, PC_I = 9216;
constexpr float NORM_EPS = 1e-6f;
constexpr size_t MiB = 1u << 20;
constexpr size_t WS_ROPE = 1 * MiB, WS_LSE = 3 * MiB, WS_LB = 5 * MiB, WS_LSUM = 5 * MiB + 65536;
constexpr size_t WS_WIN = 6 * MiB, WS_WA = 80 * MiB, WS_WB = 82 * MiB, WS_WC = 86 * MiB, WS_WO = 90 * MiB;
constexpr size_t WS_XN = 98 * MiB, WS_YA = 226 * MiB, WS_YB = 258 * MiB, WS_YC = 322 * MiB, WS_SUM = 386 * MiB, WS_P = 418 * MiB, WS_END = 1058 * MiB;
constexpr size_t WS_G = WS_P + 3072, WS_YM = WS_XN, WS_OUT = WS_P;
constexpr int G_PITCH = PC * 2;
constexpr size_t WS_XN8 = 1058 * MiB, WS_WM8 = 1122 * MiB, WS_END8 = 1134 * MiB;
constexpr float Q_SX = 21.0f, Q_SW = 960.0f;
constexpr int LDS_BYTES = 163840;
constexpr int NTHREADS = 512;
#ifndef NLAYER
#define NLAYER 2
#endif

__device__ __forceinline__ float bf2f(unsigned short b) { return __builtin_bit_cast(float, (unsigned)b << 16); }
__device__ __forceinline__ float bf2f_s(short b) { return __builtin_bit_cast(float, ((unsigned)(unsigned short)b) << 16); }
typedef float f32x2_t __attribute__((ext_vector_type(2))); typedef __bf16 bf16x2_t __attribute__((ext_vector_type(2)));
__device__ __forceinline__ unsigned pk2(float lo, float hi) { f32x2_t v = {lo, hi}; bf16x2_t b = __builtin_convertvector(v, bf16x2_t); return __builtin_bit_cast(unsigned, b); }
__device__ __forceinline__ float wave_sum(float v) {
#pragma unroll
    for (int o = 1; o < 64; o <<= 1) v += __shfl_xor(v, o);
    return v;
}
__device__ __forceinline__ f32x4 mfma16(bf16x8 a, bf16x8 b, f32x4 c) { return __builtin_amdgcn_mfma_f32_16x16x32_bf16(a, b, c, 0, 0, 0); }
__device__ __forceinline__ float fast_sigmoid(float x) { return __builtin_amdgcn_rcpf(1.0f + __expf(-x)); }

__device__ __forceinline__ unsigned q8x4(float a, float b, float c, float d, float sc) {
    const int ia = __builtin_amdgcn_fmed3f(rintf(a * sc), -127.f, 127.f), ib = __builtin_amdgcn_fmed3f(rintf(b * sc), -127.f, 127.f);
    const int ic = __builtin_amdgcn_fmed3f(rintf(c * sc), -127.f, 127.f), id = __builtin_amdgcn_fmed3f(rintf(d * sc), -127.f, 127.f);
    return (unsigned)(ia & 0xff) | ((unsigned)(ib & 0xff) << 8) | ((unsigned)(ic & 0xff) << 16) | ((unsigned)(id & 0xff) << 24);
}
__device__ __forceinline__ void transpose_item(const float* W, int K, int N, bf16_t* WT, int drow, LAS float* scr, int k0, int n0, int lane, signed char* WT8 = nullptr) {
#pragma unroll
    for (int i = 0; i < 32; ++i) { const int kk = 2 * i + (lane >> 5); scr[kk * 33 + (lane & 31)] = W[(size_t)(k0 + kk) * N + n0 + (lane & 31)]; }
    asm volatile("s_waitcnt lgkmcnt(0)" ::: "memory");
    const int c = lane & 7;
#pragma unroll
    for (int j = 0; j < 4; ++j) { const int n = (lane >> 3) + 8 * j; const LAS float* s = scr + (8 * c) * 33 + n;
        u32x4 o; o.x = pk2(s[0 * 33], s[1 * 33]); o.y = pk2(s[2 * 33], s[3 * 33]); o.z = pk2(s[4 * 33], s[5 * 33]); o.w = pk2(s[6 * 33], s[7 * 33]);
        *(u32x4*)(WT + (size_t)(drow + n) * K + k0 + 8 * c) = o;
        if (WT8) { u32x2 q; q.x = q8x4(s[0 * 33], s[1 * 33], s[2 * 33], s[3 * 33], Q_SW); q.y = q8x4(s[4 * 33], s[5 * 33], s[6 * 33], s[7 * 33], Q_SW); *(u32x2*)(WT8 + (size_t)(drow - 12800 + n) * K + k0 + 8 * c) = q; } }
    asm volatile("s_waitcnt lgkmcnt(0)" ::: "memory");
}
__device__ __forceinline__ int win_dst(int n) {
    if (n < 4608) return n;
    if (n < 5120) return 10240 + (n - 4608);
    if (n < 6656) return 4608 + (n - 5120);
    if (n < 7680) return 10240 + 512 + (n - 6656);
    if (n < 11776) return 6144 + (n - 7680);
    if (n < 12800) return 10240 + 1536 + (n - 11776);
    return n;
}
struct Weights { const float *win, *wa, *wb, *wc, *wo; };
__device__ __forceinline__ void transpose_weights(const Weights& Wt, unsigned char* ws, LAS unsigned char* lds, int gw, int NGW, int wave, int lane) {
    LAS float* scr = (LAS float*)(lds + wave * 8448);
    constexpr int I_IN = 32 * (NIN / 32), I_A = 8 * 64, I_B = 16 * 64, I_C = 16 * 64, I_O = 32 * 64;
    constexpr int NITEMS = I_IN + I_A + I_B + I_C + I_O;
    for (int it = gw; it < NITEMS; it += NGW) {
        int r = it;
        if (r < I_IN) { const int nb = r % (NIN / 32), kb = r / (NIN / 32); transpose_item(Wt.win, D, NIN, (bf16_t*)(ws + WS_WIN), win_dst(nb * 32), scr, kb * 64, nb * 32, lane, nb * 32 >= 12800 ? (signed char*)(ws + WS_WM8) : nullptr); continue; } r -= I_IN;
        if (r < I_A) { const int nb = r % 64, kb = r / 64; transpose_item(Wt.wa, 512, D, (bf16_t*)(ws + WS_WA), nb * 32, scr, kb * 64, nb * 32, lane); continue; } r -= I_A;
        if (r < I_B) { const int nb = r % 64, kb = r / 64; transpose_item(Wt.wb, 1024, D, (bf16_t*)(ws + WS_WB), nb * 32, scr, kb * 64, nb * 32, lane); continue; } r -= I_B;
        if (r < I_C) { const int nb = r % 64, kb = r / 64; transpose_item(Wt.wc, 1024, D, (bf16_t*)(ws + WS_WC), nb * 32, scr, kb * 64, nb * 32, lane); continue; } r -= I_C;
        { const int nb = r % 64, kb = r / 64; transpose_item(Wt.wo, D, D, (bf16_t*)(ws + WS_WO), nb * 32, scr, kb * 64, nb * 32, lane); }
    }
}
__device__ __forceinline__ void prenorm_row(const float* xrow, const float* gain, bf16_t* orow, unsigned* orow8, int lane) {
    f32x4 v[8]; float s = 0.f;
#pragma unroll
    for (int j = 0; j < 8; ++j) { v[j] = ((const f32x4*)xrow)[lane + 64 * j]; s += (v[j].x * v[j].x + v[j].y * v[j].y) + (v[j].z * v[j].z + v[j].w * v[j].w); }
    const float r = 1.0f / sqrtf(wave_sum(s) * (1.0f / D) + NORM_EPS);
#pragma unroll
    for (int j = 0; j < 8; ++j) { const f32x4 g = ((const f32x4*)gain)[lane + 64 * j]; const float a = v[j].x * r * g.x, b = v[j].y * r * g.y, c = v[j].z * r * g.z, d = v[j].w * r * g.w;
        u32x2 o; o.x = pk2(a, b); o.y = pk2(c, d); ((u32x2*)orow)[lane + 64 * j] = o; orow8[lane + 64 * j] = q8x4(a, b, c, d, Q_SX); }
}
template <int NR>
__device__ __forceinline__ void final_rows(const bf16_t* const (&orow)[NR], const float* post, const float* const (&xold)[NR], float* const (&xnew)[NR], const float* pre_next, bf16_t* const (&xn_next)[NR], unsigned* const (&xn8_next)[NR], int lane) {
    f32x4 v[NR][8], xo[NR][8]; float s[NR];
#pragma unroll
    for (int q = 0; q < NR; ++q) { s[q] = 0.f;
#pragma unroll
        for (int j = 0; j < 8; ++j) { const u32x2 r = ((const u32x2*)orow[q])[lane + 64 * j];
            v[q][j].x = __builtin_bit_cast(float, r.x << 16); v[q][j].y = __builtin_bit_cast(float, r.x & 0xffff0000u); v[q][j].z = __builtin_bit_cast(float, r.y << 16); v[q][j].w = __builtin_bit_cast(float, r.y & 0xffff0000u);
            s[q] += (v[q][j].x * v[q][j].x + v[q][j].y * v[q][j].y) + (v[q][j].z * v[q][j].z + v[q][j].w * v[q][j].w); }
#pragma unroll
        for (int j = 0; j < 8; ++j) xo[q][j] = ((const f32x4*)xold[q])[lane + 64 * j]; }
#pragma unroll
    for (int q = 0; q < NR; ++q) {
        const float r = 1.0f / sqrtf(wave_sum(s[q]) * (1.0f / D) + NORM_EPS);
        float s2 = 0.f;
#pragma unroll
        for (int j = 0; j < 8; ++j) { const f32x4 g = ((const f32x4*)post)[lane + 64 * j];
            f32x4 y; y.x = xo[q][j].x + v[q][j].x * r * g.x; y.y = xo[q][j].y + v[q][j].y * r * g.y; y.z = xo[q][j].z + v[q][j].z * r * g.z; y.w = xo[q][j].w + v[q][j].w * r * g.w;
            v[q][j] = y; s2 += (y.x * y.x + y.y * y.y) + (y.z * y.z + y.w * y.w); ((f32x4*)xnew[q])[lane + 64 * j] = y; }
        if (pre_next) {
            const float r2 = 1.0f / sqrtf(wave_sum(s2) * (1.0f / D) + NORM_EPS);
#pragma unroll
            for (int j = 0; j < 8; ++j) { const f32x4 g = ((const f32x4*)pre_next)[lane + 64 * j]; const float a = v[q][j].x * r2 * g.x, b = v[q][j].y * r2 * g.y, c = v[q][j].z * r2 * g.z, d = v[q][j].w * r2 * g.w;
                u32x2 o; o.x = pk2(a, b); o.y = pk2(c, d); ((u32x2*)xn_next[q])[lane + 64 * j] = o; xn8_next[q][lane + 64 * j] = q8x4(a, b, c, d, Q_SX); }
        }
    }
}

#define EPI_LOOP_BEGIN \
    const int row0 = u.pm * 256 + wr * 64 + fr; const int colb = u.pn * 256 + wc * 32 + 8 * fq; \
    _Pragma("unroll") for (int ai = 0; ai < 2; ++ai) _Pragma("unroll") for (int m = 0; m < 4; ++m) { const int row = row0 + ai * 128 + m * 16; \
    _Pragma("unroll") for (int bj = 0; bj < 2; ++bj) { const int col = colb + bj * 128; const f32x4 v0 = acc[ai][bj][m][0], v1 = acc[ai][bj][m][1];
#define EPI_LOOP_END } }

struct EpiStoreBf16 {
    static constexpr bool PERM = true, AFTER_DRAIN = false;
    bf16_t* O; int ldc;
    __device__ __forceinline__ void operator()(const f32x4 (&acc)[2][2][4][2], const pg8::Unit& u, int wr, int wc, int fr, int fq) const {
        EPI_LOOP_BEGIN
            u32x4 w; w.x = pk2(v0[0], v0[1]); w.y = pk2(v0[2], v0[3]); w.z = pk2(v1[0], v1[1]); w.w = pk2(v1[2], v1[3]);
            *(u32x4*)(O + (size_t)row * ldc + col) = w;
        EPI_LOOP_END
    }
};
struct EpiStoreRope {
    static constexpr bool PERM = true, AFTER_DRAIN = false;
    bf16_t* O; int ldc;
    __device__ __forceinline__ void operator()(const f32x4 (&acc)[2][2][4][2], const pg8::Unit& u, int wr, int wc, int fr, int fq) const {
        const bool rt = (wc == 0) && ((u.pn < 12) || (u.pn >= 18 && u.pn < 23));
        const float sgn = (fq < 2) ? -1.f : 1.f;
        const int row0 = u.pm * 256 + wr * 64 + fr; const int colb = u.pn * 256 + wc * 32 + 8 * fq;
        float irev[8];
        if (rt) {
#pragma unroll
            for (int i = 0; i < 8; ++i) irev[i] = __builtin_amdgcn_exp2f(-(float)((fq & 1) * 8 + i) * (18.931568569324174f / 16.0f) - 2.651496129472319f);
        }
#pragma unroll
        for (int ai = 0; ai < 2; ++ai)
#pragma unroll
            for (int m = 0; m < 4; ++m) { const int row = row0 + ai * 128 + m * 16;
                float cs[8], sn[8];
                if (rt) { const float pos = (float)(row & (S - 1));
#pragma unroll
                    for (int i = 0; i < 8; ++i) { const float fr_ = __builtin_amdgcn_fractf(pos * irev[i]); cs[i] = __builtin_amdgcn_cosf(fr_); sn[i] = sgn * __builtin_amdgcn_sinf(fr_); } }
#pragma unroll
                for (int bj = 0; bj < 2; ++bj) { const int col = colb + bj * 128; const f32x4 v0 = acc[ai][bj][m][0], v1 = acc[ai][bj][m][1];
                    float y[8] = {v0[0], v0[1], v0[2], v0[3], v1[0], v1[1], v1[2], v1[3]};
                    if (rt) {
#pragma unroll
                        for (int i = 0; i < 8; ++i) { const float pt = __shfl_xor(y[i], 32); y[i] = y[i] * cs[i] + pt * sn[i]; } }
                    if (u.pn >= 24 && u.pn < 28) {
#pragma unroll
                        for (int i = 0; i < 8; ++i) y[i] = y[i] * fast_sigmoid(y[i]); }
                    u32x4 w; w.x = pk2(y[0], y[1]); w.y = pk2(y[2], y[3]); w.z = pk2(y[4], y[5]); w.w = pk2(y[6], y[7]);
                    *(u32x4*)(O + (size_t)row * ldc + col) = w; } }
    }
};
struct EpiSigmoidBf16 {
    static constexpr bool PERM = true, AFTER_DRAIN = false;
    bf16_t* O; int ldc;
    __device__ __forceinline__ void operator()(const f32x4 (&acc)[2][2][4][2], const pg8::Unit& u, int wr, int wc, int fr, int fq) const {
        EPI_LOOP_BEGIN
            u32x4 w; w.x = pk2(fast_sigmoid(v0[0]), fast_sigmoid(v0[1])); w.y = pk2(fast_sigmoid(v0[2]), fast_sigmoid(v0[3]));
            w.z = pk2(fast_sigmoid(v1[0]), fast_sigmoid(v1[1])); w.w = pk2(fast_sigmoid(v1[2]), fast_sigmoid(v1[3]));
            *(u32x4*)(O + (size_t)row * ldc + col) = w;
        EPI_LOOP_END
    }
};
struct EpiSigmoidI8 {
    static constexpr bool PERM = true, AFTER_DRAIN = false;
    unsigned char* O; int ldc; float dq;
    __device__ __forceinline__ void operator()(const f32x4 (&acc)[2][2][4][2], const pg8::Unit& u, int wr, int wc, int fr, int fq) const {
        EPI_LOOP_BEGIN
            const pg8::i32x4 i0 = __builtin_bit_cast(pg8::i32x4, v0), i1 = __builtin_bit_cast(pg8::i32x4, v1);
            unsigned b[8];
#pragma unroll
            for (int i = 0; i < 4; ++i) { b[i] = (unsigned)(255.0f * fast_sigmoid((float)i0[i] * dq) + 0.5f); b[4 + i] = (unsigned)(255.0f * fast_sigmoid((float)i1[i] * dq) + 0.5f); }
            u32x2 w; w.x = b[0] | (b[1] << 8) | (b[2] << 16) | (b[3] << 24); w.y = b[4] | (b[5] << 8) | (b[6] << 16) | (b[7] << 24);
            *(u32x2*)(O + (size_t)row * ldc + col) = w;
        EPI_LOOP_END
    }
};
struct EpiStoreF32 {
    static constexpr bool PERM = true, AFTER_DRAIN = false;
    float* O; int ldc;
    __device__ __forceinline__ void operator()(const f32x4 (&acc)[2][2][4][2], const pg8::Unit& u, int wr, int wc, int fr, int fq) const {
        EPI_LOOP_BEGIN
            float* p = O + (size_t)row * ldc + col; *(f32x4*)p = v0; *(f32x4*)(p + 4) = v1;
        EPI_LOOP_END
    }
};
__device__ __forceinline__ void unpack8(const u32x4 g, float (&f)[8]) {
    f[0] = __builtin_bit_cast(float, g.x << 16); f[1] = __builtin_bit_cast(float, g.x & 0xffff0000u); f[2] = __builtin_bit_cast(float, g.y << 16); f[3] = __builtin_bit_cast(float, g.y & 0xffff0000u);
    f[4] = __builtin_bit_cast(float, g.z << 16); f[5] = __builtin_bit_cast(float, g.z & 0xffff0000u); f[6] = __builtin_bit_cast(float, g.w << 16); f[7] = __builtin_bit_cast(float, g.w & 0xffff0000u);
}
template <bool FIRST> struct EpiBranch {
    static constexpr bool PERM = true, AFTER_DRAIN = false;
    bf16_t* YM; const unsigned char* G; int br;
    __device__ __forceinline__ void operator()(const f32x4 (&acc)[2][2][4][2], const pg8::Unit& u, int wr, int wc, int fr, int fq) const {
        const int row0 = u.pm * 256 + wr * 64 + fr; const int colb = u.pn * 256 + wc * 32 + 8 * fq;
#pragma unroll
        for (int ai = 0; ai < 2; ++ai) {
            u32x2 gv[4][2]; u32x4 yv[4][2];
#pragma unroll
            for (int m = 0; m < 4; ++m)
#pragma unroll
                for (int bj = 0; bj < 2; ++bj) { const int row = row0 + ai * 128 + m * 16, col = colb + bj * 128;
                    gv[m][bj] = *(const u32x2*)(G + (size_t)row * G_PITCH + br * 2048 + col);
                    if (!FIRST) yv[m][bj] = *(const u32x4*)(YM + (size_t)row * D + col); }
#pragma unroll
            for (int m = 0; m < 4; ++m)
#pragma unroll
                for (int bj = 0; bj < 2; ++bj) { const int row = row0 + ai * 128 + m * 16, col = colb + bj * 128; const f32x4 v0 = acc[ai][bj][m][0], v1 = acc[ai][bj][m][1];
                    float g[8], y[8];
#pragma unroll
                    for (int i = 0; i < 4; ++i) { g[i] = (float)((gv[m][bj].x >> (8 * i)) & 0xffu) * (1.0f / 255.0f); g[4 + i] = (float)((gv[m][bj].y >> (8 * i)) & 0xffu) * (1.0f / 255.0f); }
                    y[0] = v0[0] * g[0]; y[1] = v0[1] * g[1]; y[2] = v0[2] * g[2]; y[3] = v0[3] * g[3]; y[4] = v1[0] * g[4]; y[5] = v1[1] * g[5]; y[6] = v1[2] * g[6]; y[7] = v1[3] * g[7];
                    if (!FIRST) { float o[8]; unpack8(yv[m][bj], o);
#pragma unroll
                        for (int i = 0; i < 8; ++i) y[i] += o[i]; }
                    u32x4 w; w.x = pk2(y[0], y[1]); w.y = pk2(y[2], y[3]); w.z = pk2(y[4], y[5]); w.w = pk2(y[6], y[7]);
                    *(u32x4*)(YM + (size_t)row * D + col) = w; }
        }
    }
};
struct EpiGate {
    static constexpr bool PERM = true, AFTER_DRAIN = false;
    bf16_t *Ya, *Yb, *Yc; const bf16_t* P; const float* lse;
    __device__ __forceinline__ void operator()(const f32x4 (&acc)[2][2][4][2], const pg8::Unit& u, int wr, int wc, int fr, int fq) const {
        const int row0 = u.pm * 256 + wr * 64 + fr; const int colb = u.pn * 256 + wc * 32 + 8 * fq;
        if (u.pn >= 2) {
            bf16_t* Y = (u.pn < 6) ? Yb : Yc; const int cofs = (u.pn < 6) ? 512 : 1536;
#pragma unroll
            for (int ai = 0; ai < 2; ++ai) {
                u32x4 rv[4][2];
#pragma unroll
                for (int m = 0; m < 4; ++m)
#pragma unroll
                    for (int bj = 0; bj < 2; ++bj) rv[m][bj] = *(const u32x4*)(Y + (size_t)(row0 + ai * 128 + m * 16) * 1024 + (colb + bj * 128 - cofs));
#pragma unroll
                for (int m = 0; m < 4; ++m)
#pragma unroll
                    for (int bj = 0; bj < 2; ++bj) { const f32x4 v0 = acc[ai][bj][m][0], v1 = acc[ai][bj][m][1];
                        float raw[8]; unpack8(rv[m][bj], raw);
                        const float a[8] = {v0[0], v0[1], v0[2], v0[3], v1[0], v1[1], v1[2], v1[3]};
                        float y[8];
#pragma unroll
                        for (int i = 0; i < 8; ++i) y[i] = raw[i] * a[i] * fast_sigmoid(a[i]);
                        u32x4 w; w.x = pk2(y[0], y[1]); w.y = pk2(y[2], y[3]); w.z = pk2(y[4], y[5]); w.w = pk2(y[6], y[7]);
                        *(u32x4*)(Y + (size_t)(row0 + ai * 128 + m * 16) * 1024 + (colb + bj * 128 - cofs)) = w; }
            }
        } else {
#pragma unroll
            for (int ai = 0; ai < 2; ++ai)
#pragma unroll
                for (int mp = 0; mp < 4; ++mp) {
                    u32x4 ov[1][2][3]; float lv[1][2][3];
#pragma unroll
                    for (int mm = 0; mm < 1; ++mm)
#pragma unroll
                        for (int bj = 0; bj < 2; ++bj) { const int row = row0 + ai * 128 + (mp + mm) * 16, col = colb + bj * 128, slot = col >> 7;
#pragma unroll
                            for (int g = 0; g < 3; ++g) { ov[mm][bj][g] = *(const u32x4*)(P + (size_t)row * PC + g * 512 + col); lv[mm][bj][g] = lse[((size_t)g * T + row) * 4 + slot]; } }
#pragma unroll
                    for (int mm = 0; mm < 1; ++mm)
#pragma unroll
                        for (int bj = 0; bj < 2; ++bj) { const int m = mp + mm; const int row = row0 + ai * 128 + m * 16, col = colb + bj * 128; const f32x4 v0 = acc[ai][bj][m][0], v1 = acc[ai][bj][m][1];
                            const float l0 = lv[mm][bj][0], l1 = lv[mm][bj][1], l2 = lv[mm][bj][2];
                            const float mx = fmaxf(l0, fmaxf(l1, l2)); float e0 = __expf(l0 - mx), e1 = __expf(l1 - mx), e2 = __expf(l2 - mx);
                            const float inv = 1.0f / (e0 + e1 + e2); e0 *= inv; e1 *= inv; e2 *= inv;
                            float o0[8], o1[8], o2[8]; unpack8(ov[mm][bj][0], o0); unpack8(ov[mm][bj][1], o1); unpack8(ov[mm][bj][2], o2);
                            const float a[8] = {v0[0], v0[1], v0[2], v0[3], v1[0], v1[1], v1[2], v1[3]};
                            float y[8];
#pragma unroll
                            for (int i = 0; i < 8; ++i) y[i] = (e0 * o0[i] + e1 * o1[i] + e2 * o2[i]) * a[i] * fast_sigmoid(a[i]);
                            u32x4 w; w.x = pk2(y[0], y[1]); w.y = pk2(y[2], y[3]); w.z = pk2(y[4], y[5]); w.w = pk2(y[6], y[7]);
                            *(u32x4*)(Ya + (size_t)row * 512 + col) = w; }
                }
        }
    }
};

constexpr int KP = 136;
struct AttnSrc { const bf16_t* Kg; const bf16_t* Vg; const bf16_t* Qrow; long tok0; int dil, kbase, L; };
template <int NKK, int NKV> struct StageRegs { bf16x8 k[(NKK * 16 + 511) / 512]; bf16x8 v[((NKV / 16) * 4 + 7) / 8]; bf16x8 q[4]; };
template <int NKK, int NKV, bool WITHQ>
__device__ __forceinline__ void stage_load(StageRegs<NKK, NKV>& R, const AttnSrc& A, int tid) {
    constexpr int KI = (NKK * 16 + 511) / 512, VI = ((NKV / 16) * 4 + 7) / 8;
    const int wave = tid >> 6, lane = tid & 63;
#pragma unroll
    for (int i = 0; i < KI; ++i) { const int task = tid + i * 512; const int row = task >> 4, c = task & 15; const int ki = A.kbase + row;
        bf16x8 v = (bf16x8){0, 0, 0, 0, 0, 0, 0, 0};
        if (task < NKK * 16 && ki >= 0 && ki < A.L) v = *(const bf16x8*)(A.Kg + (size_t)(A.tok0 + (long)ki * A.dil) * PC + c * 8);
        R.k[i] = v; }
#pragma unroll
    for (int i = 0; i < VI; ++i) { const int it = wave + 8 * i; const int row = (it >> 2) * 16 + (lane & 15), c = (it & 3) * 4 + (lane >> 4); const int ki = A.kbase + row;
        bf16x8 v = (bf16x8){0, 0, 0, 0, 0, 0, 0, 0};
        if (it < (NKV / 16) * 4 && ki >= 0 && ki < A.L) v = *(const bf16x8*)(A.Vg + (size_t)(A.tok0 + (long)ki * A.dil) * PC + c * 8);
        R.v[i] = v; }
    if (WITHQ) {
#pragma unroll
        for (int ks = 0; ks < 4; ++ks) R.q[ks] = *(const bf16x8*)(A.Qrow + ks * 32 + (lane >> 4) * 8); }
}
template <int NKK, int NKV, int VP>
__device__ __forceinline__ void stage_store(const StageRegs<NKK, NKV>& R, LAS bf16_t* Ks, LAS bf16_t* Vt, int tid) {
    constexpr int KI = (NKK * 16 + 511) / 512, VI = ((NKV / 16) * 4 + 7) / 8;
    const int wave = tid >> 6, lane = tid & 63;
#pragma unroll
    for (int i = 0; i < KI; ++i) { const int task = tid + i * 512; const int row = task >> 4, c = task & 15;
        if (task < NKK * 16) *(LAS bf16x8*)(Ks + row * KP + c * 8) = R.k[i]; }
#pragma unroll
    for (int i = 0; i < VI; ++i) { const int it = wave + 8 * i; const int row = (it >> 2) * 16 + (lane & 15), c = (it & 3) * 4 + (lane >> 4);
        if (it < (NKV / 16) * 4) {
            const u32x4 wv = __builtin_bit_cast(u32x4, R.v[i]); const bool odd = lane & 1;
            const unsigned rx = __shfl_xor(odd ? wv.x : wv.z, 1), ry = __shfl_xor(odd ? wv.y : wv.w, 1);
            const unsigned a0 = odd ? rx : wv.x, b0 = odd ? wv.z : rx, a1 = odd ? ry : wv.y, b1 = odd ? wv.w : ry;
            LAS unsigned* vp = (LAS unsigned*)(Vt + (c * 8 + (odd ? 4 : 0)) * VP + (row & ~1));
            vp[0] = (a0 & 0xffffu) | (b0 << 16); vp[VP / 2] = (a0 >> 16) | (b0 & 0xffff0000u);
            vp[VP] = (a1 & 0xffffu) | (b1 << 16); vp[VP + VP / 2] = (a1 >> 16) | (b1 & 0xffff0000u); } }
}
template <int NT, int VP>
__device__ __forceinline__ void attn_wave(const LAS bf16_t* Ks, const LAS bf16_t* Vt, int kt0, const bf16x8 (&qf)[4], int qi, int kbase, int L, int hw,
                                          bool has_sink, float sink, f32x4 (&o)[8], float& lse_out, int lane) {
    const int lr = lane & 15, lq = lane >> 4;
    f32x4 s[NT];
    __builtin_amdgcn_s_setprio(1);
#pragma unroll
    for (int kt = 0; kt < NT - 1; ++kt) { f32x4 a = (f32x4){0.f, 0.f, 0.f, 0.f}; const LAS bf16_t* kp = Ks + (kt0 + 16 * kt + lr) * KP + lq * 8;
#pragma unroll
        for (int ks = 0; ks < 4; ++ks) a = mfma16(*(const LAS bf16x8*)(kp + ks * 32), qf[ks], a);
        s[kt] = a; }
    __builtin_amdgcn_s_setprio(0);
    s[NT - 1] = (f32x4){-INFINITY, -INFINITY, -INFINITY, -INFINITY};
    const bool edge = (kbase + kt0 < 0) || (kbase + kt0 + 16 * NT > L);
#pragma unroll
    for (int kt = 0; kt < NT - 1; ++kt) {
        if (kt == 0 || kt == NT - 2 || edge) {
#pragma unroll
            for (int j = 0; j < 4; ++j) { const int ki = kbase + kt0 + 16 * kt + lq * 4 + j; const int rel = ki - qi;
                const bool ok = (ki >= 0) && (ki < L) && (rel <= hw) && (rel >= -hw);
                s[kt][j] = ok ? s[kt][j] : -INFINITY; } }
    }
    float m = -INFINITY;
#pragma unroll
    for (int kt = 0; kt < NT - 1; ++kt) m = fmaxf(fmaxf(m, fmaxf(s[kt][0], s[kt][1])), fmaxf(s[kt][2], s[kt][3]));
    m = fmaxf(m, __shfl_xor(m, 16)); m = fmaxf(m, __shfl_xor(m, 32));
    const float sc = 0.08838834764831845f * 1.4426950408889634f;
    float m2 = m * sc;
    if (has_sink) m2 = fmaxf(m2, sink * 1.4426950408889634f);
    float den = 0.f;
#pragma unroll
    for (int kt = 0; kt < NT - 1; ++kt)
#pragma unroll
        for (int j = 0; j < 4; ++j) { const float p = __builtin_amdgcn_exp2f(s[kt][j] * sc - m2); s[kt][j] = p; den += p; }
    s[NT - 1] = (f32x4){0.f, 0.f, 0.f, 0.f};
    den += __shfl_xor(den, 16); den += __shfl_xor(den, 32);
    if (has_sink) den += __builtin_amdgcn_exp2f(sink * 1.4426950408889634f - m2);
#pragma unroll
    for (int dt = 0; dt < 8; ++dt) o[dt] = (f32x4){0.f, 0.f, 0.f, 0.f};
    __builtin_amdgcn_s_setprio(1);
#pragma unroll
    for (int t = 0; t < NT / 2; ++t) {
        u32x4 pw; pw.x = pk2(s[2 * t][0], s[2 * t][1]); pw.y = pk2(s[2 * t][2], s[2 * t][3]); pw.z = pk2(s[2 * t + 1][0], s[2 * t + 1][1]); pw.w = pk2(s[2 * t + 1][2], s[2 * t + 1][3]);
        const bf16x8 p = __builtin_bit_cast(bf16x8, pw);
#pragma unroll
        for (int dt = 0; dt < 8; ++dt) { const LAS bf16_t* vp = Vt + (dt * 16 + lr) * VP + kt0 + 32 * t + lq * 4;
            const u32x2 a0 = *(const LAS u32x2*)vp, a1 = *(const LAS u32x2*)(vp + 16);
            u32x4 aw; aw.x = a0.x; aw.y = a0.y; aw.z = a1.x; aw.w = a1.y;
            o[dt] = mfma16(__builtin_bit_cast(bf16x8, aw), p, o[dt]); }
    }
    __builtin_amdgcn_s_setprio(0);
    const float inv = 1.0f / den;
#pragma unroll
    for (int dt = 0; dt < 8; ++dt) o[dt] = o[dt] * inv;
    lse_out = (m2 + __builtin_amdgcn_logf(den)) * 0.6931471805599453f;
}
constexpr int A_NK = 272, A_VP = 280, B_NKK = 288, B_NKV = 304, B_VP = 312;
struct AUnit { int g, slot, dil, phase, jb, L; long tok0; };
__device__ __forceinline__ AUnit decodeA(int u) { AUnit a; const int b = u / 1536, r = u % 1536; a.g = r >> 9; const int r2 = r & 511; a.slot = r2 >> 7; const int blk = r2 & 127;
    const int sh = 2 * a.g; a.dil = 1 << sh; const int nbp = 128 >> sh; a.phase = blk / nbp; a.jb = blk % nbp; a.L = S >> sh; a.tok0 = (long)b * S + a.phase; return a; }
__device__ __forceinline__ AttnSrc srcA(const AUnit& a, const bf16_t* P, int tid) { const int head = a.g * 4 + a.slot; const int w = tid >> 6, lr = tid & 15;
    const int qi = a.jb * 128 + 16 * w + lr;
    AttnSrc s; s.Kg = P + PA_K + head * 128; s.Vg = P + PA_V + head * 128; s.Qrow = P + (size_t)(a.tok0 + (long)qi * a.dil) * PC + PA_Q + head * 128; s.tok0 = a.tok0; s.dil = a.dil; s.kbase = a.jb * 128 - 64; s.L = a.L; return s; }
__device__ __forceinline__ void attnA_phase(bf16_t* P, float* lse, LAS unsigned char* lds, int tid, int bx, int G) {
    LAS bf16_t* Ks = (LAS bf16_t*)lds; LAS bf16_t* Vt = (LAS bf16_t*)(lds + A_NK * KP * 2);
    StageRegs<A_NK, A_NK> R;
    int u = bx;
    if (u < 3072) { const AUnit a = decodeA(u); stage_load<A_NK, A_NK, true>(R, srcA(a, P, tid), tid); }
    for (; u < 3072; u += G) {
        const AUnit a = decodeA(u);
        stage_store<A_NK, A_NK, A_VP>(R, Ks, Vt, tid);
        bf16x8 qf[4];
#pragma unroll
        for (int ks = 0; ks < 4; ++ks) qf[ks] = R.q[ks];
        __syncthreads();
        if (u + G < 3072) { const AUnit an = decodeA(u + G); stage_load<A_NK, A_NK, true>(R, srcA(an, P, tid), tid); }
        const int w = tid >> 6, lane = tid & 63, lr = lane & 15, lq = lane >> 4;
        const int qi = a.jb * 128 + 16 * w + lr; const long token = a.tok0 + (long)qi * a.dil; const int head = a.g * 4 + a.slot;
        f32x4 o[8]; float lv;
        attn_wave<10, A_VP>(Ks, Vt, 16 * w, qf, qi, a.jb * 128 - 64, a.L, 64, false, 0.f, o, lv, lane);
        bf16_t* qrow = P + (size_t)token * PC + PA_Q + head * 128;
#pragma unroll
        for (int dt = 0; dt < 8; ++dt) { u32x2 wv; wv.x = pk2(o[dt][0], o[dt][1]); wv.y = pk2(o[dt][2], o[dt][3]); *(u32x2*)(qrow + dt * 16 + lq * 4) = wv; }
        if (lq == 0) lse[((size_t)a.g * T + token) * 4 + a.slot] = lv;
        __syncthreads();
    }
}
__device__ __forceinline__ AttnSrc srcB(int u, const bf16_t* P, int tid) { const int b = u >> 10, r = u & 1023, kvh = r >> 9, blk = r & 511; const int w = tid >> 6, lr = tid & 15;
    const int head = kvh * 4 + (w >> 1), qi = blk * 32 + 16 * (w & 1) + lr;
    AttnSrc s; s.Kg = P + PB_K + kvh * 128; s.Vg = P + PB_V + kvh * 128; s.tok0 = (long)b * S; s.Qrow = P + (size_t)(s.tok0 + qi) * PC + PB_Q + head * 128; s.dil = 1; s.kbase = blk * 32 - 128; s.L = S; return s; }
__device__ __forceinline__ void attnB_phase(const bf16_t* P, bf16_t* Yb, const float* sinks, LAS unsigned char* lds, int tid, int bx, int G) {
    LAS bf16_t* Ks = (LAS bf16_t*)lds; LAS bf16_t* Vt = (LAS bf16_t*)(lds + B_NKK * KP * 2);
    StageRegs<B_NKK, B_NKV> R;
    int u = bx;
    if (u < 2048) stage_load<B_NKK, B_NKV, false>(R, srcB(u, P, tid), tid);
    for (; u < 2048; u += G) {
        bf16x8 qf[4];
        { const AttnSrc sq = srcB(u, P, tid);
#pragma unroll
          for (int ks = 0; ks < 4; ++ks) qf[ks] = *(const bf16x8*)(sq.Qrow + ks * 32 + ((tid & 63) >> 4) * 8); }
        stage_store<B_NKK, B_NKV, B_VP>(R, Ks, Vt, tid);
        __syncthreads();
        if (u + G < 2048) stage_load<B_NKK, B_NKV, false>(R, srcB(u + G, P, tid), tid);
        const int b = u >> 10, r = u & 1023, kvh = r >> 9, blk = r & 511;
        const int w = tid >> 6, lane = tid & 63, lr = lane & 15, lq = lane >> 4;
        const int head = kvh * 4 + (w >> 1), rg = w & 1;
        const int qi = blk * 32 + 16 * rg + lr; const long token = (long)b * S + qi;
        f32x4 o[8]; float lv;
        attn_wave<18, B_VP>(Ks, Vt, 16 * rg, qf, qi, blk * 32 - 128, S, 128, true, sinks[head], o, lv, lane);
        bf16_t* orow = Yb + (size_t)token * 1024 + head * 128;
#pragma unroll
        for (int dt = 0; dt < 8; ++dt) { u32x2 wv; wv.x = pk2(o[dt][0], o[dt][1]); wv.y = pk2(o[dt][2], o[dt][3]); *(u32x2*)(orow + dt * 16 + lq * 4) = wv; }
        __syncthreads();
    }
}

constexpr int H_QT = 0, H_KT = 17408, H_QH = 34816, H_KHT = 52224, H_VT = 70656, H_ST = 89088, H_SC = 123904, H_QS = 133120, H_DEC = 135168;
__device__ __forceinline__ void hgrn_unit(int b, int h, int seg, int dir, int mode, bf16_t* P, const float* lb, float* SUM, float* LSUM, LAS unsigned char* lds, int tid) {
    const int w = tid >> 6, lane = tid & 63, lr = lane & 15, lq = lane >> 4;
    const int k = tid & 127, tq = tid >> 7;
    LAS bf16_t* Qt = (LAS bf16_t*)(lds + H_QT); LAS bf16_t* Kt = (LAS bf16_t*)(lds + H_KT);
    LAS bf16_t* KhT = (LAS bf16_t*)(lds + H_KHT); LAS bf16_t* VT = (LAS bf16_t*)(lds + H_VT); LAS bf16_t* ST = (LAS bf16_t*)(lds + H_ST);
    LAS bf16_t* Sc = (LAS bf16_t*)(lds + H_SC); LAS float* QS = (LAS float*)(lds + H_QS); LAS float* DEC = (LAS float*)(lds + H_DEC);
    const float lbv = lb[h * 128 + k], oml = 1.0f - lbv;
    f32x4 Sacc[8];
#pragma unroll
    for (int vt = 0; vt < 8; ++vt) Sacc[vt] = (f32x4){0.f, 0.f, 0.f, 0.f};
    float lsum = 0.f;
    const int chain = ((b * 8 + h) * 2 + dir) * 16;
    if (mode == 1) {
        const int nprev = dir ? 15 - seg : seg;
        f32x4 nx[8], nl;
        if (nprev > 0) { const int su = chain + (dir ? 15 : 0); const float* sp = SUM + (size_t)su * 16384; nl = *(const f32x4*)(LSUM + su * 128 + 16 * w + lq * 4);
#pragma unroll
            for (int vt = 0; vt < 8; ++vt) nx[vt] = *(const f32x4*)(sp + ((w * 8 + vt) * 64 + lane) * 4); }
        for (int jj = 0; jj < nprev; ++jj) {
            f32x4 cx[8]; const f32x4 lv = nl;
#pragma unroll
            for (int vt = 0; vt < 8; ++vt) cx[vt] = nx[vt];
            if (jj + 1 < nprev) { const int su = chain + (dir ? 14 - jj : jj + 1); const float* sp = SUM + (size_t)su * 16384; nl = *(const f32x4*)(LSUM + su * 128 + 16 * w + lq * 4);
#pragma unroll
                for (int vt = 0; vt < 8; ++vt) nx[vt] = *(const f32x4*)(sp + ((w * 8 + vt) * 64 + lane) * 4); }
            f32x4 dv; dv.x = __expf(lv.x); dv.y = __expf(lv.y); dv.z = __expf(lv.z); dv.w = __expf(lv.w);
#pragma unroll
            for (int vt = 0; vt < 8; ++vt) Sacc[vt] = Sacc[vt] * dv + cx[vt]; }
    }
    typedef __attribute__((address_space(1))) const bf16_t gbf16_t;
    gbf16_t* Pg = (gbf16_t*)P;
    const unsigned colF = (dir ? PC_FB : PC_FF) + h * 128 + k, colV = PC_I + h * 128 + k, colQ = PC_Q + h * 128 + k;
    unsigned short nfz[16], nv[16], nq[16];
#define HG_ROW0(cc_) ((unsigned)((b * S + (seg * 16 + (dir ? 15 - (cc_) : (cc_))) * 64 + (dir ? 63 - tq * 16 : tq * 16)) * PC))
#define HG_LOAD_F(cc_) do { unsigned vo_ = HG_ROW0(cc_) + colF; asm volatile("" : "+v"(vo_)); \
        _Pragma("unroll") for (int ii = 0; ii < 16; ++ii) nfz[ii] = Pg[dir ? vo_ - (unsigned)(ii * PC) : vo_ + (unsigned)(ii * PC)]; } while (0)
#define HG_LOAD_QV(cc_) do { unsigned vo_ = HG_ROW0(cc_); asm volatile("" : "+v"(vo_)); \
        _Pragma("unroll") for (int ii = 0; ii < 16; ++ii) { const unsigned ro_ = dir ? vo_ - (unsigned)(ii * PC) : vo_ + (unsigned)(ii * PC); \
            nv[ii] = Pg[ro_ + colV]; if (mode == 1) nq[ii] = Pg[ro_ + colQ]; } } while (0)
    float lf[16], kk[16];
#define HG_STAGE1(qb_) do { \
        _Pragma("unroll") for (int ii = 0; ii < 16; ++ii) { const float fz = bf2f(nfz[ii]); const float e = __expf(-fz), sg = __builtin_amdgcn_rcpf(1.0f + e); \
            lf[ii] = __logf(lbv + oml * sg); kk[ii] = oml * e * sg; } \
        _Pragma("unroll") for (int ii = 1; ii < 16; ++ii) lf[ii] += lf[ii - 1]; \
        QS[(qb_) * 640 + tq * 128 + k] = lf[15]; } while (0)
    HG_LOAD_F(0); HG_LOAD_QV(0);
    HG_STAGE1(0);
    HG_LOAD_F(1);
    __syncthreads();
    for (int cc = 0; cc < 16; ++cc) {
        const int c = seg * 16 + (dir ? 15 - cc : cc); const long btok = (long)b * S + c * 64;
        LAS float* QSc = QS + (cc & 1) * 640;
        const float q0 = QSc[k], q1 = QSc[128 + k], q2 = QSc[256 + k], q3 = QSc[384 + k];
        const float off = (tq > 0 ? q0 : 0.f) + (tq > 1 ? q1 : 0.f) + (tq > 2 ? q2 : 0.f);
        const float rref = q0 + q1, bl = (q0 + q1) + (q2 + q3);
        if (tq == 0) { DEC[k] = __expf(bl); lsum += bl; }
        u32x4 kh0, kh1, vv0, vv1;
        {
            float khat[16];
            const float ebr = __expf(bl - rref);
#pragma unroll
            for (int ii = 0; ii < 16; ++ii) { const int i = tq * 16 + ii; const float bt = off + lf[ii];
                if (mode == 1) { const float qh = bf2f(nq[ii]);
                    const float eq = __expf(fminf(fmaxf(bt - rref, -80.f), 80.f)), ek = __builtin_amdgcn_rcpf(eq);
                    const float kt = kk[ii] * ek; khat[ii] = kt * ebr;
                    Qt[i * KP + k] = (bf16_t)(pk2(qh * eq, 0.f) & 0xffffu); Kt[i * KP + k] = (bf16_t)(pk2(kt, 0.f) & 0xffffu); }
                else khat[ii] = kk[ii] * __expf(bl - bt); }
            kh0.x = pk2(khat[0], khat[1]); kh0.y = pk2(khat[2], khat[3]); kh0.z = pk2(khat[4], khat[5]); kh0.w = pk2(khat[6], khat[7]);
            kh1.x = pk2(khat[8], khat[9]); kh1.y = pk2(khat[10], khat[11]); kh1.z = pk2(khat[12], khat[13]); kh1.w = pk2(khat[14], khat[15]);
            vv0.x = nv[0] | ((unsigned)nv[1] << 16); vv0.y = nv[2] | ((unsigned)nv[3] << 16); vv0.z = nv[4] | ((unsigned)nv[5] << 16); vv0.w = nv[6] | ((unsigned)nv[7] << 16);
            vv1.x = nv[8] | ((unsigned)nv[9] << 16); vv1.y = nv[10] | ((unsigned)nv[11] << 16); vv1.z = nv[12] | ((unsigned)nv[13] << 16); vv1.w = nv[14] | ((unsigned)nv[15] << 16);
        }
        *(LAS u32x4*)(KhT + k * 72 + tq * 16) = kh0; *(LAS u32x4*)(KhT + k * 72 + tq * 16 + 8) = kh1;
        *(LAS u32x4*)(VT + k * 72 + tq * 16) = vv0; *(LAS u32x4*)(VT + k * 72 + tq * 16 + 8) = vv1;
        if (mode == 1) {
            const f32x4 ra = *(const LAS f32x4*)(QSc + 16 * w + lq * 4), rb = *(const LAS f32x4*)(QSc + 128 + 16 * w + lq * 4);
            f32x4 er; er.x = __expf(ra.x + rb.x); er.y = __expf(ra.y + rb.y); er.z = __expf(ra.z + rb.z); er.w = __expf(ra.w + rb.w);
#pragma unroll
            for (int vt = 0; vt < 8; ++vt) { const f32x4 sx = Sacc[vt] * er; u32x2 sv; sv.x = pk2(sx[0], sx[1]); sv.y = pk2(sx[2], sx[3]); *(LAS u32x2*)(ST + (16 * vt + lr) * KP + 16 * w + lq * 4) = sv; }
        }
        __syncthreads();
        if (cc < 15) { HG_STAGE1((cc + 1) & 1); HG_LOAD_QV(cc + 1); if (cc < 14) HG_LOAD_F(cc + 2); }
        if (mode == 1) {
#pragma unroll
            for (int e = 0; e < 2; ++e) { const int ti = 2 * w + e, st = ti >> 2, tt = ti & 3;
                f32x4 a = (f32x4){0.f, 0.f, 0.f, 0.f};
                if (st <= tt) {
#pragma unroll
                    for (int ks = 0; ks < 4; ++ks) a = mfma16(*(const LAS bf16x8*)(Kt + (16 * st + lr) * KP + ks * 32 + lq * 8), *(const LAS bf16x8*)(Qt + (16 * tt + lr) * KP + ks * 32 + lq * 8), a);
                }
                const int t = 16 * tt + lr, s0 = 16 * st + lq * 4;
                float x0 = (t >= s0 && st <= tt) ? a[0] : 0.f, x1 = (t >= s0 + 1 && st <= tt) ? a[1] : 0.f, x2 = (t >= s0 + 2 && st <= tt) ? a[2] : 0.f, x3 = (t >= s0 + 3 && st <= tt) ? a[3] : 0.f;
                u32x2 sv; sv.x = pk2(x0, x1); sv.y = pk2(x2, x3); *(LAS u32x2*)(Sc + t * 72 + s0) = sv; }
            __syncthreads();
            const int tt = w & 3, vh = w >> 2;
            bf16x8 scf[2], qhf[4];
#pragma unroll
            for (int ks = 0; ks < 2; ++ks) scf[ks] = *(const LAS bf16x8*)(Sc + (16 * tt + lr) * 72 + ks * 32 + lq * 8);
#pragma unroll
            for (int ks = 0; ks < 4; ++ks) qhf[ks] = *(const LAS bf16x8*)(Qt + (16 * tt + lr) * KP + ks * 32 + lq * 8);
            const int il = 16 * tt + lr; const long tok = btok + (dir ? 63 - il : il);
#pragma unroll
            for (int vi = 0; vi < 4; ++vi) { const int vt = vh * 4 + vi; f32x4 a = (f32x4){0.f, 0.f, 0.f, 0.f};
#pragma unroll
                for (int ks = 0; ks < 2; ++ks) a = mfma16(*(const LAS bf16x8*)(VT + (16 * vt + lr) * 72 + ks * 32 + lq * 8), scf[ks], a);
#pragma unroll
                for (int ks = 0; ks < 4; ++ks) a = mfma16(*(const LAS bf16x8*)(ST + (16 * vt + lr) * KP + ks * 32 + lq * 8), qhf[ks], a);
                bf16_t* of = P + (size_t)tok * PC + PC_FF + h * 128 + 16 * vt + lq * 4;
                if (dir == 0) { u32x2 sv; sv.x = pk2(a[0], a[1]); sv.y = pk2(a[2], a[3]); *(u32x2*)of = sv; }
                else { const u32x2 pv = *(const u32x2*)of;
                    a[0] += __builtin_bit_cast(float, pv.x << 16); a[1] += __builtin_bit_cast(float, pv.x & 0xffff0000u); a[2] += __builtin_bit_cast(float, pv.y << 16); a[3] += __builtin_bit_cast(float, pv.y & 0xffff0000u);
                    u32x2 sv; sv.x = pk2(a[0], a[1]); sv.y = pk2(a[2], a[3]); *(u32x2*)(P + (size_t)tok * PC + PC_FB + h * 128 + 16 * vt + lq * 4) = sv; } }
        }
        { const f32x4 dv = *(const LAS f32x4*)(DEC + 16 * w + lq * 4);
          bf16x8 af[2];
#pragma unroll
          for (int ks = 0; ks < 2; ++ks) af[ks] = *(const LAS bf16x8*)(KhT + (16 * w + lr) * 72 + ks * 32 + lq * 8);
#pragma unroll
          for (int vt = 0; vt < 8; ++vt) { f32x4 a = Sacc[vt] * dv;
#pragma unroll
              for (int ks = 0; ks < 2; ++ks) a = mfma16(af[ks], *(const LAS bf16x8*)(VT + (16 * vt + lr) * 72 + ks * 32 + lq * 8), a);
              Sacc[vt] = a; } }
        __syncthreads();
    }
#undef HG_STAGE1
#undef HG_LOAD_F
#undef HG_LOAD_QV
#undef HG_ROW0
    if (mode == 0) { const int su = chain + seg; float* sp = SUM + (size_t)su * 16384;
#pragma unroll
        for (int vt = 0; vt < 8; ++vt) *(f32x4*)(sp + ((w * 8 + vt) * 64 + lane) * 4) = Sacc[vt];
        if (tq == 0) LSUM[su * 128 + k] = lsum; }
}
__device__ __forceinline__ void hgrn_full_unit(int u, bf16_t* P, const float* lb, const float* hnorm, float* SUM, float* LSUM, bf16_t* Yc, LAS unsigned char* lds, int tid) {
    const int b = u >> 7, h = (u >> 4) & 7, seg = u & 15;
    hgrn_unit(b, h, seg, 0, 1, P, lb, SUM, LSUM, lds, tid);
    __syncthreads();
#if defined(PROBE_HG) && PROBE_HG == 1
    return;
#endif
    hgrn_unit(b, h, seg, 1, 1, P, lb, SUM, LSUM, lds, tid);
    __syncthreads();
#if defined(PROBE_HG) && PROBE_HG == 2
    return;
#endif
    const int w = tid >> 6, lane = tid & 63;
    const float g0 = hnorm[h * 128 + 2 * lane], g1 = hnorm[h * 128 + 2 * lane + 1];
    for (int r0 = w * 128; r0 < w * 128 + 128; r0 += 16) {
        unsigned pv[16];
#pragma unroll
        for (int i = 0; i < 16; ++i) pv[i] = *(const unsigned*)(P + (size_t)((long)b * S + seg * 1024 + r0 + i) * PC + PC_FB + h * 128 + 2 * lane);
#pragma unroll
        for (int i = 0; i < 16; ++i) { const long tok = (long)b * S + seg * 1024 + r0 + i;
            const float x0 = __builtin_bit_cast(float, pv[i] << 16), x1 = __builtin_bit_cast(float, pv[i] & 0xffff0000u);
            const float ss = wave_sum(x0 * x0 + x1 * x1); const float rs = 1.0f / sqrtf(ss * (1.0f / 128.f) + NORM_EPS);
            *(unsigned*)(Yc + (size_t)tok * 1024 + h * 128 + 2 * lane) = pk2(x0 * rs * g0, x1 * rs * g1); }
    }
    __syncthreads();
}

#define XB_TMO      128
#define XB_XCNT(j)  (256  + 64 * (j))
#define XB_XSUB(j)  (1280 + 64 * (j))
#define XB_XGEN(j)  (2304 + 64 * (j))
#define XB_TOP      3328
#define XB_TOPGEN   3392
#define XCD_BAR_WORDS 3456
#define XB_SPIN_CAP (1u << 18)

__device__ __forceinline__ unsigned xb_ld(unsigned* p)              { return __hip_atomic_load(p, __ATOMIC_RELAXED, __HIP_MEMORY_SCOPE_AGENT); }
__device__ __forceinline__ unsigned xb_add(unsigned* p, unsigned v) { return __hip_atomic_fetch_add(p, v, __ATOMIC_RELAXED, __HIP_MEMORY_SCOPE_AGENT); }
__device__ __forceinline__ unsigned xb_xcc_id() { return (unsigned)__builtin_amdgcn_s_getreg((3 << 11) | 20) & 0xFu; }
#define XB_SPIN(cond, bar) do { unsigned _sp = 0; while (cond) { __builtin_amdgcn_s_sleep(1); \
    if ((++_sp & 255u) == 0u) { if (xb_ld(&(bar)[XB_TMO])) break; if (_sp > XB_SPIN_CAP) { atomicAdd(&(bar)[XB_TMO], 1u); break; } } } } while (0)

struct XcdBarrier {
    unsigned* bar; unsigned x;
    volatile LAS unsigned* st;
};

__device__ __forceinline__ XcdBarrier xcd_barrier_post(unsigned* bar, volatile LAS unsigned* st) {
    XcdBarrier b; b.bar = bar; b.x = xb_xcc_id(); b.st = st;
    if (threadIdx.x == 0) (void)xb_add(&bar[XB_XCNT(b.x)], 1u);
    return b;
}
__device__ __forceinline__ void xcd_barrier_complete(unsigned* bar, unsigned x, unsigned& nloc, unsigned& nx) {
    const unsigned G = gridDim.x * gridDim.y * gridDim.z;
    unsigned sum, cnt, mine, sp = 0u;
    for (;;) {
        sum = 0u; cnt = 0u; mine = 0u;
#pragma unroll
        for (unsigned j = 0; j < 16; ++j) { const unsigned c = xb_ld(&bar[XB_XCNT(j)]); sum += c; cnt += (c > 0u) ? 1u : 0u; mine = (j == x) ? c : mine; }
        if (sum == G) break;
        __builtin_amdgcn_s_sleep(1);
        if ((++sp & 255u) == 0u) { if (xb_ld(&bar[XB_TMO])) break; if (sp > XB_SPIN_CAP) { atomicAdd(&bar[XB_TMO], 1u); break; } }
    }
    nloc = mine > 0u ? mine : 1u; nx = cnt > 0u ? cnt : 1u;
}

__device__ __forceinline__ void xcd_barrier(const XcdBarrier& b) {
    asm volatile("s_waitcnt vmcnt(0)" ::: "memory");
    __syncthreads();
    if (threadIdx.x == 0) {
        unsigned* bar = b.bar;
        __builtin_amdgcn_s_waitcnt(0);
        unsigned nloc = b.st[0], nx = b.st[1];
        if (nloc == 0u) { xcd_barrier_complete(bar, b.x, nloc, nx); b.st[0] = nloc; b.st[1] = nx; }
        const unsigned old = xb_add(&bar[XB_XSUB(b.x)], 1u);
        const unsigned gen = old / nloc;
        if (old + 1u == (gen + 1u) * nloc) {
            __builtin_amdgcn_fence(__ATOMIC_RELEASE, "agent");
            asm volatile("s_waitcnt vmcnt(0)" ::: "memory");
            const unsigned og = xb_add(&bar[XB_TOP], 1u);
            const unsigned tg = og / nx;
            if (og + 1u == (tg + 1u) * nx) xb_add(&bar[XB_TOPGEN], 1u);
            else XB_SPIN(xb_ld(&bar[XB_TOPGEN]) == tg, bar);
            __builtin_amdgcn_fence(__ATOMIC_ACQUIRE, "agent");
            xb_add(&bar[XB_XGEN(b.x)], 1u);
            asm volatile("s_waitcnt vmcnt(0)" ::: "memory");
        } else {
            XB_SPIN(xb_ld(&bar[XB_XGEN(b.x)]) == gen, bar);
            __builtin_amdgcn_fence(__ATOMIC_ACQUIRE, "agent");
            asm volatile("s_waitcnt vmcnt(0)" ::: "memory");
        }
    }
    __syncthreads();
}


struct Args { const float* in[11]; float* out; unsigned char* ws; int ph_lo, ph_hi; };
#define DERIVE_PTRS \
    int tid = threadIdx.x; asm volatile("" : "+v"(tid)); const int lane = tid & 63, wave = __builtin_amdgcn_readfirstlane(tid >> 6); \
    int G = gridDim.x, bx = blockIdx.x; asm volatile("" : "+s"(G), "+s"(bx)); \
    const int gw = bx * 8 + wave, NGW = G * 8; \
    unsigned char* ws = args.ws; asm volatile("" : "+s"(ws)); \
    const float* x0 = args.in[0]; const float* pre_norm = args.in[1]; const float* post_norm = args.in[2]; const float* sink_logits = args.in[4]; \
    const float* hlb = args.in[5]; const float* hnorm = args.in[6]; float* outp = args.out; \
    asm volatile("" : "+s"(x0), "+s"(pre_norm), "+s"(post_norm), "+s"(sink_logits), "+s"(hlb), "+s"(hnorm), "+s"(outp)); \
    float2* rope = (float2*)(ws + WS_ROPE); float* lse = (float*)(ws + WS_LSE); float* LB = (float*)(ws + WS_LB); float* LSUM = (float*)(ws + WS_LSUM); \
    bf16_t* WinT = (bf16_t*)(ws + WS_WIN); bf16_t* WaT = (bf16_t*)(ws + WS_WA); bf16_t* WbT = (bf16_t*)(ws + WS_WB); bf16_t* WcT = (bf16_t*)(ws + WS_WC); bf16_t* WoT = (bf16_t*)(ws + WS_WO); \
    bf16_t* XN = (bf16_t*)(ws + WS_XN); bf16_t* Ya = (bf16_t*)(ws + WS_YA); bf16_t* Yb = (bf16_t*)(ws + WS_YB); bf16_t* Yc = (bf16_t*)(ws + WS_YC); \
    float* SUM = (float*)(ws + WS_SUM); bf16_t* P = (bf16_t*)(ws + WS_P); bf16_t* Gm = (bf16_t*)(ws + WS_G); bf16_t* YM = (bf16_t*)(ws + WS_YM); float* OUT = (float*)(ws + WS_OUT); \
    (void)tid; (void)lane; (void)gw; (void)NGW; (void)x0; (void)pre_norm; (void)post_norm; (void)sink_logits; (void)hlb; (void)hnorm; (void)outp; (void)rope; (void)lse; (void)LB; (void)LSUM; \
    (void)WinT; (void)WaT; (void)WbT; (void)WcT; (void)WoT; (void)XN; (void)Ya; (void)Yb; (void)Yc; (void)SUM; (void)P; (void)Gm; (void)YM; (void)OUT;
#ifndef REPEAT_MASK
#define REPEAT_MASK 0
#endif
#define NREP(j) (1 + ((REPEAT_MASK >> (j)) & 1))
#define IN(k) (args.ph_lo <= (k) && (k) < args.ph_hi)
#define XB_ST_OFF (LDS_BYTES - 64)
#ifdef PROBE_TS
#define STAMP(k) do { if (blockIdx.x == 0 && threadIdx.x == 0) ((unsigned long long*)(args.ws + 65536))[k] = __builtin_amdgcn_s_memrealtime(); } while (0)
#else
#define STAMP(k) do { } while (0)
#endif
#define GRID_SYNC(k) do { if (IN(k) && IN((k) + 1)) { if ((k) == 0) cg::this_grid().sync(); else { XcdBarrier xb_; xb_.bar = (unsigned*)args.ws; xb_.x = xb_xcc_id(); xb_.st = (volatile LAS unsigned*)(lds + XB_ST_OFF); xcd_barrier(xb_); } } STAMP((k) + 1); } while (0)
template <int layer> __device__ __forceinline__ void run_layer(const Args& args, LAS unsigned char* lds) {
#ifndef SKIP_P1
        for (int rep = 0; rep < NREP(0); ++rep) if (IN(1 + 8 * layer + 0)) { DERIVE_PTRS pg8::Gemm g{XN, WinT, T, PC, D}; pg8::StaticOrder So; So.init(T, PC, G, bx); EpiStoreRope E{P, PC};
          pg8::gemm_phase<EpiStoreRope, pg8::StaticOrder, true, true>(lds, g, So, E); }
#endif
        GRID_SYNC(1 + 8 * layer + 0);
#ifndef SKIP_P2
        if (IN(1 + 8 * layer + 1)) { DERIVE_PTRS const float* lbL = LB + layer * 1024;
          for (int rep = 0; rep < NREP(8); ++rep) for (int u = bx; u < 512; u += G) { const int dir = u & 1, seg = (u >> 1) & 15, h = (u >> 5) & 7, b = u >> 8; hgrn_unit(b, h, seg, dir, 0, P, lbL, SUM, LSUM, lds, tid); }
          __syncthreads();
          const int vb = (G % 8 == 0) ? (bx % 8) * (G / 8) + bx / 8 : bx;
          attnA_phase(P, lse, lds, tid, vb, G);
          for (int rep = 0; rep < NREP(9); ++rep) attnB_phase(P, Yb, sink_logits + layer * 8, lds, tid, vb, G); }
#endif
        GRID_SYNC(1 + 8 * layer + 1);
#ifndef SKIP_P3
        if (IN(1 + 8 * layer + 2)) { DERIVE_PTRS const int vb3 = (G % 8 == 0) ? (bx % 8) * (G / 8) + bx / 8 : bx;
            for (int u = vb3; u < 256; u += G) hgrn_full_unit(u, P, LB + layer * 1024, hnorm + layer * 1024, SUM, LSUM, Yc, lds, tid); }
#endif
        GRID_SYNC(1 + 8 * layer + 2);
#ifndef SKIP_P4
        if (IN(1 + 8 * layer + 3)) { DERIVE_PTRS pg8::Gemm g{XN, WinT + (size_t)PC * D, T, NGATE, D}; pg8::StaticOrder So; So.init(T, NGATE, G, bx); EpiGate E{Ya, Yb, Yc, P, lse};
          pg8::gemm_phase<EpiGate, pg8::StaticOrder, true, true>(lds, g, So, E); }
#endif
#if defined(MULTI_LAUNCH) || defined(PROBE_PHASES)
        GRID_SYNC(1 + 8 * layer + 3);
#endif
#ifndef SKIP_P5
        for (int rep = 0; rep < NREP(4); ++rep) if (IN(1 + 8 * layer + 4)) { DERIVE_PTRS pg8::Gemm g{(const bf16_t*)(ws + WS_XN8), (const bf16_t*)(ws + WS_WM8), T, NMERGE, D}; pg8::StaticOrder So; So.init(T, NMERGE, G, bx); EpiSigmoidI8 E{(unsigned char*)Gm, G_PITCH, 1.0f / (Q_SX * Q_SW)};
          pg8::gemm_phase<EpiSigmoidI8, pg8::StaticOrder, true, true, 1>(lds, g, So, E); }
#endif
        GRID_SYNC(1 + 8 * layer + 4);
#ifndef SKIP_P6
        for (int rep = 0; rep < NREP(5); ++rep) if (IN(1 + 8 * layer + 5)) { DERIVE_PTRS pg8::StaticOrder So; So.init(T, D, G, bx);
          { pg8::Gemm g{Ya, WaT, T, D, 512}; EpiBranch<true> E{YM, (const unsigned char*)Gm, 0}; pg8::gemm_phase<EpiBranch<true>, pg8::StaticOrder, true, true>(lds, g, So, E); }
          { pg8::Gemm g{Yb, WbT, T, D, 1024}; EpiBranch<false> E{YM, (const unsigned char*)Gm, 1}; pg8::gemm_phase<EpiBranch<false>, pg8::StaticOrder, true, true>(lds, g, So, E); }
          { pg8::Gemm g{Yc, WcT, T, D, 1024}; EpiBranch<false> E{YM, (const unsigned char*)Gm, 2}; pg8::gemm_phase<EpiBranch<false>, pg8::StaticOrder, true, true>(lds, g, So, E); } }
#endif
        GRID_SYNC(1 + 8 * layer + 5);
#ifndef SKIP_P7
        for (int rep = 0; rep < NREP(6); ++rep) if (IN(1 + 8 * layer + 6)) { DERIVE_PTRS pg8::Gemm g{YM, WoT, T, D, D}; pg8::StaticOrder So; So.init(T, D, G, bx); EpiStoreBf16 E{(bf16_t*)OUT, D};
          pg8::gemm_phase<EpiStoreBf16, pg8::StaticOrder, true, true>(lds, g, So, E); }
#endif
        GRID_SYNC(1 + 8 * layer + 6);
        for (int rep8 = 0; rep8 < (layer == 0 ? NREP(11) : 1); ++rep8) if (IN(1 + 8 * layer + 7)) { DERIVE_PTRS const float* xold = layer == 0 ? x0 : outp;
          for (int m = gw; m < T; m += 2 * NGW) { const int m2 = (m + NGW < T) ? m + NGW : m;
              const bf16_t* const orow[2] = {(const bf16_t*)OUT + (size_t)m * D, (const bf16_t*)OUT + (size_t)m2 * D};
              const float* const xo[2] = {xold + (size_t)m * D, xold + (size_t)m2 * D}; float* const xn[2] = {outp + (size_t)m * D, outp + (size_t)m2 * D};
              bf16_t* const xq[2] = {XN + (size_t)m * D, XN + (size_t)m2 * D}; unsigned* const xq8[2] = {(unsigned*)(ws + WS_XN8) + (size_t)m * (D / 4), (unsigned*)(ws + WS_XN8) + (size_t)m2 * (D / 4)};
              final_rows<2>(orow, post_norm + layer * D, xo, xn, layer == 0 ? pre_norm + D : nullptr, xq, xq8, lane); }
          if (layer == 0) { Weights Wt{args.in[3] + (size_t)D * NIN, args.in[7] + (size_t)512 * D, args.in[8] + (size_t)1024 * D, args.in[9] + (size_t)1024 * D, args.in[10] + (size_t)D * D};
              __syncthreads(); transpose_weights(Wt, ws, lds, gw, NGW, wave, lane); GRID_SYNC(1 + 8 * layer + 7); } }
}
__global__ void __launch_bounds__(NTHREADS, 2) fwd_megakernel(Args args) {
    extern __shared__ __attribute__((aligned(16))) unsigned char lds_raw[];
    LAS unsigned char* lds = (LAS unsigned char*)lds_raw;
    if (threadIdx.x < 16) ((LAS unsigned*)(lds + XB_ST_OFF))[threadIdx.x] = 0u;
    __syncthreads();
    if (args.ph_hi - args.ph_lo > 1 && blockIdx.x == 0) { for (int i = threadIdx.x; i < XCD_BAR_WORDS; i += NTHREADS) ((unsigned*)args.ws)[i] = 0u; }
    STAMP(0);
    for (int rep0 = 0; rep0 < NREP(10); ++rep0) if (IN(0)) { DERIVE_PTRS
    for (int i = bx * NTHREADS + tid; i < 1024; i += G * NTHREADS) { const float h0 = hlb[i], h1 = hlb[1024 + i]; const float mx = fmaxf(h0, h1);
        const float e0 = expf(h0 - mx), e1 = expf(h1 - mx); LB[i] = 0.f; LB[1024 + i] = e1 / (e0 + e1); }
    { Weights Wt{args.in[3], args.in[7], args.in[8], args.in[9], args.in[10]}; transpose_weights(Wt, ws, lds, gw, NGW, wave, lane); }
    for (int m = gw; m < T; m += NGW) prenorm_row(x0 + (size_t)m * D, pre_norm, XN + (size_t)m * D, (unsigned*)(ws + WS_XN8) + (size_t)m * (D / 4), lane);
    }
    GRID_SYNC(0);
    if (args.ph_hi - args.ph_lo > 1) (void)xcd_barrier_post((unsigned*)args.ws, (volatile LAS unsigned*)(lds + XB_ST_OFF));

    run_layer<0>(args, lds);
#if NLAYER > 1
    run_layer<1>(args, lds);
#endif
#ifdef PROBE_TS
    STAMP(17);
    if (blockIdx.x == 0 && threadIdx.x == 0) { const unsigned long long* ts = (const unsigned long long*)(args.ws + 65536); const float dus_ = 0.01f * (float)(ts[PROBE_TS + 1] - ts[PROBE_TS]); args.out[0] = 1000.0f * floorf(dus_ / (float)PROBE_BUCKET) + 1000.0f; }
#endif
}

__global__ void dump_bf16(const bf16_t* src, size_t pitch, float* out) {
    const size_t i = (size_t)blockIdx.x * blockDim.x + threadIdx.x; const size_t r = i / 2048, c = i % 2048;
    out[i] = bf2f(src[r * pitch + c]);
}
__global__ void dump_f32(const float* src, float* out) { const size_t i = (size_t)blockIdx.x * blockDim.x + threadIdx.x; out[i] = src[i]; }
__global__ void dump_mix(const unsigned char* ws, float* out) {
    const size_t i = (size_t)blockIdx.x * blockDim.x + threadIdx.x; const size_t r = i / 2048, c = i % 2048;
    const bf16_t* P = (const bf16_t*)(ws + WS_P); const bf16_t* Yb = (const bf16_t*)(ws + WS_YB); const bf16_t* Yc = (const bf16_t*)(ws + WS_YC); const float* SUM = (const float*)(ws + WS_SUM); const float* lse = (const float*)(ws + WS_LSE);
    float v = 0.f;
#if PROBE_SEL & 1
    v += bf2f(P[r * PC + c]);
#endif
#if PROBE_SEL & 2
    v += bf2f(Yb[r * 1024 + (c & 1023)]);
#endif
#if PROBE_SEL & 4
    v += SUM[i % ((size_t)512 * 16384)];
#endif
#if PROBE_SEL & 8
    v += lse[i % ((size_t)3 * T * 4)];
#endif
#if PROBE_SEL & 16
    v += bf2f(Yc[r * 1024 + (c & 1023)]);
#endif
#if PROBE_SEL & 32
    v += bf2f(P[r * PC + PC_FF + (c & 1023)]);
#endif
#if PROBE_SEL & 64
    v += bf2f(P[r * PC + PC_FB + (c & 1023)]);
#endif
    if (!(v == v) || fabsf(v) > 1e30f) v = 12345.f;
    out[i] = v;
}
extern "C" void kernel_launch(void* const* d_in, const int* in_sizes, int n_in, void* d_out, int out_size, void* d_ws, size_t ws_size, hipStream_t stream) {
    static int grid = 0;
    if (grid == 0) {
        if (n_in != 11 || ws_size < WS_END8) { fprintf(stderr, "kernel_launch: unexpected inputs (n_in %d, ws %zu)\n", n_in, ws_size); grid = -1; return; }
        int dev = 0, cus = 0, per_cu = 0;
        hipGetDevice(&dev); hipDeviceGetAttribute(&cus, hipDeviceAttributeMultiprocessorCount, dev);
        hipFuncSetAttribute((const void*)fwd_megakernel, hipFuncAttributeMaxDynamicSharedMemorySize, LDS_BYTES);
        hipOccupancyMaxActiveBlocksPerMultiprocessor(&per_cu, (const void*)fwd_megakernel, NTHREADS, LDS_BYTES);
        if (per_cu < 1) per_cu = 1;
        grid = cus * per_cu;
    }
    if (grid < 0) return;
    Args a{};
    for (int i = 0; i < 11; ++i) a.in[i] = (const float*)d_in[i];
    a.out = (float*)d_out; a.ws = (unsigned char*)d_ws;
#ifdef PROBE_PHASES
    for (int ph = 0; ph < PROBE_PHASES; ++ph) { a.ph_lo = ph; a.ph_hi = ph + 1; hipLaunchKernelGGL(fwd_megakernel, dim3(grid), dim3(NTHREADS), LDS_BYTES, stream, a); }
    PROBE_DUMP
#elif defined(MULTI_LAUNCH)
    for (int ph = 0; ph < 17; ++ph) { a.ph_lo = ph; a.ph_hi = ph + 1; hipLaunchKernelGGL(fwd_megakernel, dim3(grid), dim3(NTHREADS), LDS_BYTES, stream, a); }
#else
    static bool per_phase = false;
    if (!per_phase) {
        a.ph_lo = 0; a.ph_hi = 17;
        void* kargs[] = {&a};
        hipError_t e = hipLaunchCooperativeKernel((const void*)fwd_megakernel, dim3(grid), dim3(NTHREADS), kargs, LDS_BYTES, stream);
        if (e != hipSuccess) { fprintf(stderr, "cooperative launch failed: %s (grid %d); falling back to one launch per phase\n", hipGetErrorString(e), grid); (void)hipGetLastError(); per_phase = true; }
    }
    if (per_phase) for (int ph = 0; ph < 17; ++ph) { a.ph_lo = ph; a.ph_hi = ph + 1; hipLaunchKernelGGL(fwd_megakernel, dim3(grid), dim3(NTHREADS), LDS_BYTES, stream, a); }
#endif
}
```
